# Optimizing an MI355X kernel written in HIP

```python
import numpy as np
import jax
import jax.numpy as jnp
from jax import lax

D_MODEL = 2048
BATCH = 2
SEQ = 8192
DEPTH = 2

HEAD_DIM = 64
MIX_WIDTH = D_MODEL
A_WIDTH = MIX_WIDTH // 4
A_HEADS = A_WIDTH // HEAD_DIM
A_KV_HEADS = 2
CMP_BLOCK = 32
CMP_STRIDE = 16
SEL_BLOCK = 64
SEL_TOPK = 16
SEL_LOCAL = 2
NSA_WINDOW = 512
Q_CHUNK = 128
FORCE_BONUS = 1.0e4
B_WIDTH = MIX_WIDTH // 2
B_HEADS = 4
B_HEAD_DIM = B_WIDTH // B_HEADS
CONV_WIDTH = 4
MLSTM_CHUNK = 64
C_WIDTH = MIX_WIDTH - A_WIDTH - B_WIDTH
C_HEADS = C_WIDTH // HEAD_DIM
C_KV_HEADS = 2
SWA_WINDOW = 128
BAND_BLOCK = 128
NEG_INF = -1.0e30
EPS = 1.0e-6
IN_SPLITS = (
    A_WIDTH,
    A_KV_HEADS * HEAD_DIM,
    A_KV_HEADS * HEAD_DIM,
    A_KV_HEADS * HEAD_DIM,
    A_KV_HEADS * HEAD_DIM,
    A_KV_HEADS * HEAD_DIM,
    A_KV_HEADS * HEAD_DIM,
    A_HEADS * 3,
    A_WIDTH,
    2 * B_WIDTH,
    B_WIDTH,
    B_HEADS,
    B_HEADS,
    B_WIDTH,
    B_WIDTH,
    C_WIDTH,
    C_KV_HEADS * HEAD_DIM,
    C_KV_HEADS * HEAD_DIM,
    C_WIDTH,
)
IN_COLS = sum(IN_SPLITS)

kernel_name = 'hymba_nsa_mlstm_swa_hybrid'


def rmsnorm(x, g):
    xf = x.astype(jnp.float32)
    y = xf * lax.rsqrt(jnp.mean(xf * xf, axis=-1, keepdims=True) + EPS)
    return (y * g.astype(jnp.float32)).astype(x.dtype)


def alibi_slopes(n_heads):
    return 2.0 ** (-8.0 * jnp.arange(1, n_heads + 1, dtype=jnp.float32) / n_heads)


def causal_depthwise_conv(x, w, b):
    T = x.shape[1]
    xp = jnp.pad(x, ((0, 0), (w.shape[0] - 1, 0), (0, 0)))
    y = b
    for i in range(w.shape[0]):
        y = y + xp[:, i:i + T] * w[i]
    return y


def banded_attention(q, k, v, slopes, window, sinks):
    bsz, T, H, d = q.shape
    G = k.shape[2]
    hpg = H // G
    blk = BAND_BLOCK
    nblk = T // blk
    span = blk + window
    scale = d ** -0.5
    kp = jnp.pad(k, ((0, 0), (window, 0), (0, 0), (0, 0)))
    vp = jnp.pad(v, ((0, 0), (window, 0), (0, 0), (0, 0)))
    qb = q.reshape(bsz, nblk, blk, G, hpg, d).transpose(1, 0, 2, 3, 4, 5)
    key_off = jnp.arange(span)[None, :]
    dist = (jnp.arange(blk)[:, None] + window) - key_off
    band = (dist >= 0) & (dist < window)
    slope_term = slopes.reshape(G, hpg)[:, :, None, None] * dist.astype(jnp.float32)

    def one_block(args):
        qj, j = args
        kj = lax.dynamic_slice_in_dim(kp, j * blk, span, axis=1)
        vj = lax.dynamic_slice_in_dim(vp, j * blk, span, axis=1)
        sc = jnp.einsum('bqghd,bsgd->bghqs', qj, kj).astype(jnp.float32) * scale - slope_term
        mask = band & (key_off >= window - j * blk)
        sc = jnp.where(mask, sc, NEG_INF)
        if sinks is None:
            p = jax.nn.softmax(sc, axis=-1)
        else:
            sk = sinks.astype(jnp.float32).reshape(G, hpg)[:, :, None, None]
            mx = jnp.maximum(sc.max(axis=-1, keepdims=True), sk)
            e = jnp.exp(sc - mx)
            p = e / (e.sum(axis=-1, keepdims=True) + jnp.exp(sk - mx))
        return jnp.einsum('bghqs,bsgd->bqghd', p.astype(v.dtype), vj)

    o = lax.map(one_block, (qb, jnp.arange(nblk)))
    return o.transpose(1, 0, 2, 3, 4, 5).reshape(bsz, T, H, d)


def nsa_compress(k, pe, w1, w2):
    bsz, T, G, d = k.shape
    n_cmp = (T - CMP_BLOCK) // CMP_STRIDE + 1
    idx = jnp.arange(n_cmp)[:, None] * CMP_STRIDE + jnp.arange(CMP_BLOCK)[None, :]
    blocks = k[:, idx] + pe[None, None, :, None, :]
    blocks = blocks.transpose(0, 1, 3, 2, 4).reshape(bsz, n_cmp, G, CMP_BLOCK * d)
    return jax.nn.silu(blocks @ w1) @ w2


def nsa_compressed_and_selected(q, k_cmp, v_cmp, k_slc, v_slc, slopes):
    bsz, T, H, d = q.shape
    G = k_cmp.shape[2]
    hpg = H // G
    n_cmp = k_cmp.shape[1]
    n_sel = T // SEL_BLOCK
    n_top = min(SEL_TOPK, n_sel)
    nq = T // Q_CHUNK
    scale = d ** -0.5
    cmp_start = jnp.arange(n_cmp) * CMP_STRIDE
    cmp_end = cmp_start + CMP_BLOCK - 1
    sel_start = jnp.arange(n_sel) * SEL_BLOCK
    overlap = ((cmp_start[:, None] < sel_start[None, :] + SEL_BLOCK)
               & (cmp_start[:, None] + CMP_BLOCK > sel_start[None, :])).astype(jnp.float32)
    kb = k_slc.reshape(bsz, n_sel, SEL_BLOCK, G, d).transpose(0, 3, 1, 2, 4)
    vb = v_slc.reshape(bsz, n_sel, SEL_BLOCK, G, d).transpose(0, 3, 1, 2, 4)
    qc = q.reshape(bsz, nq, Q_CHUNK, G, hpg, d).transpose(1, 0, 2, 3, 4, 5)
    sl = slopes.reshape(G, hpg)[None, :, :, None, None]
    b_idx = jnp.arange(bsz)[:, None, None, None]
    g_idx = jnp.arange(G)[None, :, None, None]
    r_idx = jnp.arange(Q_CHUNK)[None, None, :, None]
    sel_ids = jnp.arange(n_sel)[None, :]

    def one_chunk(args):
        qi, c = args
        t = c * Q_CHUNK + jnp.arange(Q_CHUNK)
        s_cmp = jnp.einsum('bqghd,bigd->bghqi', qi, k_cmp).astype(jnp.float32) * scale
        vis = cmp_end[None, :] <= t[:, None]
        p_cmp = jax.nn.softmax(jnp.where(vis, s_cmp, NEG_INF), axis=-1)
        p_cmp = p_cmp * vis.any(axis=-1)[:, None].astype(jnp.float32)
        o_cmp = jnp.einsum('bghqi,bigd->bqghd', p_cmp.astype(v_cmp.dtype), v_cmp)
        imp = jnp.einsum('bghqi,ij->bgqj', p_cmp, overlap)
        cur = (t // SEL_BLOCK)[:, None]
        valid = sel_ids <= cur
        forced = (sel_ids == 0) | (valid & (sel_ids > cur - SEL_LOCAL))
        imp = jnp.where(forced, FORCE_BONUS, jnp.where(valid, imp, -1.0))
        _, top = lax.top_k(imp, n_top)
        chosen = valid[r_idx, top]
        ks = kb[b_idx, g_idx, top].reshape(bsz, G, Q_CHUNK, n_top * SEL_BLOCK, d)
        vs = vb[b_idx, g_idx, top].reshape(bsz, G, Q_CHUNK, n_top * SEL_BLOCK, d)
        pos = (top[..., None] * SEL_BLOCK + jnp.arange(SEL_BLOCK)).reshape(bsz, G, Q_CHUNK, n_top * SEL_BLOCK)
        dist = t[None, None, :, None] - pos
        mask = jnp.repeat(chosen, SEL_BLOCK, axis=-1) & (dist >= 0)
        s_slc = (jnp.einsum('bqghd,bgqsd->bghqs', qi, ks).astype(jnp.float32) * scale
                 - sl * dist[:, :, None].astype(jnp.float32))
        p_slc = jax.nn.softmax(jnp.where(mask[:, :, None], s_slc, NEG_INF), axis=-1)
        o_slc = jnp.einsum('bghqs,bgqsd->bqghd', p_slc.astype(vs.dtype), vs)
        return o_cmp, o_slc

    o_cmp, o_slc = lax.map(one_chunk, (qc, jnp.arange(nq)))
    o_cmp = o_cmp.transpose(1, 0, 2, 3, 4, 5).reshape(bsz, T, H, d)
    o_slc = o_slc.transpose(1, 0, 2, 3, 4, 5).reshape(bsz, T, H, d)
    return o_cmp, o_slc


def mlstm_chunkwise(q, k, v, i_pre, f_pre):
    bsz, T, H, d = q.shape
    L = MLSTM_CHUNK
    nC = T // L

    def chunks(a):
        return a.reshape(bsz, nC, L, H, -1).transpose(1, 0, 3, 2, 4)

    qc, kc, vc = chunks(q), chunks(k), chunks(v)
    ic = i_pre.reshape(bsz, nC, L, H).transpose(1, 0, 3, 2)
    lfc = jax.nn.log_sigmoid(f_pre).reshape(bsz, nC, L, H).transpose(1, 0, 3, 2)
    causal = jnp.tril(jnp.ones((L, L), dtype=bool))

    def step(carry, xs):
        C, n, m = carry
        q_, k_, v_, i_, lf_ = xs
        b = jnp.cumsum(lf_, axis=-1)
        b_last = b[..., -1]
        log_d = jnp.where(causal, b[..., :, None] - b[..., None, :] + i_[..., None, :], -jnp.inf)
        log_inter = b + m[..., None]
        m_t = jnp.maximum(log_inter, log_d.max(axis=-1))
        w_intra = jnp.exp(log_d - m_t[..., None])
        w_inter = jnp.exp(log_inter - m_t)
        qk = jnp.einsum('bhtd,bhsd->bhts', q_, k_) * w_intra
        num = (w_inter[..., None] * jnp.einsum('bhtd,bhde->bhte', q_, C)
               + jnp.einsum('bhts,bhse->bhte', qk, v_))
        den = w_inter * jnp.einsum('bhtd,bhd->bht', q_, n) + qk.sum(axis=-1)
        h = num / jnp.maximum(jnp.abs(den), jnp.exp(-m_t))[..., None]
        log_g = b_last[..., None] - b + i_
        m_new = jnp.maximum(b_last + m, log_g.max(axis=-1))
        w_g = jnp.exp(log_g - m_new[..., None])
        decay = jnp.exp(b_last + m - m_new)
        C = decay[..., None, None] * C + jnp.einsum('bhsd,bhse->bhde', k_ * w_g[..., None], v_)
        n = decay[..., None] * n + jnp.einsum('bhs,bhsd->bhd', w_g, k_)
        return (C, n, m_new), h

    init = (jnp.zeros((bsz, H, d, v.shape[-1]), jnp.float32),
            jnp.zeros((bsz, H, d), jnp.float32),
            jnp.zeros((bsz, H), jnp.float32))
    _, h = lax.scan(step, init, (qc, kc, vc, ic, lfc))
    return h.transpose(1, 0, 3, 2, 4).reshape(bsz, T, H, -1)


def hybrid_layer(x, norm_g, w_in, w_out, cmp_pe_k, cmp_w1_k, cmp_w2_k, cmp_pe_v, cmp_w1_v, cmp_w2_v,
                 conv_w, conv_b, i_bias, f_bias, mnorm_g, sinks):
    bsz, T, _ = x.shape
    f32 = jnp.float32
    h = rmsnorm(x, norm_g)
    proj = h @ w_in
    split_at = [int(p) for p in np.cumsum(IN_SPLITS)[:-1]]
    (a_q, a_kc, a_vc, a_ks, a_vs, a_kw, a_vw, a_gate, a_z,
     b_qk, b_v, b_i, b_f, b_o, b_z,
     c_q, c_k, c_v, c_z) = jnp.split(proj, split_at, axis=-1)

    def heads(a, n):
        return a.reshape(bsz, T, n, -1)

    slopes_a = alibi_slopes(A_HEADS)
    q_a = heads(a_q, A_HEADS)
    k_cmp = nsa_compress(heads(a_kc, A_KV_HEADS), cmp_pe_k, cmp_w1_k, cmp_w2_k)
    v_cmp = nsa_compress(heads(a_vc, A_KV_HEADS), cmp_pe_v, cmp_w1_v, cmp_w2_v)
    o_cmp, o_slc = nsa_compressed_and_selected(q_a, k_cmp, v_cmp, heads(a_ks, A_KV_HEADS),
                                               heads(a_vs, A_KV_HEADS), slopes_a)
    o_win = banded_attention(q_a, heads(a_kw, A_KV_HEADS), heads(a_vw, A_KV_HEADS), slopes_a, NSA_WINDOW, None)
    gate = jax.nn.sigmoid(heads(a_gate, A_HEADS))
    o_a = gate[..., 0:1] * o_cmp + gate[..., 1:2] * o_slc + gate[..., 2:3] * o_win
    y_a = o_a.reshape(bsz, T, A_WIDTH) * jax.nn.silu(a_z)

    qk_b = jax.nn.silu(causal_depthwise_conv(b_qk, conv_w, conv_b))
    q_b, k_b = jnp.split(qk_b, 2, axis=-1)
    h_b = mlstm_chunkwise(heads(q_b, B_HEADS).astype(f32),
                          heads(k_b, B_HEADS).astype(f32) * B_HEAD_DIM ** -0.5,
                          heads(b_v, B_HEADS).astype(f32),
                          (b_i + i_bias).astype(f32),
                          (b_f + f_bias).astype(f32))
    h_b = jax.nn.sigmoid(heads(b_o, B_HEADS).astype(f32)) * h_b
    h_b = rmsnorm(h_b, mnorm_g.reshape(B_HEADS, B_HEAD_DIM)).astype(x.dtype)
    y_b = h_b.reshape(bsz, T, B_WIDTH) * jax.nn.silu(b_z)

    o_c = banded_attention(heads(c_q, C_HEADS), heads(c_k, C_KV_HEADS), heads(c_v, C_KV_HEADS),
                           alibi_slopes(C_HEADS), SWA_WINDOW, sinks)
    y_c = o_c.reshape(bsz, T, C_WIDTH) * jax.nn.silu(c_z)

    mix = jnp.concatenate([y_a, y_b, y_c], axis=-1)
    return x + mix @ w_out


def setup_inputs(seed: int = 0) -> dict:
    key = jax.random.key(seed)
    ks = jax.random.split(key, 17)
    f32 = jnp.float32

    def nrm(k, shape, s):
        return jax.random.normal(k, shape, f32) * s

    cmp_in = CMP_BLOCK * HEAD_DIM
    return {
        'x': nrm(ks[0], (BATCH, SEQ, D_MODEL), 1.0),
        'norm_g': 1.0 + nrm(ks[1], (DEPTH, D_MODEL), 0.02),
        'w_in': nrm(ks[2], (DEPTH, D_MODEL, IN_COLS), D_MODEL ** -0.5),
        'w_out': nrm(ks[3], (DEPTH, MIX_WIDTH, D_MODEL), MIX_WIDTH ** -0.5),
        'cmp_pe_k': nrm(ks[4], (DEPTH, CMP_BLOCK, HEAD_DIM), 0.02),
        'cmp_w1_k': nrm(ks[5], (DEPTH, cmp_in, HEAD_DIM), cmp_in ** -0.5),
        'cmp_w2_k': nrm(ks[6], (DEPTH, HEAD_DIM, HEAD_DIM), HEAD_DIM ** -0.5),
        'cmp_pe_v': nrm(ks[7], (DEPTH, CMP_BLOCK, HEAD_DIM), 0.02),
        'cmp_w1_v': nrm(ks[8], (DEPTH, cmp_in, HEAD_DIM), cmp_in ** -0.5),
        'cmp_w2_v': nrm(ks[9], (DEPTH, HEAD_DIM, HEAD_DIM), HEAD_DIM ** -0.5),
        'mlstm_conv_w': nrm(ks[10], (DEPTH, CONV_WIDTH, 2 * B_WIDTH), CONV_WIDTH ** -0.5),
        'mlstm_conv_b': nrm(ks[11], (DEPTH, 2 * B_WIDTH), 0.01),
        'mlstm_i_bias': nrm(ks[12], (DEPTH, B_HEADS), 0.1),
        'mlstm_f_bias': jnp.linspace(3.0, 6.0, B_HEADS, dtype=f32)[None, :] + nrm(ks[13], (DEPTH, B_HEADS), 0.1),
        'mlstm_norm_g': 1.0 + nrm(ks[14], (DEPTH, B_WIDTH), 0.02),
        'swa_sinks': nrm(ks[15], (DEPTH, C_HEADS), 0.5),
        'final_norm_g': 1.0 + nrm(ks[16], (D_MODEL,), 0.02),
    }


def reference(x, norm_g, w_in, w_out, cmp_pe_k, cmp_w1_k, cmp_w2_k, cmp_pe_v, cmp_w1_v, cmp_w2_v,
              mlstm_conv_w, mlstm_conv_b, mlstm_i_bias, mlstm_f_bias, mlstm_norm_g, swa_sinks, final_norm_g):
    for l in range(DEPTH):
        x = hybrid_layer(x, norm_g[l], w_in[l], w_out[l],
                         cmp_pe_k[l], cmp_w1_k[l], cmp_w2_k[l], cmp_pe_v[l], cmp_w1_v[l], cmp_w2_v[l],
                         mlstm_conv_w[l], mlstm_conv_b[l], mlstm_i_bias[l], mlstm_f_bias[l],
                         mlstm_norm_g[l], swa_sinks[l])
    return rmsnorm(x, final_norm_g)
```

```cpp
#include <hip/hip_runtime.h>
#include <hip/hip_cooperative_groups.h>
#include <cstdio>
#include <cstdint>
namespace cg = cooperative_groups;
namespace pg8 {
#define PG8_LAS __attribute__((address_space(3)))
typedef unsigned short bf16_t;
typedef short bf16x8 __attribute__((ext_vector_type(8)));
typedef float f32x4 __attribute__((ext_vector_type(4)));
typedef unsigned u32x4 __attribute__((ext_vector_type(4)));
constexpr int BM = 256, BK = 64, HALF = 128, HTB = HALF * BK * 2  , STAGE_BYTES = 8 * HTB, NXCD = 8, WGM = 8;

__host__ __device__ __forceinline__ int lds_byte(int r, int c) { const int st = (r >> 4) * 2 + (c >> 5), rr = r & 15, cc = c & 31, ob = rr * 64 + cc * 2; return st * 1024 + (ob ^ (((ob >> 9) & 1) << 5)); }
__host__ __device__ __forceinline__ void stage_rc(int b, int& R, int& C) { const int st = b / 1024, sb = b % 1024, swz = sb ^ (((sb >> 9) & 1) << 5); R = (st >> 1) * 16 + swz / 64; C = (st & 1) * 32 + (swz % 64) / 2; }
__host__ __device__ __forceinline__ int perm32(int rho) { const int n = rho >> 4, i = rho & 15; return 8 * (i >> 2) + 4 * n + (i & 3); }

struct Unit { int pm, pn; };
struct Gemm { const bf16_t* A; const bf16_t* Bt; int M, N, K; };

struct StaticOrder {
    int nM, nN, nwg, G, c;
    __host__ __device__ void init(int M, int N, int G_, int c_) { nM = M / BM; nN = N / BM; nwg = nM * nN; G = G_; c = c_; }
    __host__ __device__ bool next(int i, Unit& u) const {
        const long L = (long)i * G + c; if (L >= nwg) return false;
        int wgid = (int)L; { const int q = nwg / NXCD, r = nwg % NXCD, xcd = wgid % NXCD, off = wgid / NXCD; wgid = (xcd < r ? xcd * (q + 1) : r * (q + 1) + (xcd - r) * q) + off; }
        const int nig = WGM * nN, gid = wgid / nig, fm = gid * WGM, gsz = (nM - fm) < WGM ? (nM - fm) : WGM;
        u.pm = fm + ((wgid % nig) % gsz); u.pn = (wgid % nig) / gsz; return true;
    }
    __device__ __forceinline__ void a_ready(const Unit&) const {}
    __device__ __forceinline__ void done(const Unit&) const {}
};

__device__ __forceinline__ unsigned cvt_pk_bf16(float lo, float hi) { unsigned r; asm volatile("v_cvt_pk_bf16_f32 %0, %1, %2" : "=v"(r) : "v"(lo), "v"(hi)); return r; }
typedef float f32x2 __attribute__((ext_vector_type(2)));
struct EpiProj {
    static constexpr bool PERM = true, AFTER_DRAIN = false;
    bf16_t* O; int ldc; const float* ssq; float* small_;
    __device__ __forceinline__ void operator()(const f32x4 (&acc)[2][2][4][2], const Unit& u, int wr, int wc, int fr, int fq) const {
        const int row0 = u.pm * BM + wr * 64 + fr;
#pragma unroll
        for (int ai = 0; ai < 2; ++ai)
#pragma unroll
            for (int m = 0; m < 4; ++m) {
                const int row = row0 + ai * HALF + m * 16;
                const f32x4* sp = (const f32x4*)(ssq + (size_t)row * 32);
                f32x4 s4 = sp[0];
#pragma unroll
                for (int j = 1; j < 8; ++j) s4 += sp[j];
                const float rstd = 1.0f / sqrtf(((s4[0] + s4[1]) + (s4[2] + s4[3])) * (1.0f / 2048.0f) + 1.0e-6f);
                if (u.pn < 32) {
                    bf16_t* rowp = O + (size_t)row * ldc + u.pn * BM + wc * 32 + 8 * fq;
#pragma unroll
                    for (int bj = 0; bj < 2; ++bj) { const f32x4 v0 = acc[ai][bj][m][0] * rstd, v1 = acc[ai][bj][m][1] * rstd;
                        u32x4 w; w.x = cvt_pk_bf16(v0[0], v0[1]); w.y = cvt_pk_bf16(v0[2], v0[3]); w.z = cvt_pk_bf16(v1[0], v1[1]); w.w = cvt_pk_bf16(v1[2], v1[3]);
                        *(u32x4*)(rowp + bj * HALF) = w; }
                } else if (wc == 0) {
                    float* sp2 = small_ + (size_t)row * 32 + 8 * fq;
                    *(f32x4*)(sp2) = acc[ai][0][m][0] * rstd; *(f32x4*)(sp2 + 4) = acc[ai][0][m][1] * rstd;
                }
            }
    }
};
struct EpiOut {
    static constexpr bool PERM = false, AFTER_DRAIN = false;
    const float* xin; float* xout; bf16_t* xb; float* ssq; int ldc;
    __device__ __forceinline__ void operator()(const f32x4 (&acc)[2][2][4][2], const Unit& u, int wr, int wc, int fr, int fq) const {
        const int row0 = u.pm * BM + wr * 64 + fr, col0 = u.pn * BM + wc * 32 + 4 * fq;
#pragma unroll
        for (int ai = 0; ai < 2; ++ai)
#pragma unroll
            for (int m = 0; m < 4; ++m) {
                const int row = row0 + ai * HALF + m * 16; const size_t off = (size_t)row * ldc + col0; float s = 0.f;
#pragma unroll
                for (int bj = 0; bj < 2; ++bj)
#pragma unroll
                    for (int n = 0; n < 2; ++n) { const size_t o2 = off + bj * HALF + n * 16; const f32x4 v = *(const f32x4*)(xin + o2) + acc[ai][bj][m][n];
                        *(f32x4*)(xout + o2) = v; unsigned w0 = cvt_pk_bf16(v[0], v[1]), w1 = cvt_pk_bf16(v[2], v[3]);
                        *(unsigned long long*)(xb + o2) = (unsigned long long)w0 | ((unsigned long long)w1 << 32);
                        s += (v[0] * v[0] + v[1] * v[1]) + (v[2] * v[2] + v[3] * v[3]); }
                s += __shfl_xor(s, 16); s += __shfl_xor(s, 32);
                if (fq == 0) ssq[(size_t)row * 32 + u.pn * 4 + wc] = s;
            }
    }
};
template <class Epi, class Sched, bool ALIGN_EPI = false, bool SP2 = false>
__device__ __forceinline__ void gemm_phase(PG8_LAS unsigned char* lds, const Gemm g, const Sched& S, const Epi& E) {
    int tid_ = threadIdx.x; asm volatile("" : "+v"(tid_)); const int tid = tid_, wid = __builtin_amdgcn_readfirstlane(tid >> 6), lane = tid & 63, wr = wid >> 2, wc = wid & 3, fr = lane & 15, fq = lane >> 4;
    const int K = g.K, nt = K / BK;
    unsigned voffA[2], voffB[2];
#pragma unroll
    for (int i = 0; i < 2; ++i) { int R, C; stage_rc(tid * 16 + i * 8192, R, C); const int Rb = Epi::PERM ? ((R & ~31) + perm32(R & 31)) : R;
        voffA[i] = (unsigned)(R * K + C) * 2u; voffB[i] = (unsigned)(Rb * K + C) * 2u; }
    const size_t kstep = (size_t)(BK * 2);
    const size_t hstep = (size_t)HALF * K * 2;
    const size_t tstep = 2 * hstep;
    const unsigned ldsw = (unsigned)wid * 1024u;
    const int aoff = lds_byte(wr * 64 + fr, fq * 8), boff = lds_byte(wc * 32 + fr, fq * 8);
#define PG8_SA(b, h) (((b) * 2 + (h)) * HTB)
#define PG8_SB(b, h) ((4 + (b) * 2 + (h)) * HTB)
#define PG8_STAGE(bufoff, gbase, voff) do { _Pragma("unroll") for (int _i = 0; _i < 2; ++_i) \
        __builtin_amdgcn_global_load_lds((const unsigned*)((const char*)(gbase) + (voff)[_i]), (PG8_LAS unsigned*)(lds + (bufoff) + ldsw + _i * 8192), 16, 0, 0); } while (0)
#define PG8_LDA(dst, b, h) do { _Pragma("unroll") for (int m = 0; m < 4; ++m) _Pragma("unroll") for (int k = 0; k < 2; ++k) dst[m][k] = *(const PG8_LAS bf16x8*)(lds + PG8_SA(b, h) + aoff + m * 2048 + k * 1024); } while (0)
#define PG8_LDB(dst, b, h) do { _Pragma("unroll") for (int n = 0; n < 2; ++n) _Pragma("unroll") for (int k = 0; k < 2; ++k) dst[n][k] = *(const PG8_LAS bf16x8*)(lds + PG8_SB(b, h) + boff + n * 2048 + k * 1024); } while (0)
#define PG8_MMA(ai, bj, At, Bt) do { __builtin_amdgcn_s_setprio(1); _Pragma("unroll") for (int m = 0; m < 4; ++m) _Pragma("unroll") for (int n = 0; n < 2; ++n) _Pragma("unroll") for (int k = 0; k < 2; ++k) \
        acc[ai][bj][m][n] = __builtin_amdgcn_mfma_f32_16x16x32_bf16(Bt[n][k], At[m][k], acc[ai][bj][m][n], 0, 0, 0); __builtin_amdgcn_s_setprio(0); } while (0)
#define PG8_WAIT_V(n) asm volatile("s_waitcnt vmcnt(" #n ")" ::: "memory")
#define PG8_WAIT_L(n) asm volatile("s_waitcnt lgkmcnt(" #n ")" ::: "memory")
#define PG8_BAR __builtin_amdgcn_s_barrier()
#define PG8_SCHED __builtin_amdgcn_sched_barrier(0)
    Unit cur, nxt; int ui = 0;
    if (!S.next(0, cur)) return;
    f32x4 acc[2][2][4][2];
#pragma unroll
    for (int a = 0; a < 2; ++a)
#pragma unroll
        for (int b = 0; b < 2; ++b)
#pragma unroll
            for (int m = 0; m < 4; ++m)
#pragma unroll
                for (int n = 0; n < 2; ++n) acc[a][b][m][n] = (f32x4){0.f, 0.f, 0.f, 0.f};
    bf16x8 At[4][2], B0[2][2], B1[2][2];
    const char* cA = (const char*)g.A + (size_t)cur.pm * tstep; const char* cB = (const char*)g.Bt + (size_t)cur.pn * tstep;
    S.a_ready(cur);
    if constexpr (SP2) {
        PG8_STAGE(PG8_SB(0, 0), cB, voffB); PG8_STAGE(PG8_SB(0, 1), cB + hstep, voffB); PG8_STAGE(PG8_SA(0, 0), cA, voffA); PG8_STAGE(PG8_SA(0, 1), cA + hstep, voffA);
        if (wr == 1) PG8_BAR;
        PG8_WAIT_V(2); PG8_BAR;
        PG8_STAGE(PG8_SB(1, 0), cB + kstep, voffB); PG8_STAGE(PG8_SA(1, 0), cA + kstep, voffA); PG8_STAGE(PG8_SB(1, 1), cB + hstep + kstep, voffB);
        PG8_WAIT_V(6); PG8_BAR;
    } else {
        PG8_STAGE(PG8_SB(0, 0), cB, voffB); PG8_STAGE(PG8_SA(0, 0), cA, voffA); PG8_STAGE(PG8_SB(0, 1), cB + hstep, voffB); PG8_STAGE(PG8_SA(0, 1), cA + hstep, voffA);
        if (wr == 1) PG8_BAR;
        PG8_WAIT_V(4); PG8_BAR;
        PG8_STAGE(PG8_SB(1, 0), cB + kstep, voffB); PG8_STAGE(PG8_SA(1, 0), cA + kstep, voffA); PG8_STAGE(PG8_SB(1, 1), cB + hstep + kstep, voffB);
        PG8_WAIT_V(6); PG8_BAR;
    }
    for (;;) {
        const bool has_next = S.next(ui + 1, nxt);
        const char* nA = has_next ? (const char*)g.A + (size_t)nxt.pm * tstep : cA; const char* nB = has_next ? (const char*)g.Bt + (size_t)nxt.pn * tstep : cB;
        for (int t = 0; t < nt; t += 2) {
            const bool last = (t == nt - 2);
            const char* a1 = cA + (size_t)(t + 1) * kstep;
            const char* a2 = last ? nA : cA + (size_t)(t + 2) * kstep; const char* b2 = last ? nB : cB + (size_t)(t + 2) * kstep;
            const char* a3 = a2 + kstep; const char* b3 = b2 + kstep;
            if (last && has_next) S.a_ready(nxt);
            if constexpr (SP2) {
            PG8_LDB(B0, 0, 0); PG8_LDB(B1, 0, 1); PG8_SCHED; PG8_LDA(At, 0, 0); PG8_STAGE(PG8_SA(1, 1), a1 + hstep, voffA);
            PG8_WAIT_V(8); PG8_WAIT_L(0); PG8_BAR; PG8_MMA(0, 0, At, B0); PG8_MMA(0, 1, At, B1); PG8_BAR; PG8_SCHED;
            PG8_LDA(At, 0, 1); PG8_STAGE(PG8_SB(0, 0), b2, voffB); PG8_STAGE(PG8_SB(0, 1), b2 + hstep, voffB); PG8_STAGE(PG8_SA(0, 0), a2, voffA);
            PG8_WAIT_V(8); PG8_WAIT_L(0); PG8_BAR; PG8_MMA(1, 0, At, B0); PG8_MMA(1, 1, At, B1); PG8_BAR; PG8_SCHED;
            PG8_LDB(B0, 1, 0); PG8_LDB(B1, 1, 1); PG8_SCHED; PG8_LDA(At, 1, 0); PG8_STAGE(PG8_SA(0, 1), a2 + hstep, voffA);
            PG8_WAIT_V(8); PG8_WAIT_L(0); PG8_BAR; PG8_MMA(0, 0, At, B0); PG8_MMA(0, 1, At, B1); PG8_BAR; PG8_SCHED;
            PG8_LDA(At, 1, 1); PG8_STAGE(PG8_SB(1, 0), b3, voffB); PG8_STAGE(PG8_SB(1, 1), b3 + hstep, voffB); PG8_STAGE(PG8_SA(1, 0), a3, voffA);
            PG8_WAIT_V(8); PG8_WAIT_L(0); PG8_BAR; PG8_MMA(1, 0, At, B0); PG8_MMA(1, 1, At, B1); PG8_BAR; PG8_SCHED;
            } else {
            PG8_LDB(B0, 0, 0); PG8_SCHED; PG8_LDA(At, 0, 0); PG8_STAGE(PG8_SA(1, 1), a1 + hstep, voffA);
            PG8_WAIT_L(8); PG8_BAR; PG8_WAIT_L(0); PG8_MMA(0, 0, At, B0); PG8_BAR; PG8_SCHED;
            PG8_LDB(B1, 0, 1); PG8_STAGE(PG8_SB(0, 0), b2, voffB);
            PG8_BAR; PG8_WAIT_L(0); PG8_MMA(0, 1, At, B1); PG8_BAR;
            PG8_LDA(At, 0, 1); PG8_STAGE(PG8_SA(0, 0), a2, voffA);
            PG8_BAR; PG8_WAIT_L(0); PG8_MMA(1, 0, At, B0); PG8_BAR; PG8_SCHED;
            PG8_STAGE(PG8_SB(0, 1), b2 + hstep, voffB);
            PG8_WAIT_V(6); PG8_BAR; PG8_MMA(1, 1, At, B1); PG8_BAR;
            PG8_LDB(B0, 1, 0); PG8_SCHED; PG8_LDA(At, 1, 0); PG8_STAGE(PG8_SA(0, 1), a2 + hstep, voffA);
            PG8_WAIT_L(8); PG8_BAR; PG8_WAIT_L(0); PG8_MMA(0, 0, At, B0); PG8_BAR; PG8_SCHED;
            PG8_LDB(B1, 1, 1); PG8_STAGE(PG8_SB(1, 0), b3, voffB);
            PG8_BAR; PG8_WAIT_L(0); PG8_MMA(0, 1, At, B1); PG8_BAR;
            PG8_LDA(At, 1, 1); PG8_STAGE(PG8_SA(1, 0), a3, voffA);
            PG8_BAR; PG8_WAIT_L(0); PG8_MMA(1, 0, At, B0); PG8_BAR; PG8_SCHED;
            PG8_STAGE(PG8_SB(1, 1), b3 + hstep, voffB);
            PG8_WAIT_V(6); PG8_BAR; PG8_MMA(1, 1, At, B1); PG8_BAR;
            }
        }
        if constexpr (ALIGN_EPI) { if (wr == 0) PG8_BAR; }
        if constexpr (!Epi::AFTER_DRAIN) { E(acc, cur, wr, wc, fr, fq); S.done(cur); }
        if (!has_next) break;
#pragma unroll
        for (int a = 0; a < 2; ++a)
#pragma unroll
            for (int b = 0; b < 2; ++b)
#pragma unroll
                for (int m = 0; m < 4; ++m)
#pragma unroll
                    for (int n = 0; n < 2; ++n) acc[a][b][m][n] = (f32x4){0.f, 0.f, 0.f, 0.f};
        cur = nxt; cA = nA; cB = nB; ++ui;
        if constexpr (ALIGN_EPI) { if (wr == 1) PG8_BAR; }
    }
    PG8_WAIT_V(0);
    if constexpr (!ALIGN_EPI) { if (wr == 0) PG8_BAR; }
    PG8_BAR;
    if constexpr (Epi::AFTER_DRAIN) { E.fused(acc, cur, wr, wc, fr, fq, lds, wid, lane); S.done(cur); }
#undef PG8_SA
#undef PG8_SB
#undef PG8_STAGE
#undef PG8_LDA
#undef PG8_LDB
#undef PG8_MMA
#undef PG8_WAIT_V
#undef PG8_WAIT_L
#undef PG8_BAR
#undef PG8_SCHED
}
}
constexpr int BATCH = 2, T = 8192, M = BATCH * T, D = 2048, NP = 8448, NIN = 8224;
constexpr int C_AQ = 0, C_AKC = 512, C_AVC = 640, C_AKS = 768, C_AVS = 896, C_AKW = 1024, C_AVW = 1152, C_AZ = 1280, C_BQ = 1792, C_BK = 2816, C_BV = 3840, C_BO = 4864, C_BZ = 5888,
              C_CQ = 6912, C_CK = 7424, C_CV = 7552, C_CZ = 7680;
constexpr int S_GATE = 0, S_I = 24, S_F = 28;
constexpr int NCMP = 511, CMP_PITCH = 512;
constexpr float EPS = 1.0e-6f, NEG = -1.0e30f;
constexpr size_t MiB = 1u << 20;
constexpr size_t WS_WIN = 0, WS_WOUT = 66 * MiB, WS_XB = 82 * MiB, WS_PROJ = 146 * MiB, WS_MIX = 410 * MiB, WS_SMALL = 474 * MiB, WS_SSQ = 476 * MiB, WS_KCMP = 478 * MiB, WS_VCMP = WS_KCMP + 512 * 1024, WS_END = 479 * MiB;
constexpr int LDS_BYTES = 147456;
typedef unsigned short bf16;
typedef float f4 __attribute__((ext_vector_type(4)));
typedef unsigned u4 __attribute__((ext_vector_type(4)));

__device__ __forceinline__ float bf2f(unsigned short u) { return __uint_as_float(((unsigned)u) << 16); }
__device__ __forceinline__ unsigned f2bf(float f) { unsigned u = __float_as_uint(f); return (u + 0x7fffu + ((u >> 16) & 1u)) >> 16; }
__device__ __forceinline__ unsigned pk2(float lo, float hi) { return f2bf(lo) | (f2bf(hi) << 16); }
__device__ __forceinline__ float wsum(float v) {
#pragma unroll
    for (int o = 1; o < 64; o <<= 1) v += __shfl_xor(v, o);
    return v; }
__device__ __forceinline__ float wmax(float v) {
#pragma unroll
    for (int o = 1; o < 64; o <<= 1) v = fmaxf(v, __shfl_xor(v, o));
    return v; }
__device__ __forceinline__ float sigmoidf_(float x) { return 1.0f / (1.0f + __expf(-x)); }
__device__ __forceinline__ float siluf_(float x) { return x / (1.0f + __expf(-x)); }
__device__ __forceinline__ float logsigmoidf_(float x) { return fminf(x, 0.f) - log1pf(__expf(-fabsf(x))); }

struct Params {
    const float* x; const float* norm_g; const float* w_in; const float* w_out;
    const float* pe_k; const float* w1_k; const float* w2_k; const float* pe_v; const float* w1_v; const float* w2_v;
    const float* conv_w; const float* conv_b; const float* i_bias; const float* f_bias; const float* mnorm_g; const float* sinks; const float* final_g;
    float* out; unsigned char* ws;
};

__device__ __forceinline__ int orig_col(int n) {
    if (n < 1280) return n;
    if (n < 4864) return n + 24;
    if (n < 8192) return n + 32;
    if (n < 8216) return 1280 + (n - 8192);
    if (n < 8224) return 4888 + (n - 8216);
    return -1;
}

__device__ __forceinline__ void transpose_item(const float* W, int K, int Nsrc, bool mapped, const float* g, bf16* WT, int nblk, float* scr, int item, int lane) {
    const int kb = item / nblk, nb = item % nblk, k0 = 64 * kb, n0 = 32 * nb;
    const int n = n0 + (lane & 31); const int oc = mapped ? orig_col(n) : n;
#pragma unroll 8
    for (int i = 0; i < 32; ++i) { const int kk = 2 * i + (lane >> 5); float v = 0.f;
        if (oc >= 0) { v = W[(size_t)(k0 + kk) * Nsrc + oc]; if (g) v *= g[k0 + kk]; }
        scr[kk * 33 + (lane & 31)] = v; }
    __builtin_amdgcn_wave_barrier(); asm volatile("s_waitcnt lgkmcnt(0)" ::: "memory");
    const int c = lane & 7;
#pragma unroll
    for (int j = 0; j < 4; ++j) { const int nn = (lane >> 3) + 8 * j; const float* s = scr + (8 * c) * 33 + nn;
        u4 o; o.x = pk2(s[0 * 33], s[1 * 33]); o.y = pk2(s[2 * 33], s[3 * 33]); o.z = pk2(s[4 * 33], s[5 * 33]); o.w = pk2(s[6 * 33], s[7 * 33]);
        *(u4*)(WT + (size_t)(n0 + nn) * K + k0 + 8 * c) = o; }
    __builtin_amdgcn_wave_barrier(); asm volatile("s_waitcnt lgkmcnt(0)" ::: "memory");
}
__device__ __forceinline__ void phase_prologue(const Params& P, unsigned char* lds, int gw, int NGW, int wave, int lane) {
    float* scr = (float*)(lds + wave * 16384);
    bf16* WIN = (bf16*)(P.ws + WS_WIN); bf16* WOUT = (bf16*)(P.ws + WS_WOUT);
    constexpr int I_IN = (D / 64) * (NP / 32), I_OUT = (D / 64) * (D / 32), NITEMS = 2 * I_IN + 2 * I_OUT;
    for (int it = gw; it < NITEMS; it += NGW) {
        int r = it;
        if (r < 2 * I_IN) { const int l = r / I_IN; r -= l * I_IN;
            transpose_item(P.w_in + (size_t)l * D * NIN, D, NIN, true, P.norm_g + l * D, WIN + (size_t)l * NP * D, NP / 32, scr, r, lane); continue; }
        r -= 2 * I_IN; { const int l = r / I_OUT; r -= l * I_OUT;
            transpose_item(P.w_out + (size_t)l * D * D, D, D, false, nullptr, WOUT + (size_t)l * D * D, D / 32, scr, r, lane); }
    }
    bf16* XB = (bf16*)(P.ws + WS_XB); float* SSQ = (float*)(P.ws + WS_SSQ);
    for (int m = gw; m < M; m += NGW) {
        const f4* xr = (const f4*)(P.x + (size_t)m * D) + lane; unsigned long long* o8 = (unsigned long long*)(XB + (size_t)m * D) + lane; float s = 0.f;
#pragma unroll
        for (int j = 0; j < 8; ++j) { const f4 v = xr[64 * j]; s += (v[0] * v[0] + v[1] * v[1]) + (v[2] * v[2] + v[3] * v[3]);
            o8[64 * j] = (unsigned long long)pk2(v[0], v[1]) | ((unsigned long long)pk2(v[2], v[3]) << 32); }
        s = wsum(s);
        if (lane < 32) SSQ[(size_t)m * 32 + lane] = (lane == 0) ? s : 0.f;
    }
}

__device__ __forceinline__ void phase_compress(const Params& P, int layer, int gw, int NGW, int lane) {
    const bf16* PROJ = (const bf16*)(P.ws + WS_PROJ);
    for (int it = gw; it < 2 * 2 * 2 * NCMP; it += NGW) {
        const int i = it % NCMP; int r = it / NCMP; const int g = r & 1; r >>= 1; const int b = r & 1; const int kv = r >> 1;
        const float* pe = (kv ? P.pe_v : P.pe_k) + (size_t)layer * 32 * 64;
        const float* w1 = (kv ? P.w1_v : P.w1_k) + (size_t)layer * 2048 * 64;
        const float* w2 = (kv ? P.w2_v : P.w2_k) + (size_t)layer * 64 * 64;
        const bf16* src = PROJ + (size_t)(b * T + 16 * i) * NP + (kv ? C_AVC : C_AKC) + g * 64;
        float hid = 0.f;
        for (int l = 0; l < 32; ++l) {
            const bf16* row = src + (size_t)l * NP;
#pragma unroll 8
            for (int dd = 0; dd < 64; ++dd) { const float a = bf2f(row[dd]) + pe[l * 64 + dd]; hid += a * w1[(size_t)(l * 64 + dd) * 64 + lane]; }
        }
        hid = siluf_(hid);
        float o = 0.f;
        for (int k = 0; k < 64; ++k) o += __shfl(hid, k) * w2[k * 64 + lane];
        float* dst = (float*)(P.ws + (kv ? WS_VCMP : WS_KCMP)) + ((size_t)(b * 2 + g) * CMP_PITCH + i) * 64;
        dst[lane] = o;
    }
}
__device__ __forceinline__ void dot4_bf16(const bf16* kp, const f4* qbuf, float (&s)[4]) {
    s[0] = s[1] = s[2] = s[3] = 0.f;
#pragma unroll 1
    for (int c = 0; c < 8; ++c) { const u4 kk = *(const u4*)(kp + c * 8);
#pragma unroll
        for (int j = 0; j < 4; ++j) { const unsigned w = kk[j]; const float k0 = __uint_as_float(w << 16), k1 = __uint_as_float(w & 0xffff0000u);
            const f4 q0 = qbuf[c * 8 + 2 * j], q1 = qbuf[c * 8 + 2 * j + 1];
            s[0] += k0 * q0[0] + k1 * q1[0]; s[1] += k0 * q0[1] + k1 * q1[1]; s[2] += k0 * q0[2] + k1 * q1[2]; s[3] += k0 * q0[3] + k1 * q1[3]; } }
}
__device__ __forceinline__ void dot4_f32(const float* kp, const f4* qbuf, float (&s)[4]) {
    s[0] = s[1] = s[2] = s[3] = 0.f;
#pragma unroll 1
    for (int c = 0; c < 16; ++c) { const f4 kk = *(const f4*)(kp + c * 4);
#pragma unroll
        for (int j = 0; j < 4; ++j) { const f4 q = qbuf[c * 4 + j]; s[0] += kk[j] * q[0]; s[1] += kk[j] * q[1]; s[2] += kk[j] * q[2]; s[3] += kk[j] * q[3]; } }
}
struct OSM { float m[4], l[4], o[4]; };
__device__ __forceinline__ void osm_init(OSM& S) {
#pragma unroll
    for (int h = 0; h < 4; ++h) { S.m[h] = NEG; S.l[h] = 0.f; S.o[h] = 0.f; } }
__device__ __forceinline__ void osm_block(OSM& S, const bf16* PROJ, size_t rowbase, int pos0, bool valid, int t, int kcol, int vcol, const float (&slope)[4], const f4* qbuf, f4* pq, int lane) {
    int pos = pos0 + lane; const int posc = pos < 0 ? 0 : (pos > T - 1 ? T - 1 : pos);
    float s[4]; dot4_bf16(PROJ + (rowbase + posc) * NP + kcol, qbuf, s);
    const float dist = (float)(t - pos);
    float p[4];
#pragma unroll
    for (int h = 0; h < 4; ++h) { const float sc = valid ? (s[h] - slope[h] * dist) : NEG; const float bm = wmax(sc); const float mn = fmaxf(S.m[h], bm);
        const float alpha = __expf(S.m[h] - mn); p[h] = valid ? __expf(sc - mn) : 0.f; S.l[h] = S.l[h] * alpha + wsum(p[h]); S.o[h] *= alpha; S.m[h] = mn; }
    __builtin_amdgcn_wave_barrier(); asm volatile("" ::: "memory");
    pq[lane] = (f4){p[0], p[1], p[2], p[3]};
    __builtin_amdgcn_wave_barrier(); asm volatile("s_waitcnt lgkmcnt(0)" ::: "memory");
    const int pb = pos0 < 0 ? 0 : pos0;
#pragma unroll 4
    for (int k = 0; k < 64; ++k) { int pk = pos0 + k; if (pk < 0) pk = 0; if (pk > T - 1) pk = T - 1; const float v = bf2f(PROJ[(rowbase + pk) * NP + vcol + lane]); const f4 pp = pq[k];
        S.o[0] += pp[0] * v; S.o[1] += pp[1] * v; S.o[2] += pp[2] * v; S.o[3] += pp[3] * v; }
    (void)pb;
    __builtin_amdgcn_wave_barrier(); asm volatile("" ::: "memory");
}

constexpr int ATT_WAVE_LDS = 1024 + 1024 + 8192 + 512;
__device__ __forceinline__ void attn_a_wave(const Params& P, int layer, int tok, int g, unsigned char* wl, int lane) {
    const bf16* PROJ = (const bf16*)(P.ws + WS_PROJ); const float* SMALL = (const float*)(P.ws + WS_SMALL); bf16* MIX = (bf16*)(P.ws + WS_MIX);
    f4* qbuf = (f4*)wl; f4* pq = (f4*)(wl + 1024); float* pbuf = (float*)(wl + 2048); float* valbuf = (float*)(wl + 2048 + 8192);
    const int b = tok / T, t = tok % T; const size_t rowbase = (size_t)b * T;
    const bf16* prow = PROJ + (size_t)tok * NP;
    { f4 qv;
#pragma unroll
      for (int h = 0; h < 4; ++h) qv[h] = bf2f(prow[C_AQ + (g * 4 + h) * 64 + lane]) * 0.125f;
      qbuf[lane] = qv; }
    __builtin_amdgcn_wave_barrier(); asm volatile("s_waitcnt lgkmcnt(0)" ::: "memory");
    float slope[4];
#pragma unroll
    for (int h = 0; h < 4; ++h) slope[h] = exp2f(-(float)(g * 4 + h + 1));
    const int nvis = (t >= 31) ? ((t - 31) / 16 + 1) : 0;
    const float* KC = (const float*)(P.ws + WS_KCMP) + (size_t)(b * 2 + g) * CMP_PITCH * 64;
    const float* VC = (const float*)(P.ws + WS_VCMP) + (size_t)(b * 2 + g) * CMP_PITCH * 64;
    float ocmp[4] = {0.f, 0.f, 0.f, 0.f};
    for (int i = lane; i < 4 * 512; i += 64) pbuf[i] = 0.f;
    __builtin_amdgcn_wave_barrier(); asm volatile("s_waitcnt lgkmcnt(0)" ::: "memory");
    if (nvis > 0) {
        float mx[4] = {NEG, NEG, NEG, NEG};
        for (int i0 = 0; i0 < nvis; i0 += 64) { const int i = i0 + lane;
            if (i < nvis) { float s[4]; dot4_f32(KC + (size_t)i * 64, qbuf, s);
#pragma unroll
                for (int h = 0; h < 4; ++h) { pbuf[h * 512 + i] = s[h]; mx[h] = fmaxf(mx[h], s[h]); } } }
        float sm[4] = {0.f, 0.f, 0.f, 0.f};
#pragma unroll
        for (int h = 0; h < 4; ++h) mx[h] = wmax(mx[h]);
        for (int i0 = 0; i0 < nvis; i0 += 64) { const int i = i0 + lane;
            if (i < nvis) {
#pragma unroll
                for (int h = 0; h < 4; ++h) { const float e = __expf(pbuf[h * 512 + i] - mx[h]); pbuf[h * 512 + i] = e; sm[h] += e; } } }
#pragma unroll
        for (int h = 0; h < 4; ++h) sm[h] = 1.0f / wsum(sm[h]);
        for (int i0 = 0; i0 < nvis; i0 += 64) { const int i = i0 + lane;
            if (i < nvis) {
#pragma unroll
                for (int h = 0; h < 4; ++h) pbuf[h * 512 + i] *= sm[h]; } }
        __builtin_amdgcn_wave_barrier(); asm volatile("s_waitcnt lgkmcnt(0)" ::: "memory");
        for (int i = 0; i < nvis; ++i) { const float v = VC[(size_t)i * 64 + lane];
#pragma unroll
            for (int h = 0; h < 4; ++h) ocmp[h] += pbuf[h * 512 + i] * v; }
    }
    const int cur = t >> 6;
    unsigned long long sel_lo, sel_hi;
    {
        float val[2];
#pragma unroll
        for (int q = 0; q < 2; ++q) { const int j = lane + 64 * q; float imp = 0.f;
#pragma unroll
            for (int h = 0; h < 4; ++h) { const float* pb = pbuf + h * 512 + 4 * j; imp += pb[0] + pb[1] + pb[2] + pb[3]; if (j > 0) imp += pb[-1]; }
            const bool valid = j <= cur; const bool forced = (j == 0) || (valid && j > cur - 2);
            val[q] = forced ? 1.0e4f : (valid ? imp : -1.0f); valbuf[j] = val[q]; }
        __builtin_amdgcn_wave_barrier(); asm volatile("s_waitcnt lgkmcnt(0)" ::: "memory");
        int rank0 = 0, rank1 = 0;
        for (int jj = 0; jj < 128; ++jj) { const float o = valbuf[jj];
            rank0 += (o > val[0] || (o == val[0] && jj < lane)) ? 1 : 0;
            rank1 += (o > val[1] || (o == val[1] && jj < lane + 64)) ? 1 : 0; }
        sel_lo = __ballot(rank0 < 16 && lane <= cur);
        sel_hi = __ballot(rank1 < 16 && (lane + 64) <= cur);
        __builtin_amdgcn_wave_barrier(); asm volatile("" ::: "memory");
    }
    OSM S; osm_init(S);
    for (int q = 0; q < 2; ++q) { unsigned long long mk = q ? sel_hi : sel_lo;
        while (mk) { const int j = __builtin_ctzll(mk) + 64 * q; mk &= mk - 1;
            const int pos0 = j * 64; osm_block(S, PROJ, rowbase, pos0, (pos0 + lane) <= t, t, C_AKS + g * 64, C_AVS + g * 64, slope, qbuf, pq, lane); } }
    float oslc[4];
#pragma unroll
    for (int h = 0; h < 4; ++h) oslc[h] = S.o[h] / S.l[h];
    osm_init(S);
    for (int c = 0; c < 8; ++c) { const int pos0 = t - 511 + 64 * c; if (pos0 + 63 < 0) continue;
        osm_block(S, PROJ, rowbase, pos0, (pos0 + lane) >= 0, t, C_AKW + g * 64, C_AVW + g * 64, slope, qbuf, pq, lane); }
    const float* sm = SMALL + (size_t)tok * 32;
#pragma unroll
    for (int h = 0; h < 4; ++h) { const int hh = g * 4 + h; const float owin = S.o[h] / S.l[h];
        const float g0 = sigmoidf_(sm[S_GATE + hh * 3 + 0]), g1 = sigmoidf_(sm[S_GATE + hh * 3 + 1]), g2 = sigmoidf_(sm[S_GATE + hh * 3 + 2]);
        const float oa = g0 * ocmp[h] + g1 * oslc[h] + g2 * owin; const float z = bf2f(prow[C_AZ + hh * 64 + lane]);
        MIX[(size_t)tok * D + hh * 64 + lane] = (bf16)f2bf(oa * siluf_(z)); }
}
__device__ __forceinline__ void attn_c_wave(const Params& P, int layer, int tok, int g, unsigned char* wl, int lane) {
    const bf16* PROJ = (const bf16*)(P.ws + WS_PROJ); bf16* MIX = (bf16*)(P.ws + WS_MIX);
    f4* qbuf = (f4*)wl; f4* pq = (f4*)(wl + 1024);
    const int b = tok / T, t = tok % T; const size_t rowbase = (size_t)b * T;
    const bf16* prow = PROJ + (size_t)tok * NP;
    { f4 qv;
#pragma unroll
      for (int h = 0; h < 4; ++h) qv[h] = bf2f(prow[C_CQ + (g * 4 + h) * 64 + lane]) * 0.125f;
      qbuf[lane] = qv; }
    __builtin_amdgcn_wave_barrier(); asm volatile("s_waitcnt lgkmcnt(0)" ::: "memory");
    float slope[4];
#pragma unroll
    for (int h = 0; h < 4; ++h) slope[h] = exp2f(-(float)(g * 4 + h + 1));
    OSM S; osm_init(S);
    for (int c = 0; c < 2; ++c) { const int pos0 = t - 127 + 64 * c; if (pos0 + 63 < 0) continue;
        osm_block(S, PROJ, rowbase, pos0, (pos0 + lane) >= 0, t, C_CK + g * 64, C_CV + g * 64, slope, qbuf, pq, lane); }
#pragma unroll
    for (int h = 0; h < 4; ++h) { const int hh = g * 4 + h; const float sk = P.sinks[layer * 8 + hh];
        const float Mx = fmaxf(S.m[h], sk); const float a = __expf(S.m[h] - Mx); const float den = S.l[h] * a + __expf(sk - Mx);
        const float oc = S.o[h] * a / den; const float z = bf2f(prow[C_CZ + hh * 64 + lane]);
        MIX[(size_t)tok * D + 1536 + hh * 64 + lane] = (bf16)f2bf(oc * siluf_(z)); }
}
__device__ __forceinline__ void mlstm_naive(const Params& P, int layer, int w, unsigned char* lds) {
    const bf16* PROJ = (const bf16*)(P.ws + WS_PROJ); const float* SMALL = (const float*)(P.ws + WS_SMALL); bf16* MIX = (bf16*)(P.ws + WS_MIX);
    float* qk = (float*)lds; float* red = (float*)(lds + 65536); float* vbuf = (float*)(lds + 131072); float* gi = (float*)(lds + 131072 + 4096);
    float* glf = gi + 32; float* mbuf = glf + 32; float* dpart = mbuf + 32;
    int tid_ = threadIdx.x; asm volatile("" : "+v"(tid_)); const int tid = tid_, lane = tid & 63, wave = tid >> 6;
    const int bh = w >> 3, b = bh >> 2, h = bh & 3, e0 = (w & 7) * 32;
    const int e = tid & 31, dg = tid >> 5, d0 = dg * 16;
    const int ch = tid;
    const int pcol = (ch < 256) ? (C_BQ + h * 256 + ch) : (C_BK + h * 256 + (ch - 256));
    const int cc = (ch < 256) ? (h * 256 + ch) : (1024 + h * 256 + (ch - 256));
    const float cw0 = P.conv_w[(size_t)layer * 4 * 2048 + 0 * 2048 + cc], cw1 = P.conv_w[(size_t)layer * 4 * 2048 + 1 * 2048 + cc],
                cw2 = P.conv_w[(size_t)layer * 4 * 2048 + 2 * 2048 + cc], cw3 = P.conv_w[(size_t)layer * 4 * 2048 + 3 * 2048 + cc], cb = P.conv_b[layer * 2048 + cc];
    const float oscale = (ch < 256) ? 1.0f : 0.0625f;
    const float ib = P.i_bias[layer * 4 + h], fb = P.f_bias[layer * 4 + h];
    float xm3 = 0.f, xm2 = 0.f, xm1 = 0.f;
    float C[16];
#pragma unroll
    for (int i = 0; i < 16; ++i) C[i] = 0.f;
    float nst = 0.f, mst = 0.f;
    for (int tb = 0; tb < T / 32; ++tb) {
        const size_t row0 = (size_t)b * T + tb * 32;
        for (int tl = 0; tl < 32; ++tl) { const float xc = bf2f(PROJ[(row0 + tl) * NP + pcol]);
            const float y = cb + cw0 * xm3 + cw1 * xm2 + cw2 * xm1 + cw3 * xc; qk[tl * 512 + ch] = siluf_(y) * oscale; xm3 = xm2; xm2 = xm1; xm1 = xc; }
        for (int i = tid; i < 1024; i += 512) { const int tl = i >> 5, ee = i & 31; vbuf[i] = bf2f(PROJ[(row0 + tl) * NP + C_BV + h * 256 + e0 + ee]); }
        if (tid < 32) { gi[tid] = SMALL[(row0 + tid) * 32 + S_I + h] + ib; glf[tid] = logsigmoidf_(SMALL[(row0 + tid) * 32 + S_F + h] + fb); }
        __syncthreads();
        for (int tl = 0; tl < 32; ++tl) {
            const float it = gi[tl], lf = glf[tl]; const float mn = fmaxf(lf + mst, it); const float fdec = __expf(lf + mst - mn), iw = __expf(it - mn); mst = mn;
            const float ve = vbuf[tl * 32 + e] * iw; const float* qp = qk + tl * 512 + d0; const float* kp = qp + 256; float part = 0.f;
#pragma unroll
            for (int i = 0; i < 16; ++i) { C[i] = fdec * C[i] + kp[i] * ve; part += qp[i] * C[i]; }
            red[(tl * 16 + dg) * 32 + e] = part;
            if (tid < 256) { nst = fdec * nst + iw * qk[tl * 512 + 256 + tid]; float dp = qk[tl * 512 + tid] * nst; dp = wsum(dp); if (lane == 0) dpart[tl * 4 + wave] = dp; }
            if (tid == 0) mbuf[tl] = mn;
        }
        __syncthreads();
        for (int i = tid; i < 1024; i += 512) { const int tl = i >> 5, ee = i & 31; float num = 0.f;
#pragma unroll
            for (int g2 = 0; g2 < 16; ++g2) num += red[(tl * 16 + g2) * 32 + ee];
            const float den = (dpart[tl * 4] + dpart[tl * 4 + 1]) + (dpart[tl * 4 + 2] + dpart[tl * 4 + 3]);
            const float hv = num / fmaxf(fabsf(den), __expf(-mbuf[tl]));
            const float og = sigmoidf_(bf2f(PROJ[(row0 + tl) * NP + C_BO + h * 256 + e0 + ee]));
            MIX[(row0 + tl) * D + 512 + h * 256 + e0 + ee] = (bf16)f2bf(og * hv); }
        __syncthreads();
    }
}
__device__ __forceinline__ void phase_headnorm(const Params& P, int layer, int gw, int NGW, int lane) {
    const bf16* PROJ = (const bf16*)(P.ws + WS_PROJ); bf16* MIX = (bf16*)(P.ws + WS_MIX);
    for (int it = gw; it < M * 4; it += NGW) { const int tok = it >> 2, h = it & 3;
        unsigned long long* mp = (unsigned long long*)(MIX + (size_t)tok * D + 512 + h * 256) + lane; const unsigned long long w = *mp;
        float v[4] = {bf2f((unsigned short)(w & 0xffff)), bf2f((unsigned short)((w >> 16) & 0xffff)), bf2f((unsigned short)((w >> 32) & 0xffff)), bf2f((unsigned short)(w >> 48))};
        float s = (v[0] * v[0] + v[1] * v[1]) + (v[2] * v[2] + v[3] * v[3]); s = wsum(s);
        const float rstd = 1.0f / sqrtf(s * (1.0f / 256.0f) + EPS);
        const unsigned long long zw = *((const unsigned long long*)(PROJ + (size_t)tok * NP + C_BZ + h * 256) + lane);
        const f4 gg = *((const f4*)(P.mnorm_g + layer * 1024 + h * 256) + lane);
        float o[4];
#pragma unroll
        for (int j = 0; j < 4; ++j) { const float z = bf2f((unsigned short)((zw >> (16 * j)) & 0xffff)); o[j] = v[j] * rstd * gg[j] * siluf_(z); }
        *mp = (unsigned long long)pk2(o[0], o[1]) | ((unsigned long long)pk2(o[2], o[3]) << 32); }
}
__device__ __forceinline__ void phase_final(const Params& P, int gw, int NGW, int lane) {
    const float* SSQ = (const float*)(P.ws + WS_SSQ);
    for (int m = gw; m < M; m += NGW) { float s = (lane < 32) ? SSQ[(size_t)m * 32 + lane] : 0.f; s = wsum(s);
        const float rstd = 1.0f / sqrtf(s * (1.0f / 2048.0f) + EPS);
        f4* xr = (f4*)(P.out + (size_t)m * D) + lane; const f4* gr = (const f4*)P.final_g + lane;
#pragma unroll
        for (int j = 0; j < 8; ++j) { f4 v = xr[64 * j]; const f4 gg = gr[64 * j]; v = v * rstd * gg; xr[64 * j] = v; } }
}
__global__ void __launch_bounds__(512, 2) hymba_fwd(Params P) {
    extern __shared__ __attribute__((aligned(16))) unsigned char lds[];
    cg::grid_group grid = cg::this_grid();
    const int G = gridDim.x, NGW = G * 8;
#define PH_IDS() int tid = threadIdx.x; asm volatile("" : "+v"(tid)); const int lane = tid & 63, wave = __builtin_amdgcn_readfirstlane(tid >> 6), gw = blockIdx.x * 8 + wave; (void)lane; (void)gw;
    pg8::bf16_t* WIN = (pg8::bf16_t*)(P.ws + WS_WIN); pg8::bf16_t* WOUT = (pg8::bf16_t*)(P.ws + WS_WOUT); pg8::bf16_t* XB = (pg8::bf16_t*)(P.ws + WS_XB);
    pg8::bf16_t* PROJ = (pg8::bf16_t*)(P.ws + WS_PROJ); pg8::bf16_t* MIX = (pg8::bf16_t*)(P.ws + WS_MIX);
    float* SMALL = (float*)(P.ws + WS_SMALL); float* SSQ = (float*)(P.ws + WS_SSQ);
    { PH_IDS(); phase_prologue(P, lds, gw, NGW, wave, lane); }
    grid.sync();
    for (int layer = 0; layer < 2; ++layer) {
        {
            pg8::Gemm g{XB, WIN + (size_t)layer * NP * D, M, NP, D}; pg8::StaticOrder S; S.init(M, NP, G, (int)blockIdx.x);
            pg8::EpiProj E{PROJ, NP, SSQ, SMALL};
            pg8::gemm_phase<pg8::EpiProj, pg8::StaticOrder, true, true>((PG8_LAS unsigned char*)lds, g, S, E);
        }
        grid.sync();
        { PH_IDS(); phase_compress(P, layer, gw, NGW, lane); }
        grid.sync();
        if (blockIdx.x < 64) mlstm_naive(P, layer, blockIdx.x, lds);
        else { PH_IDS();
            const int aw = (blockIdx.x - 64) * 8 + wave, NAW = (G - 64) * 8; unsigned char* wl = lds + wave * ATT_WAVE_LDS;
            for (int it = aw; it < 2 * M; it += NAW) attn_a_wave(P, layer, it >> 1, it & 1, wl, lane);
            for (int it = aw; it < 2 * M; it += NAW) attn_c_wave(P, layer, it >> 1, it & 1, wl, lane);
        }
        grid.sync();
        { PH_IDS(); phase_headnorm(P, layer, gw, NGW, lane); }
        grid.sync();
        {
            pg8::Gemm g{MIX, WOUT + (size_t)layer * D * D, M, D, D}; pg8::StaticOrder S; S.init(M, D, G, (int)blockIdx.x);
            pg8::EpiOut E{layer == 0 ? P.x : P.out, P.out, XB, SSQ, D};
            pg8::gemm_phase<pg8::EpiOut, pg8::StaticOrder, true, true>((PG8_LAS unsigned char*)lds, g, S, E);
        }
        grid.sync();
    }
    { PH_IDS(); phase_final(P, gw, NGW, lane); }
}

extern "C" void kernel_launch(void* const* d_in, const int* in_sizes, int n_in, void* d_out, int out_size, void* d_ws, size_t ws_size, hipStream_t stream) {
    static int grid = 0;
    if (grid == 0) {
        if (n_in != 17 || out_size != M * D || ws_size < WS_END) { fprintf(stderr, "kernel_launch: unexpected shapes (n_in %d out %d ws %zu)\n", n_in, out_size, ws_size); grid = -1; return; }
        int dev = 0, cus = 0, per_cu = 0;
        (void)hipGetDevice(&dev); (void)hipDeviceGetAttribute(&cus, hipDeviceAttributeMultiprocessorCount, dev);
        (void)hipFuncSetAttribute((const void*)hymba_fwd, hipFuncAttributeMaxDynamicSharedMemorySize, LDS_BYTES);
        (void)hipOccupancyMaxActiveBlocksPerMultiprocessor(&per_cu, (const void*)hymba_fwd, 512, LDS_BYTES);
        if (per_cu < 1) { fprintf(stderr, "kernel_launch: occupancy query reports %d blocks per CU\n", per_cu); grid = -1; return; }
        grid = cus;
    }
    if (grid < 0) return;
    Params p{};
    p.x = (const float*)d_in[0]; p.norm_g = (const float*)d_in[1]; p.w_in = (const float*)d_in[2]; p.w_out = (const float*)d_in[3];
    p.pe_k = (const float*)d_in[4]; p.w1_k = (const float*)d_in[5]; p.w2_k = (const float*)d_in[6]; p.pe_v = (const float*)d_in[7]; p.w1_v = (const float*)d_in[8]; p.w2_v = (const float*)d_in[9];
    p.conv_w = (const float*)d_in[10]; p.conv_b = (const float*)d_in[11]; p.i_bias = (const float*)d_in[12]; p.f_bias = (const float*)d_in[13]; p.mnorm_g = (const float*)d_in[14];
    p.sinks = (const float*)d_in[15]; p.final_g = (const float*)d_in[16]; p.out = (float*)d_out; p.ws = (unsigned char*)d_ws;
    void* args[] = {&p};
    hipError_t e = hipLaunchCooperativeKernel((const void*)hymba_fwd, dim3(grid), dim3(512), args, LDS_BYTES, stream);
    if (e != hipSuccess) fprintf(stderr, "kernel_launch: cooperative launch failed: %s (grid %d)\n", hipGetErrorString(e), grid);
}
```

```cpp
#include <hip/hip_runtime.h>
#include <hip/hip_cooperative_groups.h>
#include <cstdio>
#include <cstdint>
namespace cg = cooperative_groups;
namespace pg8 {
#define PG8_LAS __attribute__((address_space(3)))
typedef unsigned short bf16_t;
typedef short bf16x8 __attribute__((ext_vector_type(8)));
typedef float f32x4 __attribute__((ext_vector_type(4)));
typedef unsigned u32x4 __attribute__((ext_vector_type(4)));
constexpr int BM = 256, BK = 64, HALF = 128, HTB = HALF * BK * 2  , STAGE_BYTES = 8 * HTB, NXCD = 8, WGM = 8;

__host__ __device__ __forceinline__ int lds_byte(int r, int c) { const int st = (r >> 4) * 2 + (c >> 5), rr = r & 15, cc = c & 31, ob = rr * 64 + cc * 2; return st * 1024 + (ob ^ (((ob >> 9) & 1) << 5)); }
__host__ __device__ __forceinline__ void stage_rc(int b, int& R, int& C) { const int st = b / 1024, sb = b % 1024, swz = sb ^ (((sb >> 9) & 1) << 5); R = (st >> 1) * 16 + swz / 64; C = (st & 1) * 32 + (swz % 64) / 2; }
__host__ __device__ __forceinline__ int perm32(int rho) { const int n = rho >> 4, i = rho & 15; return 8 * (i >> 2) + 4 * n + (i & 3); }

struct Unit { int pm, pn; };
struct Gemm { const bf16_t* A; const bf16_t* Bt; int M, N, K; };

struct StaticOrder {
    int nM, nN, nwg, G, c;
    __host__ __device__ void init(int M, int N, int G_, int c_) { nM = M / BM; nN = N / BM; nwg = nM * nN; G = G_; c = c_; }
    __host__ __device__ bool next(int i, Unit& u) const {
        const long L = (long)i * G + c; if (L >= nwg) return false;
        int wgid = (int)L; { const int q = nwg / NXCD, r = nwg % NXCD, xcd = wgid % NXCD, off = wgid / NXCD; wgid = (xcd < r ? xcd * (q + 1) : r * (q + 1) + (xcd - r) * q) + off; }
        const int nig = WGM * nN, gid = wgid / nig, fm = gid * WGM, gsz = (nM - fm) < WGM ? (nM - fm) : WGM;
        u.pm = fm + ((wgid % nig) % gsz); u.pn = (wgid % nig) / gsz; return true;
    }
    __device__ __forceinline__ void a_ready(const Unit&) const {}
    __device__ __forceinline__ void done(const Unit&) const {}
};

__device__ __forceinline__ unsigned cvt_pk_bf16(float lo, float hi) { unsigned r; asm volatile("v_cvt_pk_bf16_f32 %0, %1, %2" : "=v"(r) : "v"(lo), "v"(hi)); return r; }
typedef float f32x2 __attribute__((ext_vector_type(2)));
struct EpiProj {
    static constexpr bool PERM = true, AFTER_DRAIN = false;
    bf16_t* O; int ldc; const float* ssq; float* small_;
    __device__ __forceinline__ void operator()(const f32x4 (&acc)[2][2][4][2], const Unit& u, int wr, int wc, int fr, int fq) const {
        const int row0 = u.pm * BM + wr * 64 + fr;
#pragma unroll
        for (int ai = 0; ai < 2; ++ai)
#pragma unroll
            for (int m = 0; m < 4; ++m) {
                const int row = row0 + ai * HALF + m * 16;
                const f32x4* sp = (const f32x4*)(ssq + (size_t)row * 32);
                f32x4 s4 = sp[0];
#pragma unroll
                for (int j = 1; j < 8; ++j) s4 += sp[j];
                const float rstd = 1.0f / sqrtf(((s4[0] + s4[1]) + (s4[2] + s4[3])) * (1.0f / 2048.0f) + 1.0e-6f);
                if (u.pn < 32) {
                    bf16_t* rowp = O + (size_t)row * ldc + u.pn * BM + wc * 32 + 8 * fq;
#pragma unroll
                    for (int bj = 0; bj < 2; ++bj) { const f32x4 v0 = acc[ai][bj][m][0] * rstd, v1 = acc[ai][bj][m][1] * rstd;
                        u32x4 w; w.x = cvt_pk_bf16(v0[0], v0[1]); w.y = cvt_pk_bf16(v0[2], v0[3]); w.z = cvt_pk_bf16(v1[0], v1[1]); w.w = cvt_pk_bf16(v1[2], v1[3]);
                        *(u32x4*)(rowp + bj * HALF) = w; }
                } else if (wc == 0) {
                    float* sp2 = small_ + (size_t)row * 32 + 8 * fq;
                    *(f32x4*)(sp2) = acc[ai][0][m][0] * rstd; *(f32x4*)(sp2 + 4) = acc[ai][0][m][1] * rstd;
                }
            }
    }
};
struct EpiOut {
    static constexpr bool PERM = false, AFTER_DRAIN = false;
    const float* xin; float* xout; bf16_t* xb; float* ssq; int ldc;
    __device__ __forceinline__ void operator()(const f32x4 (&acc)[2][2][4][2], const Unit& u, int wr, int wc, int fr, int fq) const {
        const int row0 = u.pm * BM + wr * 64 + fr, col0 = u.pn * BM + wc * 32 + 4 * fq;
#pragma unroll
        for (int ai = 0; ai < 2; ++ai)
#pragma unroll
            for (int m = 0; m < 4; ++m) {
                const int row = row0 + ai * HALF + m * 16; const size_t off = (size_t)row * ldc + col0; float s = 0.f;
#pragma unroll
                for (int bj = 0; bj < 2; ++bj)
#pragma unroll
                    for (int n = 0; n < 2; ++n) { const size_t o2 = off + bj * HALF + n * 16; const f32x4 v = *(const f32x4*)(xin + o2) + acc[ai][bj][m][n];
                        *(f32x4*)(xout + o2) = v; unsigned w0 = cvt_pk_bf16(v[0], v[1]), w1 = cvt_pk_bf16(v[2], v[3]);
                        *(unsigned long long*)(xb + o2) = (unsigned long long)w0 | ((unsigned long long)w1 << 32);
                        s += (v[0] * v[0] + v[1] * v[1]) + (v[2] * v[2] + v[3] * v[3]); }
                s += __shfl_xor(s, 16); s += __shfl_xor(s, 32);
                if (fq == 0) ssq[(size_t)row * 32 + u.pn * 4 + wc] = s;
            }
    }
};
template <class Epi, class Sched, bool ALIGN_EPI = false, bool SP2 = false>
__device__ __forceinline__ void gemm_phase(PG8_LAS unsigned char* lds, const Gemm g, const Sched& S, const Epi& E) {
    int tid_ = threadIdx.x; asm volatile("" : "+v"(tid_)); const int tid = tid_, wid = __builtin_amdgcn_readfirstlane(tid >> 6), lane = tid & 63, wr = wid >> 2, wc = wid & 3, fr = lane & 15, fq = lane >> 4;
    const int K = g.K, nt = K / BK;
    unsigned voffA[2], voffB[2];
#pragma unroll
    for (int i = 0; i < 2; ++i) { int R, C; stage_rc(tid * 16 + i * 8192, R, C); const int Rb = Epi::PERM ? ((R & ~31) + perm32(R & 31)) : R;
        voffA[i] = (unsigned)(R * K + C) * 2u; voffB[i] = (unsigned)(Rb * K + C) * 2u; }
    const size_t kstep = (size_t)(BK * 2);
    const size_t hstep = (size_t)HALF * K * 2;
    const size_t tstep = 2 * hstep;
    const unsigned ldsw = (unsigned)wid * 1024u;
    const int aoff = lds_byte(wr * 64 + fr, fq * 8), boff = lds_byte(wc * 32 + fr, fq * 8);
#define PG8_SA(b, h) (((b) * 2 + (h)) * HTB)
#define PG8_SB(b, h) ((4 + (b) * 2 + (h)) * HTB)
#define PG8_STAGE(bufoff, gbase, voff) do { _Pragma("unroll") for (int _i = 0; _i < 2; ++_i) \
        __builtin_amdgcn_global_load_lds((const unsigned*)((const char*)(gbase) + (voff)[_i]), (PG8_LAS unsigned*)(lds + (bufoff) + ldsw + _i * 8192), 16, 0, 0); } while (0)
#define PG8_LDA(dst, b, h) do { _Pragma("unroll") for (int m = 0; m < 4; ++m) _Pragma("unroll") for (int k = 0; k < 2; ++k) dst[m][k] = *(const PG8_LAS bf16x8*)(lds + PG8_SA(b, h) + aoff + m * 2048 + k * 1024); } while (0)
#define PG8_LDB(dst, b, h) do { _Pragma("unroll") for (int n = 0; n < 2; ++n) _Pragma("unroll") for (int k = 0; k < 2; ++k) dst[n][k] = *(const PG8_LAS bf16x8*)(lds + PG8_SB(b, h) + boff + n * 2048 + k * 1024); } while (0)
#define PG8_MMA(ai, bj, At, Bt) do { __builtin_amdgcn_s_setprio(1); _Pragma("unroll") for (int m = 0; m < 4; ++m) _Pragma("unroll") for (int n = 0; n < 2; ++n) _Pragma("unroll") for (int k = 0; k < 2; ++k) \
        acc[ai][bj][m][n] = __builtin_amdgcn_mfma_f32_16x16x32_bf16(Bt[n][k], At[m][k], acc[ai][bj][m][n], 0, 0, 0); __builtin_amdgcn_s_setprio(0); } while (0)
#define PG8_WAIT_V(n) asm volatile("s_waitcnt vmcnt(" #n ")" ::: "memory")
#define PG8_WAIT_L(n) asm volatile("s_waitcnt lgkmcnt(" #n ")" ::: "memory")
#define PG8_BAR __builtin_amdgcn_s_barrier()
#define PG8_SCHED __builtin_amdgcn_sched_barrier(0)
    Unit cur, nxt; int ui = 0;
    if (!S.next(0, cur)) return;
    f32x4 acc[2][2][4][2];
#pragma unroll
    for (int a = 0; a < 2; ++a)
#pragma unroll
        for (int b = 0; b < 2; ++b)
#pragma unroll
            for (int m = 0; m < 4; ++m)
#pragma unroll
                for (int n = 0; n < 2; ++n) acc[a][b][m][n] = (f32x4){0.f, 0.f, 0.f, 0.f};
    bf16x8 At[4][2], B0[2][2], B1[2][2];
    const char* cA = (const char*)g.A + (size_t)cur.pm * tstep; const char* cB = (const char*)g.Bt + (size_t)cur.pn * tstep;
    S.a_ready(cur);
    if constexpr (SP2) {
        PG8_STAGE(PG8_SB(0, 0), cB, voffB); PG8_STAGE(PG8_SB(0, 1), cB + hstep, voffB); PG8_STAGE(PG8_SA(0, 0), cA, voffA); PG8_STAGE(PG8_SA(0, 1), cA + hstep, voffA);
        if (wr == 1) PG8_BAR;
        PG8_WAIT_V(2); PG8_BAR;
        PG8_STAGE(PG8_SB(1, 0), cB + kstep, voffB); PG8_STAGE(PG8_SA(1, 0), cA + kstep, voffA); PG8_STAGE(PG8_SB(1, 1), cB + hstep + kstep, voffB);
        PG8_WAIT_V(6); PG8_BAR;
    } else {
        PG8_STAGE(PG8_SB(0, 0), cB, voffB); PG8_STAGE(PG8_SA(0, 0), cA, voffA); PG8_STAGE(PG8_SB(0, 1), cB + hstep, voffB); PG8_STAGE(PG8_SA(0, 1), cA + hstep, voffA);
        if (wr == 1) PG8_BAR;
        PG8_WAIT_V(4); PG8_BAR;
        PG8_STAGE(PG8_SB(1, 0), cB + kstep, voffB); PG8_STAGE(PG8_SA(1, 0), cA + kstep, voffA); PG8_STAGE(PG8_SB(1, 1), cB + hstep + kstep, voffB);
        PG8_WAIT_V(6); PG8_BAR;
    }
    for (;;) {
        const bool has_next = S.next(ui + 1, nxt);
        const char* nA = has_next ? (const char*)g.A + (size_t)nxt.pm * tstep : cA; const char* nB = has_next ? (const char*)g.Bt + (size_t)nxt.pn * tstep : cB;
        for (int t = 0; t < nt; t += 2) {
            const bool last = (t == nt - 2);
            const char* a1 = cA + (size_t)(t + 1) * kstep;
            const char* a2 = last ? nA : cA + (size_t)(t + 2) * kstep; const char* b2 = last ? nB : cB + (size_t)(t + 2) * kstep;
            const char* a3 = a2 + kstep; const char* b3 = b2 + kstep;
            if (last && has_next) S.a_ready(nxt);
            if constexpr (SP2) {
            PG8_LDB(B0, 0, 0); PG8_LDB(B1, 0, 1); PG8_SCHED; PG8_LDA(At, 0, 0); PG8_STAGE(PG8_SA(1, 1), a1 + hstep, voffA);
            PG8_WAIT_V(8); PG8_WAIT_L(0); PG8_BAR; PG8_MMA(0, 0, At, B0); PG8_MMA(0, 1, At, B1); PG8_BAR; PG8_SCHED;
            PG8_LDA(At, 0, 1); PG8_STAGE(PG8_SB(0, 0), b2, voffB); PG8_STAGE(PG8_SB(0, 1), b2 + hstep, voffB); PG8_STAGE(PG8_SA(0, 0), a2, voffA);
            PG8_WAIT_V(8); PG8_WAIT_L(0); PG8_BAR; PG8_MMA(1, 0, At, B0); PG8_MMA(1, 1, At, B1); PG8_BAR; PG8_SCHED;
            PG8_LDB(B0, 1, 0); PG8_LDB(B1, 1, 1); PG8_SCHED; PG8_LDA(At, 1, 0); PG8_STAGE(PG8_SA(0, 1), a2 + hstep, voffA);
            PG8_WAIT_V(8); PG8_WAIT_L(0); PG8_BAR; PG8_MMA(0, 0, At, B0); PG8_MMA(0, 1, At, B1); PG8_BAR; PG8_SCHED;
            PG8_LDA(At, 1, 1); PG8_STAGE(PG8_SB(1, 0), b3, voffB); PG8_STAGE(PG8_SB(1, 1), b3 + hstep, voffB); PG8_STAGE(PG8_SA(1, 0), a3, voffA);
            PG8_WAIT_V(8); PG8_WAIT_L(0); PG8_BAR; PG8_MMA(1, 0, At, B0); PG8_MMA(1, 1, At, B1); PG8_BAR; PG8_SCHED;
            } else {
            PG8_LDB(B0, 0, 0); PG8_SCHED; PG8_LDA(At, 0, 0); PG8_STAGE(PG8_SA(1, 1), a1 + hstep, voffA);
            PG8_WAIT_L(8); PG8_BAR; PG8_WAIT_L(0); PG8_MMA(0, 0, At, B0); PG8_BAR; PG8_SCHED;
            PG8_LDB(B1, 0, 1); PG8_STAGE(PG8_SB(0, 0), b2, voffB);
            PG8_BAR; PG8_WAIT_L(0); PG8_MMA(0, 1, At, B1); PG8_BAR;
            PG8_LDA(At, 0, 1); PG8_STAGE(PG8_SA(0, 0), a2, voffA);
            PG8_BAR; PG8_WAIT_L(0); PG8_MMA(1, 0, At, B0); PG8_BAR; PG8_SCHED;
            PG8_STAGE(PG8_SB(0, 1), b2 + hstep, voffB);
            PG8_WAIT_V(6); PG8_BAR; PG8_MMA(1, 1, At, B1); PG8_BAR;
            PG8_LDB(B0, 1, 0); PG8_SCHED; PG8_LDA(At, 1, 0); PG8_STAGE(PG8_SA(0, 1), a2 + hstep, voffA);
            PG8_WAIT_L(8); PG8_BAR; PG8_WAIT_L(0); PG8_MMA(0, 0, At, B0); PG8_BAR; PG8_SCHED;
            PG8_LDB(B1, 1, 1); PG8_STAGE(PG8_SB(1, 0), b3, voffB);
            PG8_BAR; PG8_WAIT_L(0); PG8_MMA(0, 1, At, B1); PG8_BAR;
            PG8_LDA(At, 1, 1); PG8_STAGE(PG8_SA(1, 0), a3, voffA);
            PG8_BAR; PG8_WAIT_L(0); PG8_MMA(1, 0, At, B0); PG8_BAR; PG8_SCHED;
            PG8_STAGE(PG8_SB(1, 1), b3 + hstep, voffB);
            PG8_WAIT_V(6); PG8_BAR; PG8_MMA(1, 1, At, B1); PG8_BAR;
            }
        }
        if constexpr (ALIGN_EPI) { if (wr == 0) PG8_BAR; }
        if constexpr (!Epi::AFTER_DRAIN) { E(acc, cur, wr, wc, fr, fq); S.done(cur); }
        if (!has_next) break;
#pragma unroll
        for (int a = 0; a < 2; ++a)
#pragma unroll
            for (int b = 0; b < 2; ++b)
#pragma unroll
                for (int m = 0; m < 4; ++m)
#pragma unroll
                    for (int n = 0; n < 2; ++n) acc[a][b][m][n] = (f32x4){0.f, 0.f, 0.f, 0.f};
        cur = nxt; cA = nA; cB = nB; ++ui;
        if constexpr (ALIGN_EPI) { if (wr == 1) PG8_BAR; }
    }
    PG8_WAIT_V(0);
    if constexpr (!ALIGN_EPI) { if (wr == 0) PG8_BAR; }
    PG8_BAR;
    if constexpr (Epi::AFTER_DRAIN) { E.fused(acc, cur, wr, wc, fr, fq, lds, wid, lane); S.done(cur); }
#undef PG8_SA
#undef PG8_SB
#undef PG8_STAGE
#undef PG8_LDA
#undef PG8_LDB
#undef PG8_MMA
#undef PG8_WAIT_V
#undef PG8_WAIT_L
#undef PG8_BAR
#undef PG8_SCHED
}
}
constexpr int BATCH = 2, T = 8192, M = BATCH * T, D = 2048, NP = 8448, NIN = 8224;
constexpr int C_AQ = 0, C_AKC = 512, C_AVC = 640, C_AKS = 768, C_AVS = 896, C_AKW = 1024, C_AVW = 1152, C_AZ = 1280, C_BQ = 1792, C_BK = 2816, C_BV = 3840, C_BO = 4864, C_BZ = 5888,
              C_CQ = 6912, C_CK = 7424, C_CV = 7552, C_CZ = 7680;
constexpr int S_GATE = 0, S_I = 24, S_F = 28;
constexpr int NCMP = 511, CMP_PITCH = 512;
constexpr float EPS = 1.0e-6f, NEG = -1.0e30f;
constexpr size_t MiB = 1u << 20;
constexpr size_t WS_WIN = 0, WS_WOUT = 66 * MiB, WS_XB = 82 * MiB, WS_PROJ = 146 * MiB, WS_MIX = 410 * MiB, WS_SMALL = 474 * MiB, WS_SSQ = 476 * MiB, WS_KCMP = 478 * MiB, WS_VCMP = WS_KCMP + 512 * 1024, WS_END = 512 * MiB;
constexpr int LDS_BYTES = 147456;
typedef unsigned short bf16;
typedef float f4 __attribute__((ext_vector_type(4)));
typedef unsigned u4 __attribute__((ext_vector_type(4)));

__device__ __forceinline__ float bf2f(unsigned short u) { return __uint_as_float(((unsigned)u) << 16); }
__device__ __forceinline__ unsigned f2bf(float f) { unsigned u = __float_as_uint(f); return (u + 0x7fffu + ((u >> 16) & 1u)) >> 16; }
__device__ __forceinline__ unsigned pk2(float lo, float hi) { return f2bf(lo) | (f2bf(hi) << 16); }
__device__ __forceinline__ float wsum(float v) {
#pragma unroll
    for (int o = 1; o < 64; o <<= 1) v += __shfl_xor(v, o);
    return v; }
__device__ __forceinline__ float wmax(float v) {
#pragma unroll
    for (int o = 1; o < 64; o <<= 1) v = fmaxf(v, __shfl_xor(v, o));
    return v; }
__device__ __forceinline__ float sigmoidf_(float x) { return 1.0f / (1.0f + __expf(-x)); }
__device__ __forceinline__ float siluf_(float x) { return x / (1.0f + __expf(-x)); }
__device__ __forceinline__ float logsigmoidf_(float x) { return fminf(x, 0.f) - log1pf(__expf(-fabsf(x))); }

struct Params {
    const float* x; const float* norm_g; const float* w_in; const float* w_out;
    const float* pe_k; const float* w1_k; const float* w2_k; const float* pe_v; const float* w1_v; const float* w2_v;
    const float* conv_w; const float* conv_b; const float* i_bias; const float* f_bias; const float* mnorm_g; const float* sinks; const float* final_g;
    float* out; unsigned char* ws;
};

__device__ __forceinline__ int orig_col(int n) {
    if (n < 1280) return n;
    if (n < 4864) return n + 24;
    if (n < 8192) return n + 32;
    if (n < 8216) return 1280 + (n - 8192);
    if (n < 8224) return 4888 + (n - 8216);
    return -1;
}

__device__ __forceinline__ void transpose_item(const float* W, int K, int Nsrc, bool mapped, const float* g, bf16* WT, int nblk, float* scr, int item, int lane) {
    const int kb = item / nblk, nb = item % nblk, k0 = 64 * kb, n0 = 32 * nb;
    const int n = n0 + (lane & 31); const int oc = mapped ? orig_col(n) : n;
#pragma unroll 8
    for (int i = 0; i < 32; ++i) { const int kk = 2 * i + (lane >> 5); float v = 0.f;
        if (oc >= 0) { v = W[(size_t)(k0 + kk) * Nsrc + oc]; if (g) v *= g[k0 + kk]; }
        scr[kk * 33 + (lane & 31)] = v; }
    __builtin_amdgcn_wave_barrier(); asm volatile("s_waitcnt lgkmcnt(0)" ::: "memory");
    const int c = lane & 7;
#pragma unroll
    for (int j = 0; j < 4; ++j) { const int nn = (lane >> 3) + 8 * j; const float* s = scr + (8 * c) * 33 + nn;
        u4 o; o.x = pk2(s[0 * 33], s[1 * 33]); o.y = pk2(s[2 * 33], s[3 * 33]); o.z = pk2(s[4 * 33], s[5 * 33]); o.w = pk2(s[6 * 33], s[7 * 33]);
        *(u4*)(WT + (size_t)(n0 + nn) * K + k0 + 8 * c) = o; }
    __builtin_amdgcn_wave_barrier(); asm volatile("s_waitcnt lgkmcnt(0)" ::: "memory");
}
__device__ __forceinline__ void phase_prologue(const Params& P, unsigned char* lds, int gw, int NGW, int wave, int lane) {
    float* scr = (float*)(lds + wave * 16384);
    bf16* WIN = (bf16*)(P.ws + WS_WIN); bf16* WOUT = (bf16*)(P.ws + WS_WOUT);
    constexpr int I_IN = (D / 64) * (NP / 32), I_OUT = (D / 64) * (D / 32), NITEMS = 2 * I_IN + 2 * I_OUT;
    for (int it = gw; it < NITEMS; it += NGW) {
        int r = it;
        if (r < 2 * I_IN) { const int l = r / I_IN; r -= l * I_IN;
            transpose_item(P.w_in + (size_t)l * D * NIN, D, NIN, true, P.norm_g + l * D, WIN + (size_t)l * NP * D, NP / 32, scr, r, lane); continue; }
        r -= 2 * I_IN; { const int l = r / I_OUT; r -= l * I_OUT;
            transpose_item(P.w_out + (size_t)l * D * D, D, D, false, nullptr, WOUT + (size_t)l * D * D, D / 32, scr, r, lane); }
    }
    bf16* XB = (bf16*)(P.ws + WS_XB); float* SSQ = (float*)(P.ws + WS_SSQ);
    for (int m = gw; m < M; m += NGW) {
        const f4* xr = (const f4*)(P.x + (size_t)m * D) + lane; unsigned long long* o8 = (unsigned long long*)(XB + (size_t)m * D) + lane; float s = 0.f;
#pragma unroll
        for (int j = 0; j < 8; ++j) { const f4 v = xr[64 * j]; s += (v[0] * v[0] + v[1] * v[1]) + (v[2] * v[2] + v[3] * v[3]);
            o8[64 * j] = (unsigned long long)pk2(v[0], v[1]) | ((unsigned long long)pk2(v[2], v[3]) << 32); }
        s = wsum(s);
        if (lane < 32) SSQ[(size_t)m * 32 + lane] = (lane == 0) ? s : 0.f;
    }
}

__device__ __forceinline__ void phase_compress(const Params& P, int layer, int gw, int NGW, int lane) {
    const bf16* PROJ = (const bf16*)(P.ws + WS_PROJ); bf16* KC = (bf16*)(P.ws + WS_KCMP);
    for (int it = gw; it < 2 * 2 * 2 * CMP_PITCH; it += NGW) {
        const int i = it % CMP_PITCH; int r = it / CMP_PITCH; const int g = r & 1; r >>= 1; const int b = r & 1; const int kv = r >> 1;
        bf16* dst = KC + ((size_t)(b * 2 + g) * CMP_PITCH + i) * 128 + kv * 64;
        if (i >= NCMP) { dst[lane] = 0; continue; }
        const float* pe = (kv ? P.pe_v : P.pe_k) + (size_t)layer * 32 * 64;
        const float* w1 = (kv ? P.w1_v : P.w1_k) + (size_t)layer * 2048 * 64;
        const float* w2 = (kv ? P.w2_v : P.w2_k) + (size_t)layer * 64 * 64;
        const bf16* src = PROJ + (size_t)(b * T + 16 * i) * NP + (kv ? C_AVC : C_AKC) + g * 64;
        float hid = 0.f;
        for (int l = 0; l < 32; ++l) {
            const bf16* row = src + (size_t)l * NP;
#pragma unroll 8
            for (int dd = 0; dd < 64; ++dd) { const float a = bf2f(row[dd]) + pe[l * 64 + dd]; hid += a * w1[(size_t)(l * 64 + dd) * 64 + lane]; }
        }
        hid = siluf_(hid);
        float o = 0.f;
        for (int k = 0; k < 64; ++k) o += __shfl(hid, k) * w2[k * 64 + lane];
        dst[lane] = (bf16)f2bf(o);
    }
}
namespace at2 {
typedef short bf16x8 __attribute__((ext_vector_type(8)));
typedef short s16x4 __attribute__((ext_vector_type(4)));
typedef float f32x16 __attribute__((ext_vector_type(16)));
typedef float f32x2_t __attribute__((ext_vector_type(2))); typedef __bf16 bf16x2_t __attribute__((ext_vector_type(2)));
typedef __attribute__((address_space(3))) const char* lds_cptr;
typedef short v4i16_t __attribute__((ext_vector_type(4)));
constexpr float C2 = 0.125f * 1.4426950408889634f;
constexpr float LOG2E = 1.4426950408889634f;
constexpr int L_KV = 0, L_IMP = 32768, L_SEL = 65536, L_WSF = 66560, L_GT = 67584, L_ACC = 70656, L_END = 136192;
__device__ __forceinline__ int crow(int r, int hi) { return (r & 3) + 8 * (r >> 2) + 4 * hi; }
__device__ __forceinline__ unsigned cvtpk(float lo, float hi) { f32x2_t v = {lo, hi}; bf16x2_t b = __builtin_convertvector(v, bf16x2_t); return __builtin_bit_cast(unsigned, b); }
__device__ __forceinline__ s16x4 vtr(lds_cptr p) { return __builtin_bit_cast(s16x4, __builtin_amdgcn_ds_read_tr16_b64_v4i16((__attribute__((address_space(3))) v4i16_t*)p)); }
__device__ __forceinline__ float swapmax(float m) { auto rr = __builtin_amdgcn_permlane32_swap(__float_as_uint(m), __float_as_uint(m), false, false); return fmaxf(__uint_as_float(rr[0]), __uint_as_float(rr[1])); }
__device__ __forceinline__ float swapsum(float m) { auto rr = __builtin_amdgcn_permlane32_swap(__float_as_uint(m), __float_as_uint(m), false, false); return __uint_as_float(rr[0]) + __uint_as_float(rr[1]); }
__device__ __forceinline__ float quadsum(float v) {
    v += __uint_as_float(__builtin_amdgcn_update_dpp(0u, __float_as_uint(v), 0xB1, 0xF, 0xF, true));
    v += __uint_as_float(__builtin_amdgcn_update_dpp(0u, __float_as_uint(v), 0x4E, 0xF, 0xF, true));
    return v; }

struct KVRegs { u4 k, v; };
__device__ __forceinline__ void kv_load(KVRegs& R, const bf16* base, size_t pitch, long row0, long rlo, long rhi, int kcol, int vcol, int tid) {
    const int key = tid >> 3, ch = tid & 7; long row = row0 + key; row = row < rlo ? rlo : (row > rhi ? rhi : row);
    const bf16* p = base + (size_t)row * pitch + ch * 8;
    R.k = *(const u4*)(p + kcol); R.v = *(const u4*)(p + vcol);
}
__device__ __forceinline__ void kv_store(const KVRegs& R, unsigned char* slot, int tid) {
    const int key = tid >> 3, ch = tid & 7;
    *(u4*)(slot + key * 128 + ((ch ^ (key & 7)) << 4)) = R.k;
    *(u4*)(slot + 8192 + (ch >> 2) * 4096 + (key >> 4) * 1024 + (key & 15) * 64 + (ch & 3) * 16) = R.v;
}
__device__ __forceinline__ void qk_tile(const unsigned char* ks, const bf16x8 (&qr)[4], f32x16& p0, f32x16& p1, int r32, int hi) {
    p0 = f32x16{}; p1 = f32x16{};
_Pragma("unroll")
    for (int d0 = 0; d0 < 4; ++d0) { const int off = r32 * 128 + (((2 * d0 + hi) ^ (r32 & 7)) << 4);
        const bf16x8 a0 = *(const bf16x8*)(ks + off), a1 = *(const bf16x8*)(ks + off + 4096);
        p0 = __builtin_amdgcn_mfma_f32_32x32x16_bf16(a0, qr[d0], p0, 0, 0, 0); p1 = __builtin_amdgcn_mfma_f32_32x32x16_bf16(a1, qr[d0], p1, 0, 0, 0); }
}
__device__ __forceinline__ void pv_tile(const unsigned char* vs, const f32x16& p0, const f32x16& p1, f32x16 (&o)[2], int lane, int hi) {
    bf16x8 pa[4];
_Pragma("unroll")
    for (int k = 0; k < 4; ++k) { const f32x16& P = (k < 2) ? p0 : p1; const int b = (k & 1) * 8;
        u4 w; w.x = cvtpk(P[b + 0], P[b + 1]); w.y = cvtpk(P[b + 2], P[b + 3]); w.z = cvtpk(P[b + 4], P[b + 5]); w.w = cvtpk(P[b + 6], P[b + 7]); pa[k] = __builtin_bit_cast(bf16x8, w); }
    const lds_cptr vb = (lds_cptr)vs + ((lane >> 4) & 1) * 32 + (lane & 3) * 8 + (4 * hi + ((lane & 15) >> 2)) * 64;
_Pragma("unroll")
    for (int d0 = 0; d0 < 2; ++d0)
_Pragma("unroll")
        for (int k = 0; k < 4; ++k) { const s16x4 lo = vtr(vb + d0 * 4096 + k * 1024), hh = vtr(vb + d0 * 4096 + k * 1024 + 512);
            const bf16x8 vf = (bf16x8){lo[0], lo[1], lo[2], lo[3], hh[0], hh[1], hh[2], hh[3]};
            o[d0] = __builtin_amdgcn_mfma_f32_32x32x16_bf16(pa[k], vf, o[d0], 0, 0, 0); }
}
struct SM { float m, l; f32x16 o[2]; };
__device__ __forceinline__ void sm_init(SM& S) { S.m = -1.0e30f; S.l = 0.f; S.o[0] = f32x16{}; S.o[1] = f32x16{}; }
__device__ __forceinline__ void sm_tile(SM& S, const unsigned char* kslot, const bf16x8 (&qr)[4], int pos0, int t, bool causal, int W, float slope2, bool rowok, float* wsf, int lane, int r32, int hi) {
    f32x16 p0, p1; qk_tile(kslot, qr, p0, p1, r32, hi);
    const float base = slope2 * (float)(pos0 + 4 * hi - t); const int rel = t - pos0 - 4 * hi;
    const int relc = rowok ? (causal ? rel : (1 << 20)) : -(1 << 20), relw = (W > 0) ? rel - W : -(1 << 20);
    float tmax = -INFINITY;
_Pragma("unroll")
    for (int r = 0; r < 16; ++r) { const int c0 = (r & 3) + 8 * (r >> 2);
        float x0 = fmaf(p0[r], C2, base + slope2 * (float)c0), x1 = fmaf(p1[r], C2, base + slope2 * (float)(c0 + 32));
        const bool v0 = (c0 <= relc) && (c0 > relw), v1 = (c0 + 32 <= relc) && (c0 + 32 > relw);
        x0 = v0 ? x0 : -INFINITY; x1 = v1 ? x1 : -INFINITY; p0[r] = x0; p1[r] = x1; tmax = fmaxf(tmax, fmaxf(x0, x1)); }
    tmax = swapmax(tmax);
    const float mn = fmaxf(S.m, tmax);
    if (__any(mn > S.m)) {
        const float alpha = __builtin_amdgcn_exp2f(S.m - mn); S.l *= alpha; S.m = mn;
        if (hi == 0) wsf[r32] = alpha;
        __builtin_amdgcn_wave_barrier(); asm volatile("s_waitcnt lgkmcnt(0)" ::: "memory");
_Pragma("unroll")
        for (int r = 0; r < 16; ++r) { const float a = wsf[crow(r, hi)]; S.o[0][r] *= a; S.o[1][r] *= a; }
        __builtin_amdgcn_wave_barrier(); asm volatile("" ::: "memory");
    }
    float ls = 0.f;
_Pragma("unroll")
    for (int r = 0; r < 16; ++r) { p0[r] = __builtin_amdgcn_exp2f(p0[r] - S.m); p1[r] = __builtin_amdgcn_exp2f(p1[r] - S.m); ls += p0[r] + p1[r]; }
    S.l += ls;
    pv_tile(kslot + 8192, p0, p1, S.o, lane, hi);
}
__device__ __forceinline__ void acc_lds(float* accw, const f32x16 (&o)[2], float fac, float* wsf, int r32, int hi, bool first) {
    __builtin_amdgcn_wave_barrier(); asm volatile("" ::: "memory");
    if (hi == 0) wsf[r32] = fac;
    __builtin_amdgcn_wave_barrier(); asm volatile("s_waitcnt lgkmcnt(0)" ::: "memory");
_Pragma("unroll")
    for (int r = 0; r < 16; ++r) { const float a = wsf[crow(r, hi)]; float* p = accw + crow(r, hi) * 64 + r32;
        if (first) { p[0] = a * o[0][r]; p[32] = a * o[1][r]; } else { p[0] += a * o[0][r]; p[32] += a * o[1][r]; } }
    __builtin_amdgcn_wave_barrier(); asm volatile("s_waitcnt lgkmcnt(0)" ::: "memory");
}
__device__ __forceinline__ void out_rows(const float* accw, const bf16* zbase  , bf16* mbase  , int lane) {
    const int row = lane >> 1, half = lane & 1; const float* a = accw + row * 64 + half * 32;
    const bf16* zp = zbase + (size_t)(row >> 2) * NP + (row & 3) * 64 + half * 32; bf16* mp = mbase + (size_t)(row >> 2) * D + (row & 3) * 64 + half * 32;
_Pragma("unroll")
    for (int i = 0; i < 4; ++i) { const u4 zw = *(const u4*)(zp + i * 8); const f4 a0 = *(const f4*)(a + i * 8), a1 = *(const f4*)(a + i * 8 + 4); u4 ow;
        float y[8];
_Pragma("unroll")
        for (int e = 0; e < 4; ++e) { const float z0 = __uint_as_float(zw[e] << 16), z1 = __uint_as_float(zw[e] & 0xffff0000u); y[2 * e] = siluf_(z0); y[2 * e + 1] = siluf_(z1); }
        ow.x = pk2(a0[0] * y[0], a0[1] * y[1]); ow.y = pk2(a0[2] * y[2], a0[3] * y[3]); ow.z = pk2(a1[0] * y[4], a1[1] * y[5]); ow.w = pk2(a1[2] * y[6], a1[3] * y[7]);
        *(u4*)(mp + i * 8) = ow; }
}
__device__ __forceinline__ void load_q(bf16x8 (&qr)[4], const bf16* PROJ, size_t tok, int qcol, int hi) {
_Pragma("unroll")
    for (int d0 = 0; d0 < 4; ++d0) qr[d0] = *(const bf16x8*)(PROJ + tok * NP + qcol + d0 * 16 + hi * 8);
}
#define AT2_TILE_LOOP(J0, J1, BASE, PITCH, ROWOF, RLO, RHI, KCOL, VCOL, ...) do { \
    KVRegs R_; int buf_ = 0; kv_load(R_, BASE, PITCH, ROWOF(J0), RLO, RHI, KCOL, VCOL, tid); __syncthreads(); kv_store(R_, lds + L_KV, tid); __syncthreads(); \
    for (int j = (J0); j <= (J1); ++j) { \
        if (j < (J1)) kv_load(R_, BASE, PITCH, ROWOF(j + 1), RLO, RHI, KCOL, VCOL, tid); \
        { const unsigned char* slot = lds + L_KV + buf_ * 16384; __VA_ARGS__ } \
        if (j < (J1)) kv_store(R_, lds + L_KV + (buf_ ^ 1) * 16384, tid); \
        __syncthreads(); buf_ ^= 1; } } while (0)

__device__ __forceinline__ void unit_a(const Params& P, int layer, int b, int g, int c, unsigned char* lds) {
    int tid_ = threadIdx.x; asm volatile("" : "+v"(tid_)); const int tid = tid_, lane = tid & 63, wave = __builtin_amdgcn_readfirstlane(tid >> 6), r32 = lane & 31, hi = lane >> 5;
    const bf16* PROJ = (const bf16*)(P.ws + WS_PROJ); const float* SMALL = (const float*)(P.ws + WS_SMALL); bf16* MIX = (bf16*)(P.ws + WS_MIX);
    float* imp = (float*)(lds + L_IMP); unsigned* selm = (unsigned*)(lds + L_SEL); float* wsf = (float*)(lds + L_WSF) + wave * 32; float* gt = (float*)(lds + L_GT) + wave * 96;
    const long rowbase = (long)b * T; const int tl = wave * 8 + (r32 >> 2), t = c * 64 + tl, hd = g * 4 + (r32 & 3); const size_t tok = (size_t)(rowbase + t);
    const float slope2 = __uint_as_float((unsigned)(126 - hd) << 23) * LOG2E;
    bf16x8 qr[4]; load_q(qr, PROJ, tok, C_AQ + hd * 64, hi);
    for (int i = tid; i < 64 * 128; i += 512) imp[i] = 0.f;
    if (hi == 0) { const float* sm = SMALL + tok * 32 + S_GATE + hd * 3; gt[r32 * 3 + 0] = sigmoidf_(sm[0]); gt[r32 * 3 + 1] = sigmoidf_(sm[1]); gt[r32 * 3 + 2] = sigmoidf_(sm[2]); }
    float* accw = (float*)(lds + L_ACC) + wave * 2048;
    const int imax = (t >= 31) ? ((t - 31) >> 4) : -1;
    const int nT = ((4 * c + 2) >> 6);
    const bf16* KC = (const bf16*)(P.ws + WS_KCMP) + (size_t)(b * 2 + g) * CMP_PITCH * 128;
#define ROW_CMP(j) ((long)(j) * 64)
    float cm = -1.0e30f, cl = 0.f;
    AT2_TILE_LOOP(0, nT, KC, 128, ROW_CMP, 0, 511, 0, 64, {
        f32x16 p0, p1; qk_tile(slot, qr, p0, p1, r32, hi); const int rel = imax - j * 64 - 4 * hi; float tm = -INFINITY;
_Pragma("unroll")
        for (int r = 0; r < 16; ++r) { const int c0 = (r & 3) + 8 * (r >> 2); const float x0 = (c0 <= rel) ? p0[r] * C2 : -INFINITY, x1 = (c0 + 32 <= rel) ? p1[r] * C2 : -INFINITY; p0[r] = x0; p1[r] = x1; tm = fmaxf(tm, fmaxf(x0, x1)); }
        const float mn = fmaxf(cm, tm); cl *= __builtin_amdgcn_exp2f(cm - mn); cm = mn; float ls = 0.f;
_Pragma("unroll")
        for (int r = 0; r < 16; ++r) ls += __builtin_amdgcn_exp2f(p0[r] - cm) + __builtin_amdgcn_exp2f(p1[r] - cm);
        cl += ls; });
    {
        const float mo = swapmax(cm); cl *= __builtin_amdgcn_exp2f(cm - mo); cm = mo; cl = swapsum(cl); }
    const float crl = (cl > 0.f) ? 1.0f / cl : 0.f;
    { SM S; sm_init(S);
      AT2_TILE_LOOP(0, nT, KC, 128, ROW_CMP, 0, 511, 0, 64, {
        f32x16 p0, p1; qk_tile(slot, qr, p0, p1, r32, hi); const int rel = imax - j * 64 - 4 * hi;
_Pragma("unroll")
        for (int r = 0; r < 16; ++r) { const int c0 = (r & 3) + 8 * (r >> 2);
            p0[r] = (c0 <= rel) ? __builtin_amdgcn_exp2f(p0[r] * C2 - cm) * crl : 0.f; p1[r] = (c0 + 32 <= rel) ? __builtin_amdgcn_exp2f(p1[r] * C2 - cm) * crl : 0.f; }
_Pragma("unroll")
        for (int rq = 0; rq < 4; ++rq) {
            const float q0 = quadsum((p0[4 * rq] + p0[4 * rq + 1]) + (p0[4 * rq + 2] + p0[4 * rq + 3])), q1 = quadsum((p1[4 * rq] + p1[4 * rq + 1]) + (p1[4 * rq + 2] + p1[4 * rq + 3]));
            const float t0 = quadsum(p0[4 * rq + 3]), t1 = quadsum(p1[4 * rq + 3]);
            if ((lane & 3) == 0) { float* ip = imp + tl * 128 + j * 16 + 2 * rq + hi; const int jb = j * 16 + 2 * rq + hi;
                atomicAdd(ip, q0); atomicAdd(ip + 8, q1); atomicAdd(ip + 1, t0); if (jb + 9 < 128) atomicAdd(ip + 9, t1); } }
        pv_tile(slot + 8192, p0, p1, S.o, lane, hi); });
      acc_lds(accw, S.o, gt[r32 * 3 + 0], wsf, r32, hi, true); }
    __syncthreads();
    int c2 = c; asm volatile("" : "+s"(c2));
    for (int k8 = 0; k8 < 8; ++k8) { const int tk = wave * 8 + k8; unsigned long long lo, hh;
        if (c2 < 16) { lo = (c2 >= 63) ? ~0ull : ((1ull << (c2 + 1)) - 1ull); hh = 0ull; }
        else {
            const float v0 = imp[tk * 128 + lane], v1 = imp[tk * 128 + 64 + lane];
            const bool e0 = (lane >= 1) && (lane <= c2 - 2), e1 = (lane + 64 <= c2 - 2);
            const unsigned k0 = __float_as_uint(fmaxf(v0, 0.f)), k1 = __float_as_uint(fmaxf(v1, 0.f));
            unsigned tau = 0u;
            for (int bit = 30; bit >= 0; --bit) { const unsigned cand = tau | (1u << bit);
                const int cnt = __popcll(__ballot(e0 && k0 >= cand)) + __popcll(__ballot(e1 && k1 >= cand)); if (cnt >= 13) tau = cand; }
            const unsigned long long g0 = __ballot(e0 && k0 > tau), g1 = __ballot(e1 && k1 > tau), q0 = __ballot(e0 && k0 == tau), q1 = __ballot(e1 && k1 == tau);
            const int need = 13 - (__popcll(g0) + __popcll(g1));
            const int pre0 = __builtin_amdgcn_mbcnt_hi((unsigned)(q0 >> 32), __builtin_amdgcn_mbcnt_lo((unsigned)q0, 0u));
            const int pre1 = __popcll(q0) + __builtin_amdgcn_mbcnt_hi((unsigned)(q1 >> 32), __builtin_amdgcn_mbcnt_lo((unsigned)q1, 0u));
            const bool f0 = (lane == 0) || (lane == c2 - 1) || (lane == c2), f1 = (lane + 64 == c2 - 1) || (lane + 64 == c2);
            const bool s0 = f0 || (e0 && (k0 > tau || (k0 == tau && pre0 < need))), s1 = f1 || (e1 && (k1 > tau || (k1 == tau && pre1 < need)));
            lo = __ballot(s0); hh = __ballot(s1);
        }
        if (lane == 0) { selm[tk * 4 + 0] = (unsigned)lo; selm[tk * 4 + 1] = (unsigned)(lo >> 32); selm[tk * 4 + 2] = (unsigned)hh; selm[tk * 4 + 3] = (unsigned)(hh >> 32); } }
    __builtin_amdgcn_wave_barrier(); asm volatile("s_waitcnt lgkmcnt(0)" ::: "memory");
    const unsigned sm0 = selm[tl * 4 + 0], sm1 = selm[tl * 4 + 1], sm2 = selm[tl * 4 + 2], sm3 = selm[tl * 4 + 3];
#define ROW_SEQ(j) (rowbase + (long)(j) * 64)
    { SM S; sm_init(S);
      AT2_TILE_LOOP(0, c, PROJ, NP, ROW_SEQ, rowbase, rowbase + T - 1, C_AKS + g * 64, C_AVS + g * 64, {
        const unsigned w = (j < 32) ? sm0 : (j < 64) ? sm1 : (j < 96) ? sm2 : sm3; const bool sel = (w >> (j & 31)) & 1u;
        if (__any(sel)) sm_tile(S, slot, qr, j * 64, t, j == c, 0, slope2, sel, wsf, lane, r32, hi); });
      const float lt = swapsum(S.l); acc_lds(accw, S.o, gt[r32 * 3 + 1] / lt, wsf, r32, hi, false); }
    { SM S; sm_init(S); const int j0 = (c >= 8) ? c - 8 : 0;
      AT2_TILE_LOOP(j0, c, PROJ, NP, ROW_SEQ, rowbase, rowbase + T - 1, C_AKW + g * 64, C_AVW + g * 64, {
        sm_tile(S, slot, qr, j * 64, t, j == c, (j == c - 8) ? 512 : 0, slope2, true, wsf, lane, r32, hi); });
      const float lt = swapsum(S.l); acc_lds(accw, S.o, gt[r32 * 3 + 2] / lt, wsf, r32, hi, false); }
    { const size_t tok0 = (size_t)(rowbase + c * 64 + wave * 8); out_rows(accw, PROJ + tok0 * NP + C_AZ + g * 256, MIX + tok0 * D + g * 256, lane); }
    __syncthreads();
}
__device__ __forceinline__ void unit_c(const Params& P, int layer, int b, int g, int c, unsigned char* lds) {
    int tid_ = threadIdx.x; asm volatile("" : "+v"(tid_)); const int tid = tid_, lane = tid & 63, wave = __builtin_amdgcn_readfirstlane(tid >> 6), r32 = lane & 31, hi = lane >> 5;
    const bf16* PROJ = (const bf16*)(P.ws + WS_PROJ); bf16* MIX = (bf16*)(P.ws + WS_MIX);
    float* wsf = (float*)(lds + L_WSF) + wave * 32;
    const long rowbase = (long)b * T; const int tl = wave * 8 + (r32 >> 2), t = c * 64 + tl, hd = g * 4 + (r32 & 3); const size_t tok = (size_t)(rowbase + t);
    const float slope2 = __uint_as_float((unsigned)(126 - hd) << 23) * LOG2E;
    bf16x8 qr[4]; load_q(qr, PROJ, tok, C_CQ + hd * 64, hi);
    SM S; sm_init(S); const int j0 = (c >= 2) ? c - 2 : 0;
    AT2_TILE_LOOP(j0, c, PROJ, NP, ROW_SEQ, rowbase, rowbase + T - 1, C_CK + g * 64, C_CV + g * 64, {
        sm_tile(S, slot, qr, j * 64, t, j == c, (j == c - 2) ? 128 : 0, slope2, true, wsf, lane, r32, hi); });
    const float lt = swapsum(S.l); const float sk2 = P.sinks[layer * 8 + hd] * LOG2E;
    const float Mx = fmaxf(S.m, sk2); const float a = __builtin_amdgcn_exp2f(S.m - Mx); const float fac = a / (lt * a + __builtin_amdgcn_exp2f(sk2 - Mx));
    float* accw = (float*)(lds + L_ACC) + wave * 2048;
    acc_lds(accw, S.o, fac, wsf, r32, hi, true);
    { const size_t tok0 = (size_t)(rowbase + c * 64 + wave * 8); out_rows(accw, PROJ + tok0 * NP + C_CZ + g * 256, MIX + tok0 * D + 1536 + g * 256, lane); }
    __syncthreads();
}
}
namespace ml {
using at2::bf16x8; using at2::s16x4; using at2::f32x16; using at2::lds_cptr; using at2::vtr; using at2::crow; using at2::cvtpk; using at2::swapsum;
constexpr size_t WS_U = 479 * MiB, WS_BC = 511 * MiB, WS_PM = WS_BC + 256 * 1024, WS_NST = WS_PM + 256 * 1024, WS_SEGS = WS_NST + 256 * 1024;
constexpr int QP = 2048;
__device__ __forceinline__ bf16x8 tr_frag(lds_cptr base, int PB, int row0, int col0, int lane) {
    const int g16 = lane >> 4, h = g16 >> 1, q = (lane & 15) >> 2, p = lane & 3;
    const lds_cptr a = base + (row0 + 8 * h + q) * PB + (col0 + 16 * (g16 & 1) + 4 * p) * 2;
    const s16x4 lo = vtr(a), hh = vtr(a + 4 * PB);
    return (bf16x8){lo[0], lo[1], lo[2], lo[3], hh[0], hh[1], hh[2], hh[3]};
}
__device__ __forceinline__ bf16x8 tr_frag_perm(lds_cptr base, int PB, int row0, int col0, int lane) {
    const int g16 = lane >> 4, h = g16 >> 1, q = (lane & 15) >> 2, p = lane & 3;
    const lds_cptr a = base + (row0 + 4 * h + q) * PB + (col0 + 16 * (g16 & 1) + 4 * p) * 2;
    const s16x4 lo = vtr(a), hh = vtr(a + 8 * PB);
    return (bf16x8){lo[0], lo[1], lo[2], lo[3], hh[0], hh[1], hh[2], hh[3]};
}
__device__ __forceinline__ void m0_prep(const Params& P, int layer, int seg, unsigned char* lds) {
    int tid_ = threadIdx.x; asm volatile("" : "+v"(tid_)); const int tid = tid_, lane = tid & 63, wave = tid >> 6;
    const bf16* PROJ = (const bf16*)(P.ws + WS_PROJ); const float* SMALL = (const float*)(P.ws + WS_SMALL); bf16* QKC = (bf16*)(P.ws + WS_XB);
    float* BC = (float*)(P.ws + WS_BC); float* PM = (float*)(P.ws + WS_PM); float* NST = (float*)(P.ws + WS_NST); float* SEGS = (float*)(P.ws + WS_SEGS);
    float* sa = (float*)lds; float* wt = sa + 256; float* scal = wt + 16;
    const int bh = seg >> 5, b = bh >> 2, h = bh & 3, s = seg & 31; const size_t tok0 = (size_t)b * T + s * 256;
    float x = 0.f, iv = 0.f;
    if (tid < 256) { const size_t tok = tok0 + tid; iv = SMALL[tok * 32 + S_I + h] + P.i_bias[layer * 4 + h]; x = logsigmoidf_(SMALL[tok * 32 + S_F + h] + P.f_bias[layer * 4 + h]);
#pragma unroll
        for (int o = 1; o < 64; o <<= 1) { const float y = __shfl_up(x, o); if (lane >= o) x += y; }
        if (lane == 63) wt[wave] = x; }
    __syncthreads();
    float a = 0.f, mx = 0.f, bc = 0.f;
    if (tid < 256) { float off = 0.f; for (int w2 = 0; w2 < wave; ++w2) off += wt[w2]; bc = x + off; a = iv - bc; mx = a;
#pragma unroll
        for (int o = 1; o < 64; o <<= 1) { const float y = __shfl_up(mx, o); if (lane >= o) mx = fmaxf(mx, y); }
        if (lane == 63) wt[8 + wave] = mx; }
    __syncthreads();
    if (tid < 256) { for (int w2 = 0; w2 < wave; ++w2) mx = fmaxf(mx, wt[8 + w2]); const size_t tok = tok0 + tid; BC[tok * 4 + h] = bc; PM[tok * 4 + h] = mx; sa[tid] = a;
        if (tid == 255) { scal[0] = bc; scal[1] = mx; SEGS[seg] = bc; SEGS[256 + seg] = mx; } }
    __syncthreads();
    const float amax = scal[1];
    const int ch = tid; const bool isq = ch < 256;
    const int pcol = isq ? (C_BQ + h * 256 + ch) : (C_BK + h * 256 + (ch - 256)); const int cc = isq ? (h * 256 + ch) : (1024 + h * 256 + (ch - 256));
    const float* cw = P.conv_w + (size_t)layer * 4 * 2048 + cc; const float cw0 = cw[0], cw1 = cw[2048], cw2 = cw[4096], cw3 = cw[6144], cb = P.conv_b[layer * 2048 + cc];
    float xm3 = 0.f, xm2 = 0.f, xm1 = 0.f;
    if (s > 0) { xm3 = bf2f(PROJ[(tok0 - 3) * NP + pcol]); xm2 = bf2f(PROJ[(tok0 - 2) * NP + pcol]); xm1 = bf2f(PROJ[(tok0 - 1) * NP + pcol]); }
    bf16* qo = QKC + tok0 * QP + (isq ? (h * 256 + ch) : (1024 + h * 256 + (ch - 256))); const bf16* xp = PROJ + tok0 * NP + pcol; float nsum = 0.f;
#pragma unroll 8
    for (int tl = 0; tl < 256; ++tl) { const float xc = bf2f(xp[(size_t)tl * NP]); const float y = cb + cw0 * xm3 + cw1 * xm2 + cw2 * xm1 + cw3 * xc; xm3 = xm2; xm2 = xm1; xm1 = xc;
        float v = siluf_(y); if (!isq) { v *= 0.0625f * __expf(sa[tl] - amax); nsum += v; }
        qo[(size_t)tl * QP] = (bf16)f2bf(v); }
    if (!isq) NST[(size_t)seg * 256 + (ch - 256)] = nsum;
    __syncthreads();
}
constexpr int PB = 576;
__device__ __forceinline__ void m1_state(const Params& P, int seg, unsigned char* lds) {
    int tid_ = threadIdx.x; asm volatile("" : "+v"(tid_)); const int tid = tid_, lane = tid & 63, wave = __builtin_amdgcn_readfirstlane(tid >> 6), r32 = lane & 31, hi = lane >> 5;
    const bf16* PROJ = (const bf16*)(P.ws + WS_PROJ); const bf16* QKC = (const bf16*)(P.ws + WS_XB); bf16* U = (bf16*)(P.ws + WS_U) + (size_t)seg * 65536;
    const int bh = seg >> 5, b = bh >> 2, h = bh & 3, s = seg & 31; const size_t tok0 = (size_t)b * T + s * 256;
    f32x16 acc[8];
#pragma unroll
    for (int i = 0; i < 8; ++i) acc[i] = f32x16{};
    const int lrow = tid >> 4, lc = tid & 15;
    const bf16* gk = QKC + (tok0 + lrow) * QP + 1024 + h * 256 + lc * 8; const bf16* gv = PROJ + (tok0 + lrow) * NP + C_BV + h * 256 + lc * 8;
    u4 rk0, rk1, rv0, rv1;
    rk0 = *(const u4*)gk; rk1 = *(const u4*)(gk + 128); rv0 = *(const u4*)gv; rv1 = *(const u4*)(gv + 128);
    __syncthreads();
    for (int ck = 0; ck < 8; ++ck) {
        unsigned char* st = lds + (ck & 1) * (2 * 32 * PB);
        *(u4*)(st + lrow * PB + lc * 16) = rk0; *(u4*)(st + lrow * PB + 256 + lc * 16) = rk1;
        *(u4*)(st + 32 * PB + lrow * PB + lc * 16) = rv0; *(u4*)(st + 32 * PB + lrow * PB + 256 + lc * 16) = rv1;
        if (ck < 7) { const size_t o = (size_t)(ck + 1) * 32; rk0 = *(const u4*)(gk + o * QP); rk1 = *(const u4*)(gk + o * QP + 128); rv0 = *(const u4*)(gv + o * NP); rv1 = *(const u4*)(gv + o * NP + 128); }
        __syncthreads();
        const lds_cptr kt = (lds_cptr)st, vt = (lds_cptr)(st + 32 * PB);
#pragma unroll
        for (int ks = 0; ks < 2; ++ks) { const bf16x8 bk = tr_frag(kt, PB, ks * 16, wave * 32, lane);
#pragma unroll
            for (int et = 0; et < 8; ++et) { const bf16x8 av = tr_frag(vt, PB, ks * 16, et * 32, lane);
                acc[et] = __builtin_amdgcn_mfma_f32_32x32x16_bf16(av, bk, acc[et], 0, 0, 0); } }
    }
    __syncthreads();
    bf16* so = (bf16*)lds;
#pragma unroll
    for (int et = 0; et < 8; ++et)
#pragma unroll
        for (int r = 0; r < 16; ++r) so[(et * 32 + crow(r, hi)) * 264 + wave * 32 + r32] = (bf16)f2bf(acc[et][r]);
    __syncthreads();
    for (int i = tid; i < 256 * 32; i += 512) { const int e = i >> 5, c16 = i & 31; *(u4*)(U + (size_t)e * 256 + c16 * 8) = *(const u4*)(so + e * 264 + c16 * 8); }
    __syncthreads();
}
__device__ __forceinline__ void m2_scan(const Params& P) {
    int tid_ = threadIdx.x; asm volatile("" : "+v"(tid_)); const int gt = blockIdx.x * 512 + tid_;
    if (gt >= 8 * 8192) return;
    const int bh = gt >> 13, idx = gt & 8191; bf16* U = (bf16*)(P.ws + WS_U) + (size_t)bh * 32 * 65536 + idx * 8; float* NST = (float*)(P.ws + WS_NST) + (size_t)bh * 32 * 256; float* SEGS = (float*)(P.ws + WS_SEGS);
    float c[8] = {0.f, 0.f, 0.f, 0.f, 0.f, 0.f, 0.f, 0.f}; float n8[8] = {0.f, 0.f, 0.f, 0.f, 0.f, 0.f, 0.f, 0.f}; float m = 0.f; const bool don = idx < 32;
    for (int s0 = 0; s0 < 32; s0 += 8) {
        u4 uu[8];
#pragma unroll
        for (int k = 0; k < 8; ++k) uu[k] = *(const u4*)(U + (size_t)(s0 + k) * 65536);
#pragma unroll
        for (int k = 0; k < 8; ++k) { const int sg = bh * 32 + s0 + k; const float blast = SEGS[sg], mloc = blast + SEGS[256 + sg];
            const float mn = fmaxf(blast + m, mloc); const float dec = __expf(blast + m - mn), wl = __expf(mloc - mn);
            u4 o; o.x = pk2(c[0], c[1]); o.y = pk2(c[2], c[3]); o.z = pk2(c[4], c[5]); o.w = pk2(c[6], c[7]); *(u4*)(U + (size_t)(s0 + k) * 65536) = o;
#pragma unroll
            for (int e = 0; e < 4; ++e) { c[2 * e] = dec * c[2 * e] + wl * __uint_as_float(uu[k][e] << 16); c[2 * e + 1] = dec * c[2 * e + 1] + wl * __uint_as_float(uu[k][e] & 0xffff0000u); }
            if (don) { float* np = NST + (size_t)(s0 + k) * 256 + idx * 8; const f4 a0 = *(const f4*)np, a1 = *(const f4*)(np + 4);
                *(f4*)np = (f4){n8[0], n8[1], n8[2], n8[3]}; *(f4*)(np + 4) = (f4){n8[4], n8[5], n8[6], n8[7]};
#pragma unroll
                for (int e = 0; e < 4; ++e) { n8[e] = dec * n8[e] + wl * a0[e]; n8[4 + e] = dec * n8[4 + e] + wl * a1[e]; } }
            if (idx == 0) SEGS[512 + sg] = m;
            m = mn; }
    }
}
constexpr int M3_STG = 32768 + 64 * PB;
constexpr int M3_TAB = 2 * M3_STG;
__device__ __forceinline__ void m3_out(const Params& P, int layer, int seg, unsigned char* lds) {
    int tid_ = threadIdx.x; asm volatile("" : "+v"(tid_)); const int tid = tid_, lane = tid & 63, wave = __builtin_amdgcn_readfirstlane(tid >> 6), r32 = lane & 31, hi = lane >> 5;
    const bf16* PROJ = (const bf16*)(P.ws + WS_PROJ); const bf16* QKC = (const bf16*)(P.ws + WS_XB); const bf16* CT = (const bf16*)(P.ws + WS_U) + (size_t)seg * 65536; bf16* MIX = (bf16*)(P.ws + WS_MIX);
    const float* BC = (const float*)(P.ws + WS_BC); const float* PM = (const float*)(P.ws + WS_PM); const float* NST = (const float*)(P.ws + WS_NST) + (size_t)seg * 256; const float* SEGS = (const float*)(P.ws + WS_SEGS);
    const int bh = seg >> 5, b = bh >> 2, h = bh & 3, s = seg & 31; const size_t tok0 = (size_t)b * T + s * 256;
    float* wsf = (float*)(lds + M3_TAB) + wave * 32; float* nvec = (float*)(lds + M3_TAB + 1024); float* rowf = nvec + 256; float* wint = rowf + 256; float* clampv = wint + 256;
    if (tid < 256) { const float mst = SEGS[512 + seg], amax = SEGS[256 + seg]; const float pm = PM[(tok0 + tid) * 4 + h], bc = BC[(tok0 + tid) * 4 + h]; const float mxt = fmaxf(mst, pm);
        rowf[tid] = __expf(amax - mxt); wint[tid] = __expf(mst - mxt); clampv[tid] = __expf(-(bc + mxt)); nvec[tid] = NST[tid]; }
    f32x16 H[8];
#pragma unroll
    for (int i = 0; i < 8; ++i) H[i] = f32x16{};
    const bf16* qrow = QKC + (tok0 + wave * 32 + r32) * QP + h * 256 + hi * 8;
    {   const int lrow = tid >> 3, lch = tid & 7;
        u4 rc[4];
#pragma unroll
        for (int i = 0; i < 4; ++i) rc[i] = *(const u4*)(CT + (size_t)(lrow + 64 * i) * 256 + lch * 8);
        __syncthreads();
        float dq = 0.f;
        for (int ck = 0; ck < 4; ++ck) { unsigned char* st = lds + (ck & 1) * 32768;
#pragma unroll
            for (int i = 0; i < 4; ++i) { const int row = lrow + 64 * i; *(u4*)(st + row * 128 + ((lch ^ (row & 7)) << 4)) = rc[i]; }
            if (ck < 3) {
#pragma unroll
                for (int i = 0; i < 4; ++i) rc[i] = *(const u4*)(CT + (size_t)(lrow + 64 * i) * 256 + (ck + 1) * 64 + lch * 8); }
            __syncthreads();
#pragma unroll
            for (int k4 = 0; k4 < 4; ++k4) { const int ks = ck * 4 + k4; const bf16x8 qa = *(const bf16x8*)(qrow + ks * 16);
#pragma unroll
                for (int e = 0; e < 8; ++e) dq += bf2f((unsigned short)qa[e]) * nvec[ks * 16 + hi * 8 + e];
#pragma unroll
                for (int et = 0; et < 8; ++et) { const int row = et * 32 + r32; const bf16x8 cb = *(const bf16x8*)(st + row * 128 + (((2 * k4 + hi) ^ (row & 7)) << 4));
                    H[et] = __builtin_amdgcn_mfma_f32_32x32x16_bf16(qa, cb, H[et], 0, 0, 0); } }
        }
        dq = swapsum(dq);
        __builtin_amdgcn_wave_barrier(); asm volatile("" ::: "memory");
        if (hi == 0) wsf[r32] = wint[wave * 32 + r32];
        __builtin_amdgcn_wave_barrier(); asm volatile("s_waitcnt lgkmcnt(0)" ::: "memory");
#pragma unroll
        for (int r = 0; r < 16; ++r) { const float a = wsf[crow(r, hi)];
#pragma unroll
            for (int et = 0; et < 8; ++et) H[et][r] *= a; }
        __builtin_amdgcn_wave_barrier(); asm volatile("" ::: "memory");
        const float rf = rowf[wave * 32 + r32]; float dsum = 0.f;
        const int krow = tid >> 3, kc4 = tid & 7;
        __syncthreads();
        for (int j = 0; j < 4; ++j) { unsigned char* st = lds + (j & 1) * M3_STG;
            { const bf16* gk = QKC + (tok0 + j * 64 + krow) * QP + 1024 + h * 256; const bf16* gv = PROJ + (tok0 + j * 64 + krow) * NP + C_BV + h * 256;
#pragma unroll
              for (int i = 0; i < 4; ++i) { const int ch = kc4 + 8 * i; const u4 kk = *(const u4*)(gk + ch * 8), vv = *(const u4*)(gv + ch * 8);
                  *(u4*)(st + krow * 512 + ((ch ^ (krow & 7)) << 4)) = kk; *(u4*)(st + 32768 + krow * PB + ch * 16) = vv; } }
            __syncthreads();
            if (j <= (wave >> 1)) {
                f32x16 p0 = f32x16{}, p1 = f32x16{};
#pragma unroll
                for (int ks = 0; ks < 16; ++ks) { const bf16x8 qb = *(const bf16x8*)(qrow + ks * 16); const int off = r32 * 512 + (((2 * ks + hi) ^ (r32 & 7)) << 4);
                    const bf16x8 a0 = *(const bf16x8*)(st + off), a1 = *(const bf16x8*)(st + off + 32 * 512);
                    p0 = __builtin_amdgcn_mfma_f32_32x32x16_bf16(a0, qb, p0, 0, 0, 0); p1 = __builtin_amdgcn_mfma_f32_32x32x16_bf16(a1, qb, p1, 0, 0, 0); }
                const int rel = wave * 32 + r32 - j * 64 - 4 * hi;
#pragma unroll
                for (int r = 0; r < 16; ++r) { const int c0 = (r & 3) + 8 * (r >> 2); const float x0 = (c0 <= rel) ? p0[r] * rf : 0.f, x1 = (c0 + 32 <= rel) ? p1[r] * rf : 0.f; p0[r] = x0; p1[r] = x1; dsum += x0 + x1; }
                bf16x8 pa[4];
#pragma unroll
                for (int k = 0; k < 4; ++k) { const f32x16& Pq = (k < 2) ? p0 : p1; const int bb = (k & 1) * 8;
                    u4 w; w.x = cvtpk(Pq[bb + 0], Pq[bb + 1]); w.y = cvtpk(Pq[bb + 2], Pq[bb + 3]); w.z = cvtpk(Pq[bb + 4], Pq[bb + 5]); w.w = cvtpk(Pq[bb + 6], Pq[bb + 7]); pa[k] = __builtin_bit_cast(bf16x8, w); }
                const lds_cptr vt = (lds_cptr)(st + 32768);
#pragma unroll
                for (int k = 0; k < 4; ++k)
#pragma unroll
                    for (int et = 0; et < 8; ++et) { const bf16x8 vf = tr_frag_perm(vt, PB, k * 16, et * 32, lane); H[et] = __builtin_amdgcn_mfma_f32_32x32x16_bf16(pa[k], vf, H[et], 0, 0, 0); }
            }
        }
        dsum = swapsum(dsum);
        const int trow = wave * 32 + r32; const float den = wint[trow] * dq + dsum; const float rden = 1.0f / fmaxf(fabsf(den), clampv[trow]);
        __syncthreads();
        if (hi == 0) wsf[r32] = rden;
        __builtin_amdgcn_wave_barrier(); asm volatile("s_waitcnt lgkmcnt(0)" ::: "memory");
        bf16* hs = (bf16*)(lds + wave * (32 * 528));
#pragma unroll
        for (int r = 0; r < 16; ++r) { const float a = wsf[crow(r, hi)];
#pragma unroll
            for (int et = 0; et < 8; ++et) hs[crow(r, hi) * 264 + et * 32 + r32] = (bf16)f2bf(H[et][r] * a); }
        __builtin_amdgcn_wave_barrier(); asm volatile("s_waitcnt lgkmcnt(0)" ::: "memory");
        const int row = lane >> 1, half = lane & 1; const size_t tok = tok0 + wave * 32 + row;
        const bf16* og = PROJ + tok * NP + C_BO + h * 256 + half * 128; const bf16* zg = PROJ + tok * NP + C_BZ + h * 256 + half * 128; const float* gg = P.mnorm_g + layer * 1024 + h * 256 + half * 128;
        bf16* mo = MIX + tok * D + 512 + h * 256 + half * 128; const bf16* hr = hs + row * 264 + half * 128;
        float ss = 0.f;
#pragma unroll 4
        for (int i = 0; i < 16; ++i) { const u4 hw = *(const u4*)(hr + i * 8), ow = *(const u4*)(og + i * 8);
#pragma unroll
            for (int e = 0; e < 4; ++e) { const float h0 = __uint_as_float(hw[e] << 16) * sigmoidf_(__uint_as_float(ow[e] << 16)), h1 = __uint_as_float(hw[e] & 0xffff0000u) * sigmoidf_(__uint_as_float(ow[e] & 0xffff0000u)); ss += h0 * h0 + h1 * h1; } }
        ss += __uint_as_float(__builtin_amdgcn_update_dpp(0u, __float_as_uint(ss), 0xB1, 0xF, 0xF, true));
        const float rstd = 1.0f / sqrtf(ss * (1.0f / 256.0f) + EPS);
#pragma unroll 2
        for (int i = 0; i < 16; ++i) { const u4 hw = *(const u4*)(hr + i * 8), ow = *(const u4*)(og + i * 8), zw = *(const u4*)(zg + i * 8); const f4 g0 = *(const f4*)(gg + i * 8), g1 = *(const f4*)(gg + i * 8 + 4); u4 out; float y[8];
#pragma unroll
            for (int e = 0; e < 4; ++e) { const float h0 = __uint_as_float(hw[e] << 16) * sigmoidf_(__uint_as_float(ow[e] << 16)), h1 = __uint_as_float(hw[e] & 0xffff0000u) * sigmoidf_(__uint_as_float(ow[e] & 0xffff0000u));
                y[2 * e] = h0 * rstd * siluf_(__uint_as_float(zw[e] << 16)); y[2 * e + 1] = h1 * rstd * siluf_(__uint_as_float(zw[e] & 0xffff0000u)); }
            out.x = pk2(y[0] * g0[0], y[1] * g0[1]); out.y = pk2(y[2] * g0[2], y[3] * g0[3]); out.z = pk2(y[4] * g1[0], y[5] * g1[1]); out.w = pk2(y[6] * g1[2], y[7] * g1[3]);
            *(u4*)(mo + i * 8) = out; }
    }
    __syncthreads();
}
}
__device__ __forceinline__ void phase_final(const Params& P, int gw, int NGW, int lane) {
    const float* SSQ = (const float*)(P.ws + WS_SSQ);
    for (int m = gw; m < M; m += NGW) { float s = (lane < 32) ? SSQ[(size_t)m * 32 + lane] : 0.f; s = wsum(s);
        const float rstd = 1.0f / sqrtf(s * (1.0f / 2048.0f) + EPS);
        f4* xr = (f4*)(P.out + (size_t)m * D) + lane; const f4* gr = (const f4*)P.final_g + lane;
#pragma unroll
        for (int j = 0; j < 8; ++j) { f4 v = xr[64 * j]; const f4 gg = gr[64 * j]; v = v * rstd * gg; xr[64 * j] = v; } }
}
__global__ void __launch_bounds__(512, 2) hymba_fwd(Params P) {
    extern __shared__ __attribute__((aligned(16))) unsigned char lds[];
    cg::grid_group grid = cg::this_grid();
    const int G = gridDim.x, NGW = G * 8;
#define PH_IDS() int tid = threadIdx.x; asm volatile("" : "+v"(tid)); const int lane = tid & 63, wave = __builtin_amdgcn_readfirstlane(tid >> 6), gw = blockIdx.x * 8 + wave; (void)lane; (void)gw;
    pg8::bf16_t* WIN = (pg8::bf16_t*)(P.ws + WS_WIN); pg8::bf16_t* WOUT = (pg8::bf16_t*)(P.ws + WS_WOUT); pg8::bf16_t* XB = (pg8::bf16_t*)(P.ws + WS_XB);
    pg8::bf16_t* PROJ = (pg8::bf16_t*)(P.ws + WS_PROJ); pg8::bf16_t* MIX = (pg8::bf16_t*)(P.ws + WS_MIX);
    float* SMALL = (float*)(P.ws + WS_SMALL); float* SSQ = (float*)(P.ws + WS_SSQ);
    { PH_IDS(); phase_prologue(P, lds, gw, NGW, wave, lane); }
    grid.sync();
    for (int layer = 0; layer < 2; ++layer) {
        {
            pg8::Gemm g{XB, WIN + (size_t)layer * NP * D, M, NP, D}; pg8::StaticOrder S; S.init(M, NP, G, (int)blockIdx.x);
            pg8::EpiProj E{PROJ, NP, SSQ, SMALL};
            pg8::gemm_phase<pg8::EpiProj, pg8::StaticOrder, true, true>((PG8_LAS unsigned char*)lds, g, S, E);
        }
        grid.sync();
        { PH_IDS(); phase_compress(P, layer, gw, NGW, lane); }
        for (int sg = blockIdx.x; sg < 256; sg += G) { ml::m0_prep(P, layer, sg, lds); ml::m1_state(P, sg, lds); }
        grid.sync();
        ml::m2_scan(P);
        grid.sync();
        {
            const int w = blockIdx.x;
            if (w < 256) { const int bg = w >> 6, cp = w & 63; at2::unit_a(P, layer, bg >> 1, bg & 1, cp, lds); at2::unit_a(P, layer, bg >> 1, bg & 1, 127 - cp, lds); }
            for (int u = w; u < 512; u += G) { const int bg = u >> 7; at2::unit_c(P, layer, bg >> 1, bg & 1, u & 127, lds); }
        }
        for (int sg = blockIdx.x; sg < 256; sg += G) ml::m3_out(P, layer, sg, lds);
        grid.sync();
        {
            pg8::Gemm g{MIX, WOUT + (size_t)layer * D * D, M, D, D}; pg8::StaticOrder S; S.init(M, D, G, (int)blockIdx.x);
            pg8::EpiOut E{layer == 0 ? P.x : P.out, P.out, XB, SSQ, D};
            pg8::gemm_phase<pg8::EpiOut, pg8::StaticOrder, true, true>((PG8_LAS unsigned char*)lds, g, S, E);
        }
        grid.sync();
    }
    { PH_IDS(); phase_final(P, gw, NGW, lane); }
}

extern "C" void kernel_launch(void* const* d_in, const int* in_sizes, int n_in, void* d_out, int out_size, void* d_ws, size_t ws_size, hipStream_t stream) {
    static int grid = 0;
    if (grid == 0) {
        if (n_in != 17 || out_size != M * D || ws_size < WS_END) { fprintf(stderr, "kernel_launch: unexpected shapes (n_in %d out %d ws %zu)\n", n_in, out_size, ws_size); grid = -1; return; }
        int dev = 0, cus = 0, per_cu = 0;
        (void)hipGetDevice(&dev); (void)hipDeviceGetAttribute(&cus, hipDeviceAttributeMultiprocessorCount, dev);
        (void)hipFuncSetAttribute((const void*)hymba_fwd, hipFuncAttributeMaxDynamicSharedMemorySize, LDS_BYTES);
        (void)hipOccupancyMaxActiveBlocksPerMultiprocessor(&per_cu, (const void*)hymba_fwd, 512, LDS_BYTES);
        if (per_cu < 1) { fprintf(stderr, "kernel_launch: occupancy query reports %d blocks per CU\n", per_cu); grid = -1; return; }
        grid = cus;
    }
    if (grid < 0) return;
    Params p{};
    p.x = (const float*)d_in[0]; p.norm_g = (const float*)d_in[1]; p.w_in = (const float*)d_in[2]; p.w_out = (const float*)d_in[3];
    p.pe_k = (const float*)d_in[4]; p.w1_k = (const float*)d_in[5]; p.w2_k = (const float*)d_in[6]; p.pe_v = (const float*)d_in[7]; p.w1_v = (const float*)d_in[8]; p.w2_v = (const float*)d_in[9];
    p.conv_w = (const float*)d_in[10]; p.conv_b = (const float*)d_in[11]; p.i_bias = (const float*)d_in[12]; p.f_bias = (const float*)d_in[13]; p.mnorm_g = (const float*)d_in[14];
    p.sinks = (const float*)d_in[15]; p.final_g = (const float*)d_in[16]; p.out = (float*)d_out; p.ws = (unsigned char*)d_ws;
    void* args[] = {&p};
    hipError_t e = hipLaunchCooperativeKernel((const void*)hymba_fwd, dim3(grid), dim3(512), args, LDS_BYTES, stream);
    if (e != hipSuccess) fprintf(stderr, "kernel_launch: cooperative launch failed: %s (grid %d)\n", hipGetErrorString(e), grid);
}
```

```cpp
#include <hip/hip_runtime.h>
#include <hip/hip_cooperative_groups.h>
#include <cstdio>
#include <cstdint>
namespace cg = cooperative_groups;
__device__ __forceinline__ int tidx_(int wv) { int l; asm volatile("v_mbcnt_lo_u32_b32 %0, -1, 0\n\tv_mbcnt_hi_u32_b32 %0, -1, %0" : "=v"(l)); return wv * 64 + l; }
namespace pg8 {
#define PG8_LAS __attribute__((address_space(3)))
typedef unsigned short bf16_t;
typedef short bf16x8 __attribute__((ext_vector_type(8)));
typedef float f32x4 __attribute__((ext_vector_type(4)));
typedef unsigned u32x4 __attribute__((ext_vector_type(4)));
constexpr int BM = 256, BK = 64, HALF = 128, HTB = HALF * BK * 2  , STAGE_BYTES = 8 * HTB, NXCD = 8, WGM = 8;

__host__ __device__ __forceinline__ int lds_byte(int r, int c) { const int st = (r >> 4) * 2 + (c >> 5), rr = r & 15, cc = c & 31, ob = rr * 64 + cc * 2; return st * 1024 + (ob ^ (((ob >> 9) & 1) << 5)); }
__host__ __device__ __forceinline__ void stage_rc(int b, int& R, int& C) { const int st = b / 1024, sb = b % 1024, swz = sb ^ (((sb >> 9) & 1) << 5); R = (st >> 1) * 16 + swz / 64; C = (st & 1) * 32 + (swz % 64) / 2; }
__host__ __device__ __forceinline__ int perm32(int rho) { const int n = rho >> 4, i = rho & 15; return 8 * (i >> 2) + 4 * n + (i & 3); }

struct Unit { int pm, pn; };
struct Gemm { const bf16_t* A; const bf16_t* Bt; int M, N, K, wv; };

struct StaticOrder {
    int nM, nN, nwg, G, c;
    __host__ __device__ void init(int M, int N, int G_, int c_) { nM = M / BM; nN = N / BM; nwg = nM * nN; G = G_; c = c_; }
    __host__ __device__ bool next(int i, Unit& u) const {
        const long L = (long)i * G + c; if (L >= nwg) return false;
        int wgid = (int)L; { const int q = nwg / NXCD, r = nwg % NXCD, xcd = wgid % NXCD, off = wgid / NXCD; wgid = (xcd < r ? xcd * (q + 1) : r * (q + 1) + (xcd - r) * q) + off; }
        const int nig = WGM * nN, gid = wgid / nig, fm = gid * WGM, gsz = (nM - fm) < WGM ? (nM - fm) : WGM;
        u.pm = fm + ((wgid % nig) % gsz); u.pn = (wgid % nig) / gsz; return true;
    }
    __device__ __forceinline__ void a_ready(const Unit&) const {}
    __device__ __forceinline__ void done(const Unit&) const {}
};

__device__ __forceinline__ unsigned cvt_pk_bf16(float lo, float hi) { unsigned r; asm volatile("v_cvt_pk_bf16_f32 %0, %1, %2" : "=v"(r) : "v"(lo), "v"(hi)); return r; }
typedef float f32x2 __attribute__((ext_vector_type(2)));
struct EpiProj {
    static constexpr bool PERM = true, AFTER_DRAIN = false;
    bf16_t* O; int ldc; const float* ssq; float* small_;
    __device__ __forceinline__ void operator()(const f32x4 (&acc)[2][2][4][2], const Unit& u, int wr, int wc, int fr, int fq) const {
        const int row0 = u.pm * BM + wr * 64 + fr;
        float mine[2];
#pragma unroll
        for (int q = 0; q < 2; ++q) { const int idx = 2 * fq + q; const int row = row0 + (idx >> 2) * HALF + (idx & 3) * 16;
            const f32x4* sp = (const f32x4*)(ssq + (size_t)row * 32); f32x4 s4 = sp[0];
#pragma unroll
            for (int j = 1; j < 8; ++j) s4 += sp[j];
            mine[q] = 1.0f / sqrtf(((s4[0] + s4[1]) + (s4[2] + s4[3])) * (1.0f / 2048.0f) + 1.0e-6f); }
#pragma unroll
        for (int ai = 0; ai < 2; ++ai)
#pragma unroll
            for (int m = 0; m < 4; ++m) {
                const int row = row0 + ai * HALF + m * 16; const int idx = ai * 4 + m;
                const float rstd = __shfl(mine[idx & 1], fr + 16 * (idx >> 1));
                if (u.pn < 32) {
                    bf16_t* rowp = O + (size_t)row * ldc + u.pn * BM + wc * 32 + 8 * fq;
#pragma unroll
                    for (int bj = 0; bj < 2; ++bj) { const f32x4 v0 = acc[ai][bj][m][0] * rstd, v1 = acc[ai][bj][m][1] * rstd;
                        u32x4 w; w.x = cvt_pk_bf16(v0[0], v0[1]); w.y = cvt_pk_bf16(v0[2], v0[3]); w.z = cvt_pk_bf16(v1[0], v1[1]); w.w = cvt_pk_bf16(v1[2], v1[3]);
                        *(u32x4*)(rowp + bj * HALF) = w; }
                } else if (wc == 0) {
                    float* sp2 = small_ + (size_t)row * 32 + 8 * fq;
                    *(f32x4*)(sp2) = acc[ai][0][m][0] * rstd; *(f32x4*)(sp2 + 4) = acc[ai][0][m][1] * rstd;
                }
            }
    }
};
struct EpiOut {
    static constexpr bool PERM = true, AFTER_DRAIN = false;
    bf16_t* xb; float* ssq; int ldc;
    __device__ __forceinline__ void operator()(const f32x4 (&acc)[2][2][4][2], const Unit& u, int wr, int wc, int fr, int fq) const {
        const int row0 = u.pm * BM + wr * 64 + fr, col0 = u.pn * BM + wc * 32 + 8 * fq;
#pragma unroll
        for (int ai = 0; ai < 2; ++ai) {
            u32x4 xv[4][2];
#pragma unroll
            for (int m = 0; m < 4; ++m)
#pragma unroll
                for (int bj = 0; bj < 2; ++bj) xv[m][bj] = *(const u32x4*)(xb + (size_t)(row0 + ai * HALF + m * 16) * ldc + col0 + bj * HALF);
            asm volatile("" ::: "memory");
#pragma unroll
            for (int m = 0; m < 4; ++m) {
                const int row = row0 + ai * HALF + m * 16; float s = 0.f;
#pragma unroll
                for (int bj = 0; bj < 2; ++bj) { const u32x4 x = xv[m][bj]; f32x4 v0 = acc[ai][bj][m][0], v1 = acc[ai][bj][m][1];
                    v0[0] += __uint_as_float(x.x << 16); v0[1] += __uint_as_float(x.x & 0xffff0000u); v0[2] += __uint_as_float(x.y << 16); v0[3] += __uint_as_float(x.y & 0xffff0000u);
                    v1[0] += __uint_as_float(x.z << 16); v1[1] += __uint_as_float(x.z & 0xffff0000u); v1[2] += __uint_as_float(x.w << 16); v1[3] += __uint_as_float(x.w & 0xffff0000u);
                    u32x4 w; w.x = cvt_pk_bf16(v0[0], v0[1]); w.y = cvt_pk_bf16(v0[2], v0[3]); w.z = cvt_pk_bf16(v1[0], v1[1]); w.w = cvt_pk_bf16(v1[2], v1[3]);
                    *(u32x4*)(xb + (size_t)row * ldc + col0 + bj * HALF) = w;
                    s += ((v0[0] * v0[0] + v0[1] * v0[1]) + (v0[2] * v0[2] + v0[3] * v0[3])) + ((v1[0] * v1[0] + v1[1] * v1[1]) + (v1[2] * v1[2] + v1[3] * v1[3])); }
                s += __shfl_xor(s, 16); s += __shfl_xor(s, 32);
                if (fq == 0) ssq[(size_t)row * 32 + u.pn * 4 + wc] = s;
            }
        }
    }
};
struct OneUnit { int pm, pn;
    __device__ __forceinline__ bool next(int i, Unit& u) const { if (i != 0) return false; u.pm = pm; u.pn = pn; return true; }
    __device__ __forceinline__ void a_ready(const Unit&) const {}
    __device__ __forceinline__ void done(const Unit&) const {} };
template <class Epi, class Sched, bool ALIGN_EPI = false, bool SP2 = false>
__device__ __forceinline__ void gemm_phase(PG8_LAS unsigned char* lds, const Gemm g, const Sched& S, const Epi& E) {
    int tid_ = tidx_(g.wv); const int tid = tid_, wid = __builtin_amdgcn_readfirstlane(tid >> 6), lane = tid & 63, wr = wid >> 2, wc = wid & 3, fr = lane & 15, fq = lane >> 4;
    const int K = g.K, nt = K / BK;
    unsigned voffA[2], voffB[2];
#pragma unroll
    for (int i = 0; i < 2; ++i) { int R, C; stage_rc(tid * 16 + i * 8192, R, C); const int Rb = Epi::PERM ? ((R & ~31) + perm32(R & 31)) : R;
        voffA[i] = (unsigned)(R * K + C) * 2u; voffB[i] = (unsigned)(Rb * K + C) * 2u; }
    const size_t kstep = (size_t)(BK * 2);
    const size_t hstep = (size_t)HALF * K * 2;
    const size_t tstep = 2 * hstep;
    const unsigned ldsw = (unsigned)wid * 1024u;
    const int aoff = lds_byte(wr * 64 + fr, fq * 8), boff = lds_byte(wc * 32 + fr, fq * 8);
#define PG8_SA(b, h) (((b) * 2 + (h)) * HTB)
#define PG8_SB(b, h) ((4 + (b) * 2 + (h)) * HTB)
#define PG8_STAGE(bufoff, gbase, voff) do { _Pragma("unroll") for (int _i = 0; _i < 2; ++_i) \
        __builtin_amdgcn_global_load_lds((const unsigned*)((const char*)(gbase) + (voff)[_i]), (PG8_LAS unsigned*)(lds + (bufoff) + ldsw + _i * 8192), 16, 0, 0); } while (0)
#define PG8_LDA(dst, b, h) do { _Pragma("unroll") for (int m = 0; m < 4; ++m) _Pragma("unroll") for (int k = 0; k < 2; ++k) dst[m][k] = *(const PG8_LAS bf16x8*)(lds + PG8_SA(b, h) + aoff + m * 2048 + k * 1024); } while (0)
#define PG8_LDB(dst, b, h) do { _Pragma("unroll") for (int n = 0; n < 2; ++n) _Pragma("unroll") for (int k = 0; k < 2; ++k) dst[n][k] = *(const PG8_LAS bf16x8*)(lds + PG8_SB(b, h) + boff + n * 2048 + k * 1024); } while (0)
#define PG8_MMA(ai, bj, At, Bt) do { __builtin_amdgcn_s_setprio(1); _Pragma("unroll") for (int m = 0; m < 4; ++m) _Pragma("unroll") for (int n = 0; n < 2; ++n) _Pragma("unroll") for (int k = 0; k < 2; ++k) \
        acc[ai][bj][m][n] = __builtin_amdgcn_mfma_f32_16x16x32_bf16(Bt[n][k], At[m][k], acc[ai][bj][m][n], 0, 0, 0); __builtin_amdgcn_s_setprio(0); } while (0)
#define PG8_WAIT_V(n) asm volatile("s_waitcnt vmcnt(" #n ")" ::: "memory")
#define PG8_WAIT_L(n) asm volatile("s_waitcnt lgkmcnt(" #n ")" ::: "memory")
#define PG8_BAR __builtin_amdgcn_s_barrier()
#define PG8_SCHED __builtin_amdgcn_sched_barrier(0)
    Unit cur, nxt; int ui = 0;
    if (!S.next(0, cur)) return;
    f32x4 acc[2][2][4][2];
#pragma unroll
    for (int a = 0; a < 2; ++a)
#pragma unroll
        for (int b = 0; b < 2; ++b)
#pragma unroll
            for (int m = 0; m < 4; ++m)
#pragma unroll
                for (int n = 0; n < 2; ++n) acc[a][b][m][n] = (f32x4){0.f, 0.f, 0.f, 0.f};
    bf16x8 At[4][2], B0[2][2], B1[2][2];
    const char* cA = (const char*)g.A + (size_t)cur.pm * tstep; const char* cB = (const char*)g.Bt + (size_t)cur.pn * tstep;
    S.a_ready(cur);
    if constexpr (SP2) {
        PG8_STAGE(PG8_SB(0, 0), cB, voffB); PG8_STAGE(PG8_SB(0, 1), cB + hstep, voffB); PG8_STAGE(PG8_SA(0, 0), cA, voffA); PG8_STAGE(PG8_SA(0, 1), cA + hstep, voffA);
        if (wr == 1) PG8_BAR;
        PG8_WAIT_V(2); PG8_BAR;
        PG8_STAGE(PG8_SB(1, 0), cB + kstep, voffB); PG8_STAGE(PG8_SA(1, 0), cA + kstep, voffA); PG8_STAGE(PG8_SB(1, 1), cB + hstep + kstep, voffB);
        PG8_WAIT_V(6); PG8_BAR;
    } else {
        PG8_STAGE(PG8_SB(0, 0), cB, voffB); PG8_STAGE(PG8_SA(0, 0), cA, voffA); PG8_STAGE(PG8_SB(0, 1), cB + hstep, voffB); PG8_STAGE(PG8_SA(0, 1), cA + hstep, voffA);
        if (wr == 1) PG8_BAR;
        PG8_WAIT_V(4); PG8_BAR;
        PG8_STAGE(PG8_SB(1, 0), cB + kstep, voffB); PG8_STAGE(PG8_SA(1, 0), cA + kstep, voffA); PG8_STAGE(PG8_SB(1, 1), cB + hstep + kstep, voffB);
        PG8_WAIT_V(6); PG8_BAR;
    }
    for (;;) {
        const bool has_next = S.next(ui + 1, nxt);
        const char* nA = has_next ? (const char*)g.A + (size_t)nxt.pm * tstep : cA; const char* nB = has_next ? (const char*)g.Bt + (size_t)nxt.pn * tstep : cB;
        for (int t = 0; t < nt; t += 2) {
            const bool last = (t == nt - 2);
            const char* a1 = cA + (size_t)(t + 1) * kstep;
            const char* a2 = last ? nA : cA + (size_t)(t + 2) * kstep; const char* b2 = last ? nB : cB + (size_t)(t + 2) * kstep;
            const char* a3 = a2 + kstep; const char* b3 = b2 + kstep;
            if (last && has_next) S.a_ready(nxt);
            if constexpr (SP2) {
            PG8_LDB(B0, 0, 0); PG8_LDB(B1, 0, 1); PG8_SCHED; PG8_LDA(At, 0, 0); PG8_STAGE(PG8_SA(1, 1), a1 + hstep, voffA);
            PG8_WAIT_V(8); PG8_WAIT_L(0); PG8_BAR; PG8_MMA(0, 0, At, B0); PG8_MMA(0, 1, At, B1); PG8_BAR; PG8_SCHED;
            PG8_LDA(At, 0, 1); PG8_STAGE(PG8_SB(0, 0), b2, voffB); PG8_STAGE(PG8_SB(0, 1), b2 + hstep, voffB); PG8_STAGE(PG8_SA(0, 0), a2, voffA);
            PG8_WAIT_V(8); PG8_WAIT_L(0); PG8_BAR; PG8_MMA(1, 0, At, B0); PG8_MMA(1, 1, At, B1); PG8_BAR; PG8_SCHED;
            PG8_LDB(B0, 1, 0); PG8_LDB(B1, 1, 1); PG8_SCHED; PG8_LDA(At, 1, 0); PG8_STAGE(PG8_SA(0, 1), a2 + hstep, voffA);
            PG8_WAIT_V(8); PG8_WAIT_L(0); PG8_BAR; PG8_MMA(0, 0, At, B0); PG8_MMA(0, 1, At, B1); PG8_BAR; PG8_SCHED;
            PG8_LDA(At, 1, 1); PG8_STAGE(PG8_SB(1, 0), b3, voffB); PG8_STAGE(PG8_SB(1, 1), b3 + hstep, voffB); PG8_STAGE(PG8_SA(1, 0), a3, voffA);
            PG8_WAIT_V(8); PG8_WAIT_L(0); PG8_BAR; PG8_MMA(1, 0, At, B0); PG8_MMA(1, 1, At, B1); PG8_BAR; PG8_SCHED;
            } else {
            PG8_LDB(B0, 0, 0); PG8_SCHED; PG8_LDA(At, 0, 0); PG8_STAGE(PG8_SA(1, 1), a1 + hstep, voffA);
            PG8_WAIT_L(8); PG8_BAR; PG8_WAIT_L(0); PG8_MMA(0, 0, At, B0); PG8_BAR; PG8_SCHED;
            PG8_LDB(B1, 0, 1); PG8_STAGE(PG8_SB(0, 0), b2, voffB);
            PG8_BAR; PG8_WAIT_L(0); PG8_MMA(0, 1, At, B1); PG8_BAR;
            PG8_LDA(At, 0, 1); PG8_STAGE(PG8_SA(0, 0), a2, voffA);
            PG8_BAR; PG8_WAIT_L(0); PG8_MMA(1, 0, At, B0); PG8_BAR; PG8_SCHED;
            PG8_STAGE(PG8_SB(0, 1), b2 + hstep, voffB);
            PG8_WAIT_V(6); PG8_BAR; PG8_MMA(1, 1, At, B1); PG8_BAR;
            PG8_LDB(B0, 1, 0); PG8_SCHED; PG8_LDA(At, 1, 0); PG8_STAGE(PG8_SA(0, 1), a2 + hstep, voffA);
            PG8_WAIT_L(8); PG8_BAR; PG8_WAIT_L(0); PG8_MMA(0, 0, At, B0); PG8_BAR; PG8_SCHED;
            PG8_LDB(B1, 1, 1); PG8_STAGE(PG8_SB(1, 0), b3, voffB);
            PG8_BAR; PG8_WAIT_L(0); PG8_MMA(0, 1, At, B1); PG8_BAR;
            PG8_LDA(At, 1, 1); PG8_STAGE(PG8_SA(1, 0), a3, voffA);
            PG8_BAR; PG8_WAIT_L(0); PG8_MMA(1, 0, At, B0); PG8_BAR; PG8_SCHED;
            PG8_STAGE(PG8_SB(1, 1), b3 + hstep, voffB);
            PG8_WAIT_V(6); PG8_BAR; PG8_MMA(1, 1, At, B1); PG8_BAR;
            }
        }
        if constexpr (ALIGN_EPI) { if (wr == 0) PG8_BAR; }
#ifdef PG8_PROBE
        const unsigned long long e0_ = __builtin_amdgcn_s_memrealtime();
#endif
        if constexpr (!Epi::AFTER_DRAIN) { E(acc, cur, wr, wc, fr, fq); S.done(cur); }
#ifdef PG8_PROBE
        if (wid == 0) { const unsigned long long d_ = __builtin_amdgcn_s_memrealtime() - e0_; volatile PG8_LAS unsigned long long* pa_ = (volatile PG8_LAS unsigned long long*)(lds + 155592); *pa_ = *pa_ + d_; }
#endif
        if (!has_next) break;
#pragma unroll
        for (int a = 0; a < 2; ++a)
#pragma unroll
            for (int b = 0; b < 2; ++b)
#pragma unroll
                for (int m = 0; m < 4; ++m)
#pragma unroll
                    for (int n = 0; n < 2; ++n) acc[a][b][m][n] = (f32x4){0.f, 0.f, 0.f, 0.f};
        cur = nxt; cA = nA; cB = nB; ++ui;
        if constexpr (ALIGN_EPI) { if (wr == 1) PG8_BAR; }
    }
    PG8_WAIT_V(0);
    if constexpr (!ALIGN_EPI) { if (wr == 0) PG8_BAR; }
    PG8_BAR;
    if constexpr (Epi::AFTER_DRAIN) { E.fused(acc, cur, wr, wc, fr, fq, lds, wid, lane); S.done(cur); }
#undef PG8_SA
#undef PG8_SB
#undef PG8_STAGE
#undef PG8_LDA
#undef PG8_LDB
#undef PG8_MMA
#undef PG8_WAIT_V
#undef PG8_WAIT_L
#undef PG8_BAR
#undef PG8_SCHED
}
}
constexpr int BATCH = 2, T = 8192, M = BATCH * T, D = 2048, NP = 8448, NIN = 8224;
constexpr int C_AQ = 0, C_AKC = 512, C_AVC = 640, C_AKS = 768, C_AVS = 896, C_AKW = 1024, C_AVW = 1152, C_AZ = 1280, C_BQ = 1792, C_BK = 2816, C_BV = 3840, C_BO = 4864, C_BZ = 5888,
              C_CQ = 6912, C_CK = 7424, C_CV = 7552, C_CZ = 7680;
constexpr int S_GATE = 0, S_I = 24, S_F = 28;
constexpr int NCMP = 511, CMP_PITCH = 512;
constexpr float EPS = 1.0e-6f, NEG = -1.0e30f;
constexpr size_t MiB = 1u << 20;
constexpr size_t WS_WIN = 0, WS_WOUT = 66 * MiB, WS_XB = 82 * MiB, WS_PROJ = 146 * MiB, WS_MIX = 410 * MiB, WS_SMALL = 474 * MiB, WS_SSQ = 476 * MiB, WS_KCMP = 478 * MiB, WS_VCMP = WS_KCMP + 512 * 1024, WS_END = 514 * MiB;
constexpr size_t WS_BAR = 513 * MiB + 65536;
constexpr int LDS_BYTES = 155648;
typedef unsigned short bf16;
typedef float f4 __attribute__((ext_vector_type(4)));
typedef unsigned u4 __attribute__((ext_vector_type(4)));

__device__ __forceinline__ float bf2f(unsigned short u) { return __uint_as_float(((unsigned)u) << 16); }
typedef float f32x2_hw __attribute__((ext_vector_type(2))); typedef __bf16 bf16x2_hw __attribute__((ext_vector_type(2)));
__device__ __forceinline__ unsigned pk2(float lo, float hi) { f32x2_hw v = {lo, hi}; bf16x2_hw r = __builtin_convertvector(v, bf16x2_hw); return __builtin_bit_cast(unsigned, r); }
__device__ __forceinline__ unsigned f2bf(float f) { return pk2(f, 0.f) & 0xffffu; }
__device__ __forceinline__ float wsum(float v) {
#pragma unroll
    for (int o = 1; o < 64; o <<= 1) v += __shfl_xor(v, o);
    return v; }
__device__ __forceinline__ float wmax(float v) {
#pragma unroll
    for (int o = 1; o < 64; o <<= 1) v = fmaxf(v, __shfl_xor(v, o));
    return v; }
__device__ __forceinline__ float sigmoidf_(float x) { return __builtin_amdgcn_rcpf(1.0f + __expf(-x)); }
__device__ __forceinline__ float siluf_(float x) { return x * __builtin_amdgcn_rcpf(1.0f + __expf(-x)); }
__device__ __forceinline__ float logsigmoidf_(float x) { return fminf(x, 0.f) - log1pf(__expf(-fabsf(x))); }

struct Params {
    const float* x; const float* norm_g; const float* w_in; const float* w_out;
    const float* pe_k; const float* w1_k; const float* w2_k; const float* pe_v; const float* w1_v; const float* w2_v;
    const float* conv_w; const float* conv_b; const float* i_bias; const float* f_bias; const float* mnorm_g; const float* sinks; const float* final_g;
    float* out; unsigned char* ws; int wv;
};

__device__ __forceinline__ int orig_col(int n) {
    if (n < 1280) return n;
    if (n < 4864) return n + 24;
    if (n < 8192) return n + 32;
    if (n < 8216) return 1280 + (n - 8192);
    if (n < 8224) return 4888 + (n - 8216);
    return -1;
}

__device__ __forceinline__ void transpose_item(const float* W, int K, int Nsrc, bool mapped, const float* g, bf16* WT, int nblk, float* scr, int item, int lane) {
    const int kb = item / nblk, nb = item % nblk, k0 = 64 * kb, n0 = 32 * nb;
    const int n = n0 + (lane & 31); const int oc = mapped ? orig_col(n) : n;
#pragma unroll 8
    for (int i = 0; i < 32; ++i) { const int kk = 2 * i + (lane >> 5); float v = 0.f;
        if (oc >= 0) { v = W[(size_t)(k0 + kk) * Nsrc + oc]; if (g) v *= g[k0 + kk]; }
        scr[kk * 33 + (lane & 31)] = v; }
    __builtin_amdgcn_wave_barrier(); asm volatile("s_waitcnt lgkmcnt(0)" ::: "memory");
    const int c = lane & 7;
#pragma unroll
    for (int j = 0; j < 4; ++j) { const int nn = (lane >> 3) + 8 * j; const float* s = scr + (8 * c) * 33 + nn;
        u4 o; o.x = pk2(s[0 * 33], s[1 * 33]); o.y = pk2(s[2 * 33], s[3 * 33]); o.z = pk2(s[4 * 33], s[5 * 33]); o.w = pk2(s[6 * 33], s[7 * 33]);
        *(u4*)(WT + (size_t)(n0 + nn) * K + k0 + 8 * c) = o; }
    __builtin_amdgcn_wave_barrier(); asm volatile("s_waitcnt lgkmcnt(0)" ::: "memory");
}
__device__ __forceinline__ void transpose_tile(const float* W, int K, int Nsrc, bool mapped, const float* g, bf16* WT, int ntile, unsigned char* lds, int tile, int tid) {
    float* tl = (float*)lds; const int kb = tile / ntile, nb = tile % ntile, k0 = 64 * kb, n0 = 256 * nb;
    __syncthreads();
    { const int c4 = tid & 63, r0 = tid >> 6; const int n = n0 + c4 * 4; const int oc = mapped ? orig_col(n) : n;
      float gs[8];
#pragma unroll
      for (int i = 0; i < 8; ++i) gs[i] = g ? g[k0 + r0 + 8 * i] : 1.0f;
      f4 wv[8];
#pragma unroll
      for (int i = 0; i < 8; ++i) { wv[i] = (f4){0.f, 0.f, 0.f, 0.f}; if (oc >= 0) wv[i] = *(const f4*)(W + (size_t)(k0 + r0 + 8 * i) * Nsrc + oc); }
#pragma unroll
      for (int i = 0; i < 8; ++i) { const int kk = r0 + 8 * i; f4 v = wv[i] * gs[i];
          float* d = tl + kk * 257 + c4 * 4; d[0] = v[0]; d[1] = v[1]; d[2] = v[2]; d[3] = v[3]; } }
    __syncthreads();
    { const int c = tid & 7, nn0 = tid >> 3;
#pragma unroll
      for (int j = 0; j < 4; ++j) { const int nn = nn0 + 64 * j; const float* s = tl + (8 * c) * 257 + nn;
          u4 o; o.x = pk2(s[0 * 257], s[1 * 257]); o.y = pk2(s[2 * 257], s[3 * 257]); o.z = pk2(s[4 * 257], s[5 * 257]); o.w = pk2(s[6 * 257], s[7 * 257]);
          *(u4*)(WT + (size_t)(n0 + nn) * K + k0 + 8 * c) = o; } }
}
struct PTile { const float* W; const float* g; bf16* WT; int Nsrc, k0, n0; bool mapped; };
__device__ __forceinline__ PTile ptile_of(const Params& P, int it) {
    constexpr int T_IN = (D / 64) * (NP / 256), T_OUT = (D / 64) * (D / 256);
    PTile t; int r = it;
    if (r < 2 * T_IN) { const int l = r / T_IN; r -= l * T_IN; t.W = P.w_in + (size_t)l * D * NIN; t.g = P.norm_g + l * D; t.WT = (bf16*)(P.ws + WS_WIN) + (size_t)l * NP * D; t.Nsrc = NIN; t.mapped = true;
        t.k0 = 64 * (r / (NP / 256)); t.n0 = 256 * (r % (NP / 256)); }
    else { r -= 2 * T_IN; const int l = r / T_OUT; r -= l * T_OUT; t.W = P.w_out + (size_t)l * D * D; t.g = nullptr; t.WT = (bf16*)(P.ws + WS_WOUT) + (size_t)l * D * D; t.Nsrc = D; t.mapped = false;
        t.k0 = 64 * (r / (D / 256)); t.n0 = 256 * (r % (D / 256)); }
    return t;
}
__device__ __forceinline__ void phase_prologue(const Params& P, unsigned char* lds, int gw, int NGW, int wave, int lane) {
    constexpr int T_IN = (D / 64) * (NP / 256), T_OUT = (D / 64) * (D / 256), NTILES = 2 * T_IN + 2 * T_OUT;
    const int tid = wave * 64 + lane; float* tl = (float*)lds;
    const int c4 = tid & 63, r0 = tid >> 6;
    float gs[8]; f4 wv[8];
#define PT_LOAD(t) do { const int n_ = (t).n0 + c4 * 4; const int oc_ = (t).mapped ? orig_col(n_) : n_; \
        _Pragma("unroll") for (int i = 0; i < 8; ++i) gs[i] = (t).g ? (t).g[(t).k0 + r0 + 8 * i] : 1.0f; \
        _Pragma("unroll") for (int i = 0; i < 8; ++i) { wv[i] = (f4){0.f, 0.f, 0.f, 0.f}; if (oc_ >= 0) wv[i] = *(const f4*)((t).W + (size_t)((t).k0 + r0 + 8 * i) * (t).Nsrc + oc_); } } while (0)
    int it = blockIdx.x;
    if (it < NTILES) { const PTile t = ptile_of(P, it); PT_LOAD(t); }
    for (; it < NTILES; it += gridDim.x) {
        const PTile t = ptile_of(P, it);
        __syncthreads();
#pragma unroll
        for (int i = 0; i < 8; ++i) { const int kk = r0 + 8 * i; const f4 v = wv[i] * gs[i];
            float* d = tl + kk * 257 + c4 * 4; d[0] = v[0]; d[1] = v[1]; d[2] = v[2]; d[3] = v[3]; }
        if (it + (int)gridDim.x < NTILES) { const PTile tn = ptile_of(P, it + (int)gridDim.x); PT_LOAD(tn); }
        __syncthreads();
        { const int c = tid & 7, nn0 = tid >> 3;
#pragma unroll
          for (int j = 0; j < 4; ++j) { const int nn = nn0 + 64 * j; const float* s = tl + (8 * c) * 257 + nn;
              u4 o; o.x = pk2(s[0 * 257], s[1 * 257]); o.y = pk2(s[2 * 257], s[3 * 257]); o.z = pk2(s[4 * 257], s[5 * 257]); o.w = pk2(s[6 * 257], s[7 * 257]);
              *(u4*)(t.WT + (size_t)(t.n0 + nn) * D + t.k0 + 8 * c) = o; } }
    }
#undef PT_LOAD
    __syncthreads();
    bf16* XB = (bf16*)(P.ws + WS_XB); float* SSQ = (float*)(P.ws + WS_SSQ);
    f4 xv[8];
    if (gw < M) { const f4* xr = (const f4*)(P.x + (size_t)gw * D) + lane;
#pragma unroll
        for (int j = 0; j < 8; ++j) xv[j] = xr[64 * j]; }
    for (int m = gw; m < M; m += NGW) {
        unsigned long long* o8 = (unsigned long long*)(XB + (size_t)m * D) + lane; float s = 0.f;
        unsigned long long ov[8];
#pragma unroll
        for (int j = 0; j < 8; ++j) { const f4 v = xv[j]; s += (v[0] * v[0] + v[1] * v[1]) + (v[2] * v[2] + v[3] * v[3]); ov[j] = (unsigned long long)pk2(v[0], v[1]) | ((unsigned long long)pk2(v[2], v[3]) << 32); }
        if (m + NGW < M) { const f4* xr = (const f4*)(P.x + (size_t)(m + NGW) * D) + lane;
#pragma unroll
            for (int j = 0; j < 8; ++j) xv[j] = xr[64 * j]; }
        asm volatile("" ::: "memory");
#pragma unroll
        for (int j = 0; j < 8; ++j) o8[64 * j] = ov[j];
        s = wsum(s);
        if (lane < 32) SSQ[(size_t)m * 32 + lane] = (lane == 0) ? s : 0.f;
    }
}

__device__ __forceinline__ void phase_compress(const Params& P, int layer, int gw, int NGW, int lane) {
    const bf16* PROJ = (const bf16*)(P.ws + WS_PROJ); bf16* KC = (bf16*)(P.ws + WS_KCMP);
    for (int it = gw; it < 2 * 2 * 2 * CMP_PITCH; it += NGW) {
        const int i = it % CMP_PITCH; int r = it / CMP_PITCH; const int g = r & 1; r >>= 1; const int b = r & 1; const int kv = r >> 1;
        bf16* dst = KC + ((size_t)(b * 2 + g) * CMP_PITCH + i) * 128 + kv * 64;
        if (i >= NCMP) { dst[lane] = 0; continue; }
        const float* pe = (kv ? P.pe_v : P.pe_k) + (size_t)layer * 32 * 64;
        const float* w1 = (kv ? P.w1_v : P.w1_k) + (size_t)layer * 2048 * 64;
        const float* w2 = (kv ? P.w2_v : P.w2_k) + (size_t)layer * 64 * 64;
        const bf16* src = PROJ + (size_t)(b * T + 16 * i) * NP + (kv ? C_AVC : C_AKC) + g * 64;
        float hid = 0.f;
        for (int l = 0; l < 32; ++l) {
            const bf16* row = src + (size_t)l * NP;
#pragma unroll 8
            for (int dd = 0; dd < 64; ++dd) { const float a = bf2f(row[dd]) + pe[l * 64 + dd]; hid += a * w1[(size_t)(l * 64 + dd) * 64 + lane]; }
        }
        hid = siluf_(hid);
        float o = 0.f;
        for (int k = 0; k < 64; ++k) o += __shfl(hid, k) * w2[k * 64 + lane];
        dst[lane] = (bf16)f2bf(o);
    }
}
#define LAS __attribute__((address_space(3)))
#define XB_TMO      128
#define XB_XCNT(j)  (256  + 64 * (j))
#define XB_XSUB(j)  (1280 + 64 * (j))
#define XB_XGEN(j)  (2304 + 64 * (j))
#define XB_TOP      3328
#define XB_TOPGEN   3392
#define XCD_BAR_WORDS 3456
#define XB_SPIN_CAP (1u << 18)

__device__ __forceinline__ unsigned xb_ld(unsigned* p)              { return __hip_atomic_load(p, __ATOMIC_RELAXED, __HIP_MEMORY_SCOPE_AGENT); }
__device__ __forceinline__ unsigned xb_add(unsigned* p, unsigned v) { return __hip_atomic_fetch_add(p, v, __ATOMIC_RELAXED, __HIP_MEMORY_SCOPE_AGENT); }
__device__ __forceinline__ unsigned xb_xcc_id() { return (unsigned)__builtin_amdgcn_s_getreg((3 << 11) | 20) & 0xFu; }
#define XB_SPIN(cond, bar) do { unsigned _sp = 0; while (cond) { __builtin_amdgcn_s_sleep(1); \
    if ((++_sp & 255u) == 0u) { if (xb_ld(&(bar)[XB_TMO])) break; if (_sp > XB_SPIN_CAP) { atomicAdd(&(bar)[XB_TMO], 1u); break; } } } } while (0)

struct XcdBarrier {
    unsigned* bar; unsigned x; int wv;
    volatile LAS unsigned* st;
};

__device__ __forceinline__ XcdBarrier xcd_barrier_post(unsigned* bar, volatile LAS unsigned* st, int wv) {
    XcdBarrier b; b.bar = bar; b.x = xb_xcc_id(); b.st = st; b.wv = wv;
    if (tidx_(wv) == 0) (void)xb_add(&bar[XB_XCNT(b.x)], 1u);
    return b;
}
__device__ __forceinline__ void xcd_barrier_complete(unsigned* bar, unsigned x, unsigned& nloc, unsigned& nx) {
    const unsigned G = gridDim.x * gridDim.y * gridDim.z;
    unsigned sum, cnt, mine, sp = 0u;
    for (;;) {
        sum = 0u; cnt = 0u; mine = 0u; unsigned cc[16];
#pragma unroll
        for (unsigned j = 0; j < 16; ++j) cc[j] = xb_ld(&bar[XB_XCNT(j)]);
#pragma unroll
        for (unsigned j = 0; j < 16; ++j) { const unsigned c = cc[j]; sum += c; cnt += (c > 0u) ? 1u : 0u; mine = (j == x) ? c : mine; }
        if (sum == G) break;
        __builtin_amdgcn_s_sleep(1);
        if ((++sp & 255u) == 0u) { if (xb_ld(&bar[XB_TMO])) break; if (sp > XB_SPIN_CAP) { atomicAdd(&bar[XB_TMO], 1u); break; } }
    }
    nloc = mine > 0u ? mine : 1u; nx = cnt > 0u ? cnt : 1u;
}

__device__ __forceinline__ void xcd_barrier(const XcdBarrier& b) {
    asm volatile("s_waitcnt vmcnt(0)" ::: "memory");
    __syncthreads();
    if (tidx_(b.wv) == 0) {
        unsigned* bar = b.bar; unsigned xq = b.x; asm volatile("" : "+s"(bar), "+s"(xq));
        __builtin_amdgcn_s_waitcnt(0);
        unsigned nloc = b.st[0], nx = b.st[1];
        if (nloc == 0u) { xcd_barrier_complete(bar, xq, nloc, nx); b.st[0] = nloc; b.st[1] = nx; }
        const unsigned old = xb_add(&bar[XB_XSUB(xq)], 1u);
        const unsigned gen = old / nloc;
        if (old + 1u == (gen + 1u) * nloc) {
            __builtin_amdgcn_fence(__ATOMIC_RELEASE, "agent");
            asm volatile("s_waitcnt vmcnt(0)" ::: "memory");
            const unsigned og = xb_add(&bar[XB_TOP], 1u);
            const unsigned tg = og / nx;
            if (og + 1u == (tg + 1u) * nx) xb_add(&bar[XB_TOPGEN], 1u);
            else XB_SPIN(xb_ld(&bar[XB_TOPGEN]) == tg, bar);
            __builtin_amdgcn_fence(__ATOMIC_ACQUIRE, "agent");
            xb_add(&bar[XB_XGEN(xq)], 1u);
            asm volatile("s_waitcnt vmcnt(0)" ::: "memory");
        } else {
            XB_SPIN(xb_ld(&bar[XB_XGEN(xq)]) == gen, bar);
            __builtin_amdgcn_fence(__ATOMIC_ACQUIRE, "agent");
            asm volatile("s_waitcnt vmcnt(0)" ::: "memory");
        }
    }
    __syncthreads();
}

namespace at2 {
typedef short bf16x8 __attribute__((ext_vector_type(8)));
typedef short s16x4 __attribute__((ext_vector_type(4)));
typedef float f32x16 __attribute__((ext_vector_type(16)));
typedef float f32x2_t __attribute__((ext_vector_type(2))); typedef __bf16 bf16x2_t __attribute__((ext_vector_type(2)));
typedef __attribute__((address_space(3))) const char* lds_cptr;
typedef short v4i16_t __attribute__((ext_vector_type(4)));
constexpr float C2 = 0.125f * 1.4426950408889634f;
constexpr float LOG2E = 1.4426950408889634f;
constexpr int IMPP = 132;
constexpr int L_KV = 0, L_ACC = 65536, L_IMP = L_ACC, L_SEL = 131072, L_WSF = 132096, L_GT = 133120, L_END = 136192;
__device__ __forceinline__ int crow(int r, int hi) { return (r & 3) + 8 * (r >> 2) + 4 * hi; }
__device__ __forceinline__ unsigned cvtpk(float lo, float hi) { f32x2_t v = {lo, hi}; bf16x2_t b = __builtin_convertvector(v, bf16x2_t); return __builtin_bit_cast(unsigned, b); }
__device__ __forceinline__ s16x4 vtr(lds_cptr p) { return __builtin_bit_cast(s16x4, __builtin_amdgcn_ds_read_tr16_b64_v4i16((__attribute__((address_space(3))) v4i16_t*)p)); }
__device__ __forceinline__ float swapmax(float m) { auto rr = __builtin_amdgcn_permlane32_swap(__float_as_uint(m), __float_as_uint(m), false, false); return fmaxf(__uint_as_float(rr[0]), __uint_as_float(rr[1])); }
__device__ __forceinline__ float swapsum(float m) { auto rr = __builtin_amdgcn_permlane32_swap(__float_as_uint(m), __float_as_uint(m), false, false); return __uint_as_float(rr[0]) + __uint_as_float(rr[1]); }
__device__ __forceinline__ float quadsum(float v) {
    v += __uint_as_float(__builtin_amdgcn_update_dpp(0u, __float_as_uint(v), 0xB1, 0xF, 0xF, true));
    v += __uint_as_float(__builtin_amdgcn_update_dpp(0u, __float_as_uint(v), 0x4E, 0xF, 0xF, true));
    return v; }

struct KVRegs { u4 k, v; };
__device__ __forceinline__ void kv_load(KVRegs& R, const bf16* base, size_t pitch, long row0, long rlo, long rhi, int kcol, int vcol, int tid) {
    const int key = tid >> 3, ch = tid & 7; long row = row0 + key; row = row < rlo ? rlo : (row > rhi ? rhi : row);
    const bf16* p = base + (size_t)row * pitch + ch * 8;
    R.k = *(const u4*)(p + kcol); R.v = *(const u4*)(p + vcol);
}
__device__ __forceinline__ void kv_store(const KVRegs& R, unsigned char* slot, int tid) {
    const int key = tid >> 3, ch = tid & 7;
    *(u4*)(slot + key * 128 + ((ch ^ (key & 7)) << 4)) = R.k;
    *(u4*)(slot + 8192 + (ch >> 2) * 4096 + (key >> 4) * 1024 + (key & 15) * 64 + (ch & 3) * 16) = R.v;
}
__device__ __forceinline__ void qk_tile(const unsigned char* ks, const bf16x8 (&qr)[4], f32x16& p0, f32x16& p1, int r32, int hi, const f32x16& cinit) {
    p0 = cinit; p1 = cinit;
_Pragma("unroll")
    for (int d0 = 0; d0 < 4; ++d0) { const int off = r32 * 128 + (((2 * d0 + hi) ^ ((r32 >> 1) & 7)) << 4);
        const bf16x8 a0 = *(const bf16x8*)(ks + off), a1 = *(const bf16x8*)(ks + off + 4096);
        p0 = __builtin_amdgcn_mfma_f32_32x32x16_bf16(a0, qr[d0], p0, 0, 0, 0); p1 = __builtin_amdgcn_mfma_f32_32x32x16_bf16(a1, qr[d0], p1, 0, 0, 0); }
}
__device__ __forceinline__ void pv_tile(const unsigned char* vs, const f32x16& p0, const f32x16& p1, f32x16 (&o)[2], int lane, int hi) {
    bf16x8 pa[4];
_Pragma("unroll")
    for (int k = 0; k < 4; ++k) { const f32x16& P = (k < 2) ? p0 : p1; const int b = (k & 1) * 8;
        u4 w; w.x = cvtpk(P[b + 0], P[b + 1]); w.y = cvtpk(P[b + 2], P[b + 3]); w.z = cvtpk(P[b + 4], P[b + 5]); w.w = cvtpk(P[b + 6], P[b + 7]); pa[k] = __builtin_bit_cast(bf16x8, w); }
    const lds_cptr vb = (lds_cptr)vs + ((lane >> 4) & 1) * 32 + (lane & 3) * 8 + (4 * hi + ((lane & 15) >> 2)) * 64;
_Pragma("unroll")
    for (int d0 = 0; d0 < 2; ++d0)
_Pragma("unroll")
        for (int k = 0; k < 4; ++k) { const s16x4 lo = vtr(vb + d0 * 4096 + k * 1024), hh = vtr(vb + d0 * 4096 + k * 1024 + 512);
            const bf16x8 vf = (bf16x8){lo[0], lo[1], lo[2], lo[3], hh[0], hh[1], hh[2], hh[3]};
            o[d0] = __builtin_amdgcn_mfma_f32_32x32x16_bf16(pa[k], vf, o[d0], 0, 0, 0); }
}
struct SM { float m, l; bool fresh; f32x16 o[2]; };
__device__ __forceinline__ void sm_init(SM& S) { S.m = 0.f; S.l = 0.f; S.fresh = true; S.o[0] = f32x16{}; S.o[1] = f32x16{}; }
__device__ __forceinline__ float vmax3(float a, float b, float c) { float d; asm("v_max3_f32 %0, %1, %2, %3" : "=v"(d) : "v"(a), "v"(b), "v"(c)); return d; }
__device__ __forceinline__ float max32(const f32x16& p, const f32x16& q) {
    float a = vmax3(p[0], p[1], p[2]), b = vmax3(q[0], q[1], q[2]);
    a = vmax3(a, p[3], p[4]); b = vmax3(b, q[3], q[4]); a = vmax3(a, p[5], p[6]); b = vmax3(b, q[5], q[6]); a = vmax3(a, p[7], p[8]); b = vmax3(b, q[7], q[8]);
    a = vmax3(a, p[9], p[10]); b = vmax3(b, q[9], q[10]); a = vmax3(a, p[11], p[12]); b = vmax3(b, q[11], q[12]); a = vmax3(a, p[13], p[14]); b = vmax3(b, q[13], q[14]);
    return vmax3(a, b, fmaxf(p[15], q[15])); }
struct Bias { bf16x8 A0, A1; unsigned w2, shb; };
__device__ __forceinline__ unsigned pk_hi16(unsigned lo_src, unsigned hi_src) { return __builtin_amdgcn_perm(hi_src, lo_src, 0x07060302u); }
__device__ __forceinline__ void bias_init(Bias& B, float slope2, int r32, int hi) {
    const float s32 = 32.0f * slope2; const unsigned shb = __float_as_uint(s32) & 0xffff0000u; const float r1 = s32 - __uint_as_float(shb); const unsigned smb = __float_as_uint(r1) & 0xffff0000u; const float r2 = r1 - __uint_as_float(smb);
    B.shb = hi ? 0u : shb; B.w2 = hi ? 0u : pk_hi16(smb, __float_as_uint(r2));
    const unsigned kb = __float_as_uint((float)r32) >> 16;
    u4 a0, a1;
    if (hi) { a0 = (u4){kb | (kb << 16), kb, 0u, 0u}; a1 = a0; }
    else { a0 = (u4){0x3F803F80u, 0x00003F80u, 0u, 0u}; a1 = (u4){0x3F803F80u, 0x3F803F80u, 0x3F803F80u, 0u}; }
    B.A0 = __builtin_bit_cast(bf16x8, a0); B.A1 = __builtin_bit_cast(bf16x8, a1);
}
__device__ __forceinline__ void qk_rel(const unsigned char* ks, const bf16x8 (&qr)[4], f32x16& p0, f32x16& p1, int r32, int hi, const Bias& B, float c, bool rowok, float slope2) {
    const float cv = hi ? slope2 : c;
    const unsigned hb = __float_as_uint(cv) & 0xffff0000u; const float r1 = cv - __uint_as_float(hb); const unsigned mb = __float_as_uint(r1) & 0xffff0000u; const float r2 = r1 - __uint_as_float(mb);
    u4 w; w.x = pk_hi16(hb, mb); w.y = pk_hi16(__float_as_uint(r2), B.shb); w.z = B.w2; w.w = 0u;
    if (!rowok && !hi) w.x = 0x0000FF80u;
    const bf16x8 bq = __builtin_bit_cast(bf16x8, w);
    p0 = __builtin_amdgcn_mfma_f32_32x32x16_bf16(B.A0, bq, f32x16{}, 0, 0, 0); p1 = __builtin_amdgcn_mfma_f32_32x32x16_bf16(B.A1, bq, f32x16{}, 0, 0, 0);
_Pragma("unroll")
    for (int d0 = 0; d0 < 4; ++d0) { const int off = r32 * 128 + (((2 * d0 + hi) ^ ((r32 >> 1) & 7)) << 4);
        const bf16x8 a0 = *(const bf16x8*)(ks + off), a1 = *(const bf16x8*)(ks + off + 4096);
        p0 = __builtin_amdgcn_mfma_f32_32x32x16_bf16(a0, qr[d0], p0, 0, 0, 0); p1 = __builtin_amdgcn_mfma_f32_32x32x16_bf16(a1, qr[d0], p1, 0, 0, 0); }
}
template <bool HASN>
__device__ __forceinline__ void sm_post(SM& S, f32x16& p0, f32x16& p1, const unsigned char* kslot, bool needmask, int relc, int relw, float* wsf, int lane, int r32, int hi, f32x16& n0, f32x16& n1) {
    if (needmask) {
_Pragma("unroll")
        for (int r = 0; r < 16; ++r) { const int c0 = (r & 3) + 8 * (r >> 2);
            p0[r] = ((c0 <= relc) && (c0 > relw)) ? p0[r] : -INFINITY; p1[r] = ((c0 + 32 <= relc) && (c0 + 32 > relw)) ? p1[r] : -INFINITY; } }
    const float tmax = swapmax(max32(p0, p1));
    const bool seen = tmax > -INFINITY; const bool trig = (tmax > 6.0f) || (S.fresh && seen && tmax < -6.0f);
    if (__any(trig)) {
        const float d = trig ? tmax : 0.f; const float alpha = S.fresh ? 1.0f : __builtin_amdgcn_exp2f(-d); S.m += d; S.l *= alpha;
        if (hi == 0) wsf[r32] = alpha;
        __builtin_amdgcn_wave_barrier(); asm volatile("s_waitcnt lgkmcnt(0)" ::: "memory");
_Pragma("unroll")
        for (int r = 0; r < 16; ++r) { const float a = wsf[crow(r, hi)]; S.o[0][r] *= a; S.o[1][r] *= a; }
        __builtin_amdgcn_wave_barrier(); asm volatile("" ::: "memory");
_Pragma("unroll")
        for (int r = 0; r < 16; ++r) { p0[r] -= d; p1[r] -= d; }
        if constexpr (HASN) {
_Pragma("unroll")
            for (int r = 0; r < 16; ++r) { n0[r] -= d; n1[r] -= d; } }
    }
    S.fresh = S.fresh && !seen;
    float ls = S.l;
_Pragma("unroll")
    for (int r = 0; r < 16; ++r) { p0[r] = __builtin_amdgcn_exp2f(p0[r]); ls += p0[r]; p1[r] = __builtin_amdgcn_exp2f(p1[r]); ls += p1[r]; }
    S.l = ls;
    pv_tile(kslot + 8192, p0, p1, S.o, lane, hi);
}
__device__ __forceinline__ void sm_tile(SM& S, const unsigned char* kslot, const bf16x8 (&qr)[4], const Bias& alibi, float rc0, float slope2, bool rowok, bool needmask, int relc, int relw, float* wsf, int lane, int r32, int hi) {
    f32x16 p0, p1; qk_rel(kslot, qr, p0, p1, r32, hi, alibi, rc0 - S.m, rowok, slope2);
    sm_post<false>(S, p0, p1, kslot, needmask, relc, relw, wsf, lane, r32, hi, p0, p1);
}
__device__ __forceinline__ void sm_tile2(SM& S, const unsigned char* slA, const unsigned char* slB, const bf16x8 (&qr)[4], const Bias& alibi, float rcA0, float rcB0, float slope2, bool okA, bool okB,
                                         bool maskA, int relcA, int relwA, bool maskB, int relcB, int relwB, float* wsf, int lane, int r32, int hi) {
    f32x16 a0, a1, b0, b1; qk_rel(slA, qr, a0, a1, r32, hi, alibi, rcA0 - S.m, okA, slope2); qk_rel(slB, qr, b0, b1, r32, hi, alibi, rcB0 - S.m, okB, slope2);
    sm_post<true>(S, a0, a1, slA, maskA, relcA, relwA, wsf, lane, r32, hi, b0, b1);
    sm_post<false>(S, b0, b1, slB, maskB, relcB, relwB, wsf, lane, r32, hi, b0, b1);
}
__device__ __forceinline__ void acc_lds(float* accw, const f32x16 (&o)[2], float fac, float* wsf, int r32, int hi, bool first) {
    __builtin_amdgcn_wave_barrier(); asm volatile("" ::: "memory");
    if (hi == 0) wsf[r32] = fac;
    __builtin_amdgcn_wave_barrier(); asm volatile("s_waitcnt lgkmcnt(0)" ::: "memory");
_Pragma("unroll")
    for (int r = 0; r < 16; ++r) { const float a = wsf[crow(r, hi)]; float* p = accw + crow(r, hi) * 64 + r32;
        if (first) { p[0] = a * o[0][r]; p[32] = a * o[1][r]; } else { p[0] += a * o[0][r]; p[32] += a * o[1][r]; } }
    __builtin_amdgcn_wave_barrier(); asm volatile("s_waitcnt lgkmcnt(0)" ::: "memory");
}
__device__ __forceinline__ void acc_reg(f32x16 (&tot)[2], const f32x16 (&o)[2], float fac, float* wsf, int r32, int hi, bool first) {
    __builtin_amdgcn_wave_barrier(); asm volatile("" ::: "memory");
    if (hi == 0) wsf[r32] = fac;
    __builtin_amdgcn_wave_barrier(); asm volatile("s_waitcnt lgkmcnt(0)" ::: "memory");
_Pragma("unroll")
    for (int r = 0; r < 16; ++r) { const float a = wsf[crow(r, hi)];
        if (first) { tot[0][r] = a * o[0][r]; tot[1][r] = a * o[1][r]; } else { tot[0][r] += a * o[0][r]; tot[1][r] += a * o[1][r]; } }
    __builtin_amdgcn_wave_barrier(); asm volatile("" ::: "memory");
}
__device__ __forceinline__ void stage_rows(float* accw, const f32x16 (&tot)[2], int r32, int hi) {
_Pragma("unroll")
    for (int r = 0; r < 16; ++r) { float* p = accw + crow(r, hi) * 64 + r32; p[0] = tot[0][r]; p[32] = tot[1][r]; }
    __builtin_amdgcn_wave_barrier(); asm volatile("s_waitcnt lgkmcnt(0)" ::: "memory");
}
__device__ __forceinline__ void out_rows(const float* accw, const bf16* zbase  , bf16* mbase  , int lane) {
    const int row = lane >> 1, half = lane & 1; const float* a = accw + row * 64 + half * 32;
    const bf16* zp = zbase + (size_t)(row >> 2) * NP + (row & 3) * 64 + half * 32; bf16* mp = mbase + (size_t)(row >> 2) * D + (row & 3) * 64 + half * 32;
    u4 zq[4];
_Pragma("unroll")
    for (int i = 0; i < 4; ++i) zq[i] = *(const u4*)(zp + i * 8);
    asm volatile("" ::: "memory");
_Pragma("unroll")
    for (int i = 0; i < 4; ++i) { const u4 zw = zq[i]; const f4 a0 = *(const f4*)(a + i * 8), a1 = *(const f4*)(a + i * 8 + 4); u4 ow;
        float y[8];
_Pragma("unroll")
        for (int e = 0; e < 4; ++e) { const float z0 = __uint_as_float(zw[e] << 16), z1 = __uint_as_float(zw[e] & 0xffff0000u); y[2 * e] = siluf_(z0); y[2 * e + 1] = siluf_(z1); }
        ow.x = pk2(a0[0] * y[0], a0[1] * y[1]); ow.y = pk2(a0[2] * y[2], a0[3] * y[3]); ow.z = pk2(a1[0] * y[4], a1[1] * y[5]); ow.w = pk2(a1[2] * y[6], a1[3] * y[7]);
        *(u4*)(mp + i * 8) = ow; }
}
__device__ __forceinline__ void load_q(bf16x8 (&qr)[4], const bf16* PROJ, size_t tok, int qcol, int hi) {
_Pragma("unroll")
    for (int d0 = 0; d0 < 4; ++d0) { const u4 w = *(const u4*)(PROJ + tok * NP + qcol + d0 * 16 + hi * 8); u4 o;
_Pragma("unroll")
        for (int e = 0; e < 4; ++e) o[e] = cvtpk(__uint_as_float(w[e] << 16) * C2, __uint_as_float(w[e] & 0xffff0000u) * C2);
        qr[d0] = __builtin_bit_cast(bf16x8, o); }
}
__device__ __forceinline__ void glds16(const void* gsrc, unsigned lds_dst) { unsigned keep;
    asm volatile("s_mov_b32 %0, m0\n\ts_mov_b32 m0, %2\n\ts_nop 0\n\tglobal_load_lds_dwordx4 %1, off\n\ts_mov_b32 m0, %0" : "=&s"(keep) : "v"(gsrc), "s"(lds_dst) : "memory"); }
__device__ __forceinline__ void kv_dma(const bf16* base, size_t pitch, long row0, long rlo, long rhi, int kcol, int vcol, unsigned slot  , int wave, int lane) {
    { const int key = 8 * wave + (lane >> 3), ch = (lane & 7) ^ ((key >> 1) & 7); long row = row0 + key; row = row < rlo ? rlo : (row > rhi ? rhi : row);
      glds16(base + (size_t)row * pitch + kcol + ch * 8, (unsigned)__builtin_amdgcn_readfirstlane(slot + wave * 1024)); }
    { const int key = 16 * (wave & 3) + (lane >> 2), ch = (wave >> 2) * 4 + (lane & 3); long row = row0 + key; row = row < rlo ? rlo : (row > rhi ? rhi : row);
      glds16(base + (size_t)row * pitch + vcol + ch * 8, (unsigned)__builtin_amdgcn_readfirstlane(slot + 8192 + wave * 1024)); }
}
#define AT2_TILE_LOOP(J0, J1, BASE, PITCH, ROWOF, RLO, RHI, KCOL, VCOL, ...) do { \
    const int jA_ = (J0), jB_ = (J1); int par_ = 0; const unsigned lds0_ = (unsigned)(uintptr_t)lds; \
    asm volatile("s_waitcnt vmcnt(0) lgkmcnt(0)" ::: "memory"); __builtin_amdgcn_s_barrier(); \
    kv_dma(BASE, PITCH, ROWOF(jB_), RLO, RHI, KCOL, VCOL, lds0_ + L_KV, wave, lane); \
    if (jB_ - 1 >= jA_) kv_dma(BASE, PITCH, ROWOF(jB_ - 1), RLO, RHI, KCOL, VCOL, lds0_ + L_KV + 16384, wave, lane); \
    for (int j = jB_; j >= jA_; j -= 2) { \
        asm volatile("s_waitcnt vmcnt(0) lgkmcnt(0)" ::: "memory"); __builtin_amdgcn_s_barrier(); asm volatile("" ::: "memory"); \
        if (j - 2 >= jA_) kv_dma(BASE, PITCH, ROWOF(j - 2), RLO, RHI, KCOL, VCOL, lds0_ + L_KV + (par_ ^ 1) * 32768, wave, lane); \
        if (j - 3 >= jA_) kv_dma(BASE, PITCH, ROWOF(j - 3), RLO, RHI, KCOL, VCOL, lds0_ + L_KV + (par_ ^ 1) * 32768 + 16384, wave, lane); \
        { const bool has2 = (j - 1 >= jA_); const unsigned char* slotA = lds + L_KV + par_ * 32768; const unsigned char* slotB = slotA + 16384; (void)has2; (void)slotB; __VA_ARGS__ } \
        par_ ^= 1; } \
    asm volatile("s_waitcnt lgkmcnt(0)" ::: "memory"); __builtin_amdgcn_s_barrier(); asm volatile("" ::: "memory"); } while (0)

#define AT2_TILE_LOOP4(J0, J1, BASE, PITCH, ROWOF, RLO, RHI, KCOL, VCOL, ...) do { \
    const int jA_ = (J0), jB_ = (J1); int ps_ = 0; const unsigned lds0_ = (unsigned)(uintptr_t)lds; \
    asm volatile("s_waitcnt vmcnt(0) lgkmcnt(0)" ::: "memory"); __builtin_amdgcn_s_barrier(); \
    _Pragma("unroll") for (int q_ = 0; q_ < 3; ++q_) { const int ja_ = jB_ - 2 * q_, jb_ = ja_ - 1; \
        kv_dma(BASE, PITCH, ROWOF((ja_ < jA_) ? jA_ : ja_), RLO, RHI, KCOL, VCOL, lds0_ + L_KV + q_ * 32768, wave, lane); \
        kv_dma(BASE, PITCH, ROWOF((jb_ < jA_) ? jA_ : jb_), RLO, RHI, KCOL, VCOL, lds0_ + L_KV + q_ * 32768 + 16384, wave, lane); } \
    for (int j = jB_; j >= jA_; j -= 2) { \
        asm volatile("s_waitcnt vmcnt(8) lgkmcnt(0)" ::: "memory"); __builtin_amdgcn_s_barrier(); asm volatile("" ::: "memory"); \
        { const int ja_ = j - 6, jb_ = j - 7; const unsigned dst_ = lds0_ + L_KV + ((ps_ + 3) & 3) * 32768; \
          kv_dma(BASE, PITCH, ROWOF((ja_ < jA_) ? jA_ : ja_), RLO, RHI, KCOL, VCOL, dst_, wave, lane); \
          kv_dma(BASE, PITCH, ROWOF((jb_ < jA_) ? jA_ : jb_), RLO, RHI, KCOL, VCOL, dst_ + 16384, wave, lane); } \
        { const bool has2 = (j - 1 >= jA_); const unsigned char* slotA = lds + L_KV + ps_ * 32768; const unsigned char* slotB = slotA + 16384; (void)has2; (void)slotB; __VA_ARGS__ } \
        ps_ = (ps_ + 1) & 3; } \
    asm volatile("s_waitcnt vmcnt(0) lgkmcnt(0)" ::: "memory"); __builtin_amdgcn_s_barrier(); asm volatile("" ::: "memory"); } while (0)

#define AT2_TILE_LOOP8(J0, J1, BASE, PITCH, ROWOF, RLO, RHI, KCOL, VCOL, ...) do { \
    const int jA_ = (J0), jB_ = (J1); int ps_ = 0; const unsigned lds0_ = (unsigned)(uintptr_t)lds; \
    asm volatile("s_waitcnt vmcnt(0) lgkmcnt(0)" ::: "memory"); __builtin_amdgcn_s_barrier(); \
    _Pragma("unroll") for (int q_ = 0; q_ < 4; ++q_) { const int ja_ = jB_ - q_; if (ja_ >= jA_) kv_dma(BASE, PITCH, ROWOF(ja_), RLO, RHI, KCOL, VCOL, lds0_ + L_KV + q_ * 16384, wave, lane); } \
    for (int j = jB_; j >= jA_; j -= 4) { \
        asm volatile("s_waitcnt vmcnt(0) lgkmcnt(0)" ::: "memory"); __builtin_amdgcn_s_barrier(); asm volatile("" ::: "memory"); \
        _Pragma("unroll") for (int q_ = 0; q_ < 4; ++q_) { const int ja_ = j - 4 - q_; if (ja_ >= jA_) kv_dma(BASE, PITCH, ROWOF(ja_), RLO, RHI, KCOL, VCOL, lds0_ + L_KV + (ps_ ^ 1) * 65536 + q_ * 16384, wave, lane); } \
        _Pragma("nounroll") for (int jq = 0; jq < 4; ++jq) { const int jt = j - jq; const unsigned char* slot = lds + L_KV + ps_ * 65536 + jq * 16384; if (jt >= jA_) { __VA_ARGS__ } } \
        ps_ ^= 1; } \
    asm volatile("s_waitcnt vmcnt(0) lgkmcnt(0)" ::: "memory"); __builtin_amdgcn_s_barrier(); asm volatile("" ::: "memory"); } while (0)

#define AT2_GROUP_LOOP8(J0, J1, BASE, PITCH, ROWOF, RLO, RHI, KCOL, VCOL, ...) do { \
    const int jA_ = (J0), jB_ = (J1); int ps_ = 0; const unsigned lds0_ = (unsigned)(uintptr_t)lds; \
    asm volatile("s_waitcnt vmcnt(0) lgkmcnt(0)" ::: "memory"); __builtin_amdgcn_s_barrier(); \
    _Pragma("unroll") for (int q_ = 0; q_ < 4; ++q_) { const int ja_ = jB_ - q_; if (ja_ >= jA_) kv_dma(BASE, PITCH, ROWOF(ja_), RLO, RHI, KCOL, VCOL, lds0_ + L_KV + q_ * 16384, wave, lane); } \
    for (int j = jB_; j >= jA_; j -= 4) { \
        asm volatile("s_waitcnt vmcnt(0) lgkmcnt(0)" ::: "memory"); __builtin_amdgcn_s_barrier(); asm volatile("" ::: "memory"); \
        _Pragma("unroll") for (int q_ = 0; q_ < 4; ++q_) { const int ja_ = j - 4 - q_; if (ja_ >= jA_) kv_dma(BASE, PITCH, ROWOF(ja_), RLO, RHI, KCOL, VCOL, lds0_ + L_KV + (ps_ ^ 1) * 65536 + q_ * 16384, wave, lane); } \
        { const unsigned char* gslots = lds + L_KV + ps_ * 65536; __VA_ARGS__ } \
        ps_ ^= 1; } \
    asm volatile("s_waitcnt vmcnt(0) lgkmcnt(0)" ::: "memory"); __builtin_amdgcn_s_barrier(); asm volatile("" ::: "memory"); } while (0)

#ifdef PROBE_ID
#define UA_STAMP(k) ts[k] = __builtin_amdgcn_s_memrealtime()
#else
#define UA_STAMP(k) do {} while (0)
#endif
__device__ __forceinline__ void unit_a(const Params& P, int layer, int b, int g, int c, unsigned char* lds, unsigned long long* ts) {
    int tid_ = tidx_(P.wv); const int tid = tid_, lane = tid & 63, wave = __builtin_amdgcn_readfirstlane(tid >> 6), r32 = lane & 31, hi = lane >> 5;
    const bf16* PROJ = (const bf16*)(P.ws + WS_PROJ); const float* SMALL = (const float*)(P.ws + WS_SMALL); bf16* MIX = (bf16*)(P.ws + WS_MIX);
    UA_STAMP(6);
    float* imp = (float*)(lds + L_IMP); unsigned* selm = (unsigned*)(lds + L_SEL); float* wsf = (float*)(lds + L_WSF) + wave * 32; float* gt = (float*)(lds + L_GT) + wave * 96;
    const long rowbase = (long)b * T; const int tl = wave * 8 + (r32 >> 2), t = c * 64 + tl, hd = g * 4 + (r32 & 3); const size_t tok = (size_t)(rowbase + t);
    const float slope2 = __uint_as_float((unsigned)(126 - hd) << 23) * LOG2E;
    bf16x8 qr[4]; load_q(qr, PROJ, tok, C_AQ + hd * 64, hi);
    const f32x16 zero16 = f32x16{}; Bias alibi; bias_init(alibi, slope2, r32, hi);
    if (hi == 0) { const float* sm = SMALL + tok * 32 + S_GATE + hd * 3; gt[r32 * 3 + 0] = sigmoidf_(sm[0]); gt[r32 * 3 + 1] = sigmoidf_(sm[1]); gt[r32 * 3 + 2] = sigmoidf_(sm[2]); }
    float* accw = (float*)(lds + L_KV) + wave * 2048; f32x16 tot[2];
#define ROW_SEQ(j) (rowbase + (long)(j) * 64)
    { SM S; sm_init(S); const int j0 = (c >= 8) ? c - 8 : 0;
      AT2_TILE_LOOP4(j0, c, PROJ, NP, ROW_SEQ, rowbase, rowbase + T - 1, C_AKW + g * 64, C_AVW + g * 64, {
        const int jb = j - 1; const float rcA = slope2 * (float)(j * 64 - t), rcB = rcA - 64.0f * slope2; const int relA = t - j * 64 - 4 * hi, relB = relA + 64;
        const bool mA = (j == c) || (j == c - 8), mB = (jb == c) || (jb == c - 8);
        const int rcA_ = (j == c) ? relA : (1 << 20), rwA_ = (j == c - 8) ? relA - 512 : -(1 << 20), rcB_ = (jb == c) ? relB : (1 << 20), rwB_ = (jb == c - 8) ? relB - 512 : -(1 << 20);
        if (has2) sm_tile2(S, slotA, slotB, qr, alibi, rcA, rcB, slope2, true, true, mA, rcA_, rwA_, mB, rcB_, rwB_, wsf, lane, r32, hi);
        else sm_tile(S, slotA, qr, alibi, rcA, slope2, true, mA, rcA_, rwA_, wsf, lane, r32, hi); });
      const float lt = swapsum(S.l); acc_reg(tot, S.o, gt[r32 * 3 + 2] / lt, wsf, r32, hi, true); }
    for (int i = tid; i < 64 * IMPP; i += 512) imp[i] = 0.f;
    const int imax = (t >= 31) ? ((t - 31) >> 4) : -1;
    const int nT = ((4 * c + 2) >> 6);
    const bf16* KC = (const bf16*)(P.ws + WS_KCMP) + (size_t)(b * 2 + g) * CMP_PITCH * 128;
#define ROW_CMP(j) ((long)(j) * 64)
    UA_STAMP(0);
    float cm = -1.0e30f, cl = 0.f;
#define CMP1_TILE(jt, slot) do { \
        f32x16 p0, p1; qk_tile(slot, qr, p0, p1, r32, hi, zero16); const int rel = imax - (jt) * 64 - 4 * hi; float tm = -INFINITY; \
        _Pragma("unroll") for (int r = 0; r < 16; ++r) { const int c0 = (r & 3) + 8 * (r >> 2); const float x0 = (c0 <= rel) ? p0[r] : -INFINITY, x1 = (c0 + 32 <= rel) ? p1[r] : -INFINITY; p0[r] = x0; p1[r] = x1; tm = fmaxf(tm, fmaxf(x0, x1)); } \
        const float mn = fmaxf(cm, tm); cl *= __builtin_amdgcn_exp2f(cm - mn); cm = mn; float ls = 0.f; \
        _Pragma("unroll") for (int r = 0; r < 16; ++r) ls += __builtin_amdgcn_exp2f(p0[r] - cm) + __builtin_amdgcn_exp2f(p1[r] - cm); \
        cl += ls; } while (0)
    AT2_TILE_LOOP(0, nT, KC, 128, ROW_CMP, 0, 511, 0, 64, { CMP1_TILE(j, slotA); if (has2) CMP1_TILE(j - 1, slotB); });
    {
        const float mo = swapmax(cm); cl *= __builtin_amdgcn_exp2f(cm - mo); cm = mo; cl = swapsum(cl); }
    const float crl = (cl > 0.f) ? 1.0f / cl : 0.f;
    UA_STAMP(1);
    SM Sc; sm_init(Sc);
#define CMP2_TILE(jt, slot) do { \
        f32x16 p0, p1; qk_tile(slot, qr, p0, p1, r32, hi, zero16); const int rel = imax - (jt) * 64 - 4 * hi; \
        _Pragma("unroll") for (int r = 0; r < 16; ++r) { const int c0 = (r & 3) + 8 * (r >> 2); \
            p0[r] = (c0 <= rel) ? __builtin_amdgcn_exp2f(p0[r] - cm) * crl : 0.f; p1[r] = (c0 + 32 <= rel) ? __builtin_amdgcn_exp2f(p1[r] - cm) * crl : 0.f; } \
          \
        _Pragma("unroll") for (int rq = 0; rq < 4; ++rq) { \
            const float q0 = quadsum((p0[4 * rq] + p0[4 * rq + 1]) + (p0[4 * rq + 2] + p0[4 * rq + 3])), q1 = quadsum((p1[4 * rq] + p1[4 * rq + 1]) + (p1[4 * rq + 2] + p1[4 * rq + 3])); \
            const float t0 = quadsum(p0[4 * rq + 3]), t1 = quadsum(p1[4 * rq + 3]); \
              \
            { float* ip = imp + tl * IMPP + (jt) * 16 + 2 * rq + hi; const int jb = (jt) * 16 + 2 * rq + hi; \
              if ((lane & 3) == 0) { ip[0] += q0; ip[8] += q1; } \
              __builtin_amdgcn_wave_barrier(); asm volatile("s_waitcnt lgkmcnt(0)" ::: "memory"); \
              if ((lane & 3) == 0) { ip[1] += t0; if (jb + 9 < 128) ip[9] += t1; } \
              __builtin_amdgcn_wave_barrier(); asm volatile("s_waitcnt lgkmcnt(0)" ::: "memory"); } } \
        pv_tile(slot + 8192, p0, p1, Sc.o, lane, hi); } while (0)
    AT2_TILE_LOOP(0, nT, KC, 128, ROW_CMP, 0, 511, 0, 64, { CMP2_TILE(j, slotA); if (has2) CMP2_TILE(j - 1, slotB); });
    __syncthreads();
    UA_STAMP(2);
    {   int c2 = c; asm volatile("" : "+s"(c2));
        const int tk = wave * 8 + (lane >> 3), sub = lane & 7; unsigned bits = 0u;
        if (c2 < 16) {
_Pragma("unroll")
            for (int i = 0; i < 16; ++i) bits |= ((sub * 16 + i) <= c2) ? (1u << i) : 0u;
        } else {
            unsigned key[16]; unsigned eligm = 0u, forcedm = 0u;
            { const f4* ip = (const f4*)(imp + tk * IMPP + sub * 16);
_Pragma("unroll")
              for (int q4 = 0; q4 < 4; ++q4) { const f4 v = ip[q4];
_Pragma("unroll")
                  for (int e = 0; e < 4; ++e) { const int i = q4 * 4 + e, jx = sub * 16 + i; const bool el = (jx >= 1) && (jx <= c2 - 2);
                      key[i] = el ? __float_as_uint(fmaxf(v[e], 0.f)) : 0u; eligm |= el ? (1u << i) : 0u; forcedm |= ((jx == 0) || (jx == c2 - 1) || (jx == c2)) ? (1u << i) : 0u; } } }
#define G8SUM(x) do { x += __builtin_amdgcn_update_dpp(0, x, 0xB1, 0xF, 0xF, true); x += __builtin_amdgcn_update_dpp(0, x, 0x4E, 0xF, 0xF, true); x += __builtin_amdgcn_update_dpp(0, x, 0x141, 0xF, 0xF, true); } while (0)
            unsigned tau = 0u;
            for (int bit = 30; bit >= 0; --bit) { const unsigned cand = tau | (1u << bit); int cnt = 0;
_Pragma("unroll")
                for (int i = 0; i < 16; ++i) cnt += (key[i] >= cand) ? 1 : 0;
                G8SUM(cnt); if (cnt >= 13) tau = cand; }
            int ngt = 0, neq = 0; unsigned gtm = 0u, eqm = 0u;
_Pragma("unroll")
            for (int i = 0; i < 16; ++i) { const bool el = (eligm >> i) & 1u; const bool g1 = el && key[i] > tau, e1 = el && key[i] == tau; gtm |= g1 ? (1u << i) : 0u; eqm |= e1 ? (1u << i) : 0u; ngt += g1 ? 1 : 0; neq += e1 ? 1 : 0; }
            G8SUM(ngt); const int need = 13 - ngt;
            int incl = neq;
_Pragma("unroll")
            for (int d = 1; d < 8; d <<= 1) { const int y = __shfl_up(incl, d, 8); if (sub >= d) incl += y; }
            int pre = incl - neq;
            bits = forcedm | gtm;
_Pragma("unroll")
            for (int i = 0; i < 16; ++i) { if ((eqm >> i) & 1u) { if (pre < need) bits |= (1u << i); ++pre; } }
#undef G8SUM
        }
        ((unsigned short*)selm)[tk * 8 + sub] = (unsigned short)bits;
    }
    __builtin_amdgcn_wave_barrier(); asm volatile("s_waitcnt lgkmcnt(0)" ::: "memory");
    const unsigned sm0 = selm[tl * 4 + 0], sm1 = selm[tl * 4 + 1], sm2 = selm[tl * 4 + 2], sm3 = selm[tl * 4 + 3];
    __syncthreads();
    acc_reg(tot, Sc.o, gt[r32 * 3 + 0], wsf, r32, hi, false);
    { typedef __attribute__((address_space(1))) float gfloat; gfloat* pa = (gfloat*)(P.out + (size_t)16 * 1024 * 1024 + ((size_t)blockIdx.x * 8 + wave) * 2048 + lane); gfloat* pb = pa + 1024; asm volatile("" : "+v"(pa), "+v"(pb));
_Pragma("unroll")
      for (int r = 0; r < 16; ++r) { pa[r * 64] = tot[0][r]; pb[r * 64] = tot[1][r]; } }
    UA_STAMP(3);
    { SM S; sm_init(S);
      AT2_GROUP_LOOP8(0, c, PROJ, NP, ROW_SEQ, rowbase, rowbase + T - 1, C_AKS + g * 64, C_AVS + g * 64, {
            unsigned gm = 0u;
            _Pragma("unroll") for (int jq = 0; jq < 4; ++jq) { const int jt = j - jq; if (jt >= 0) { const unsigned wS = (jt < 32) ? sm0 : (jt < 64) ? sm1 : (jt < 96) ? sm2 : sm3; if (__any((wS >> (jt & 31)) & 1u)) gm |= 1u << jq; } }
            while (gm) {
                const int qa = __builtin_ctz(gm); gm &= gm - 1u; const int ja = j - qa; const unsigned wA = (ja < 32) ? sm0 : (ja < 64) ? sm1 : (ja < 96) ? sm2 : sm3; const bool selA = (wA >> (ja & 31)) & 1u;
                const float rcA = slope2 * (float)(ja * 64 - t); const int relA = t - ja * 64 - 4 * hi;
                if (gm) { const int qb = __builtin_ctz(gm); gm &= gm - 1u; const int jb = j - qb; const unsigned wB = (jb < 32) ? sm0 : (jb < 64) ? sm1 : (jb < 96) ? sm2 : sm3; const bool selB = (wB >> (jb & 31)) & 1u;
                    sm_tile2(S, gslots + qa * 16384, gslots + qb * 16384, qr, alibi, rcA, slope2 * (float)(jb * 64 - t), slope2, selA, selB, ja == c, relA, -(1 << 20), false, t - jb * 64 - 4 * hi, -(1 << 20), wsf, lane, r32, hi); }
                else sm_tile(S, gslots + qa * 16384, qr, alibi, rcA, slope2, selA, ja == c, relA, -(1 << 20), wsf, lane, r32, hi); } });
      f32x16 pk0, pk1;
      { typedef __attribute__((address_space(1))) float gfloat; const gfloat* pa = (const gfloat*)(P.out + (size_t)16 * 1024 * 1024 + ((size_t)blockIdx.x * 8 + wave) * 2048 + lane); const gfloat* pb = pa + 1024; asm volatile("" : "+v"(pa), "+v"(pb));
_Pragma("unroll")
        for (int r = 0; r < 16; ++r) { pk0[r] = pa[r * 64]; pk1[r] = pb[r * 64]; } }
      const float lt = swapsum(S.l); acc_reg(tot, S.o, gt[r32 * 3 + 1] / lt, wsf, r32, hi, true);
      tot[0] += pk0; tot[1] += pk1; }
    UA_STAMP(4);
    UA_STAMP(5);
    stage_rows(accw, tot, r32, hi);
    { const size_t tok0 = (size_t)(rowbase + c * 64 + wave * 8); out_rows(accw, PROJ + tok0 * NP + C_AZ + g * 256, MIX + tok0 * D + g * 256, lane); }
    __syncthreads();
    UA_STAMP(7);
}
__device__ __forceinline__ void unit_c(const Params& P, int layer, int b, int g, int c, unsigned char* lds) {
    int tid_ = tidx_(P.wv); const int tid = tid_, lane = tid & 63, wave = __builtin_amdgcn_readfirstlane(tid >> 6), r32 = lane & 31, hi = lane >> 5;
    const bf16* PROJ = (const bf16*)(P.ws + WS_PROJ); bf16* MIX = (bf16*)(P.ws + WS_MIX);
    float* wsf = (float*)(lds + L_WSF) + wave * 32;
    const long rowbase = (long)b * T; const int tl = wave * 8 + (r32 >> 2), t = c * 64 + tl, hd = g * 4 + (r32 & 3); const size_t tok = (size_t)(rowbase + t);
    const float slope2 = __uint_as_float((unsigned)(126 - hd) << 23) * LOG2E;
    bf16x8 qr[4]; load_q(qr, PROJ, tok, C_CQ + hd * 64, hi);
    Bias alibi; bias_init(alibi, slope2, r32, hi);
    SM S; sm_init(S); const int j0 = (c >= 2) ? c - 2 : 0;
    AT2_TILE_LOOP(j0, c, PROJ, NP, ROW_SEQ, rowbase, rowbase + T - 1, C_CK + g * 64, C_CV + g * 64, {
        const int jb = j - 1; const float rcA = slope2 * (float)(j * 64 - t), rcB = rcA - 64.0f * slope2; const int relA = t - j * 64 - 4 * hi, relB = relA + 64;
        const bool mA = (j == c) || (j == c - 2), mB = (jb == c) || (jb == c - 2);
        const int rcA_ = (j == c) ? relA : (1 << 20), rwA_ = (j == c - 2) ? relA - 128 : -(1 << 20), rcB_ = (jb == c) ? relB : (1 << 20), rwB_ = (jb == c - 2) ? relB - 128 : -(1 << 20);
        if (has2) sm_tile2(S, slotA, slotB, qr, alibi, rcA, rcB, slope2, true, true, mA, rcA_, rwA_, mB, rcB_, rwB_, wsf, lane, r32, hi);
        else sm_tile(S, slotA, qr, alibi, rcA, slope2, true, mA, rcA_, rwA_, wsf, lane, r32, hi); });
    const float lt = swapsum(S.l); const float sk2 = P.sinks[layer * 8 + hd] * LOG2E;
    const float Mx = fmaxf(S.m, sk2); const float a = __builtin_amdgcn_exp2f(S.m - Mx); const float fac = a / (lt * a + __builtin_amdgcn_exp2f(sk2 - Mx));
    float* accw = (float*)(lds + L_ACC) + wave * 2048;
    acc_lds(accw, S.o, fac, wsf, r32, hi, true);
    { const size_t tok0 = (size_t)(rowbase + c * 64 + wave * 8); out_rows(accw, PROJ + tok0 * NP + C_CZ + g * 256, MIX + tok0 * D + 1536 + g * 256, lane); }
    __syncthreads();
}
}
namespace ml {
using at2::bf16x8; using at2::s16x4; using at2::f32x16; using at2::lds_cptr; using at2::vtr; using at2::crow; using at2::cvtpk; using at2::swapsum;
constexpr size_t WS_U = 479 * MiB, WS_BC = 511 * MiB, WS_PM = WS_BC + 256 * 1024, WS_NST = WS_PM + 256 * 1024, WS_SEGS = WS_NST + 256 * 1024;
constexpr int QP = 2048;
__device__ __forceinline__ bf16x8 tr_frag(lds_cptr base, int PB, int row0, int col0, int lane) {
    const int g16 = lane >> 4, h = g16 >> 1, q = (lane & 15) >> 2, p = lane & 3;
    const lds_cptr a = base + (row0 + 8 * h + q) * PB + (col0 + 16 * (g16 & 1) + 4 * p) * 2;
    const s16x4 lo = vtr(a), hh = vtr(a + 4 * PB);
    return (bf16x8){lo[0], lo[1], lo[2], lo[3], hh[0], hh[1], hh[2], hh[3]};
}
__device__ __forceinline__ bf16x8 tr_frag_perm(lds_cptr base, int PB, int row0, int col0, int lane) {
    const int g16 = lane >> 4, h = g16 >> 1, q = (lane & 15) >> 2, p = lane & 3;
    const lds_cptr a = base + (row0 + 4 * h + q) * PB + (col0 + 16 * (g16 & 1) + 4 * p) * 2;
    const s16x4 lo = vtr(a), hh = vtr(a + 8 * PB);
    return (bf16x8){lo[0], lo[1], lo[2], lo[3], hh[0], hh[1], hh[2], hh[3]};
}
__device__ __forceinline__ void m0_prep(const Params& P, int layer, int seg, unsigned char* lds) {
    int tid_ = tidx_(P.wv); const int tid = tid_, lane = tid & 63, wave = tid >> 6;
    const bf16* PROJ = (const bf16*)(P.ws + WS_PROJ); const float* SMALL = (const float*)(P.ws + WS_SMALL); bf16* QKC = (bf16*)P.out;
    float* BC = (float*)(P.ws + WS_BC); float* PM = (float*)(P.ws + WS_PM); float* NST = (float*)(P.ws + WS_NST); float* SEGS = (float*)(P.ws + WS_SEGS);
    float* sa = (float*)lds; float* wt = sa + 256; float* scal = wt + 16;
    const int bh = seg >> 5, b = bh >> 2, h = bh & 3, s = seg & 31; const size_t tok0 = (size_t)b * T + s * 256;
    float x = 0.f, iv = 0.f;
    if (tid < 256) { const size_t tok = tok0 + tid; iv = SMALL[tok * 32 + S_I + h] + P.i_bias[layer * 4 + h]; x = logsigmoidf_(SMALL[tok * 32 + S_F + h] + P.f_bias[layer * 4 + h]);
#pragma unroll
        for (int o = 1; o < 64; o <<= 1) { const float y = __shfl_up(x, o); if (lane >= o) x += y; }
        if (lane == 63) wt[wave] = x; }
    __syncthreads();
    float a = 0.f, mx = 0.f, bc = 0.f;
    if (tid < 256) { float off = 0.f; for (int w2 = 0; w2 < wave; ++w2) off += wt[w2]; bc = x + off; a = iv - bc; mx = a;
#pragma unroll
        for (int o = 1; o < 64; o <<= 1) { const float y = __shfl_up(mx, o); if (lane >= o) mx = fmaxf(mx, y); }
        if (lane == 63) wt[8 + wave] = mx; }
    __syncthreads();
    if (tid < 256) { for (int w2 = 0; w2 < wave; ++w2) mx = fmaxf(mx, wt[8 + w2]); const size_t tok = tok0 + tid; BC[tok * 4 + h] = bc; PM[tok * 4 + h] = mx; sa[tid] = a;
        if (tid == 255) { scal[0] = bc; scal[1] = mx; SEGS[seg] = bc; SEGS[256 + seg] = mx; } }
    __syncthreads();
    const float amax = scal[1];
    if (tid < 256) sa[tid] = 0.0625f * __expf(sa[tid] - amax);
    __syncthreads();
    bf16* xin = (bf16*)(lds + 4096); bf16* xout = (bf16*)(lds + 4096 + 67 * 1024);
    const int ch = tid; const bool isq = ch < 256; const int cc = isq ? (h * 256 + ch) : (1024 + h * 256 + (ch - 256));
    const float* cw = P.conv_w + (size_t)layer * 4 * 2048 + cc; const float cw0 = cw[0], cw1 = cw[2048], cw2 = cw[4096], cw3 = cw[6144], cb = P.conv_b[layer * 2048 + cc];
    float nsum = 0.f;
    const long tlo = (long)b * T;
    u4 pre[9];
#define M0_LOAD(SB) do { const long t0_ = (long)tok0 + (SB) * 64; _Pragma("unroll") for (int i = 0; i < 9; ++i) { const int ci = tid + 512 * i; pre[i] = (u4){0u, 0u, 0u, 0u}; \
        if (ci < 67 * 64) { const int row = ci >> 6, c = ci & 63; const long tr = t0_ - 3 + row; \
            if (tr >= tlo) pre[i] = *(const u4*)(PROJ + (size_t)tr * NP + ((c < 32) ? (C_BQ + h * 256 + c * 8) : (C_BK + h * 256 + (c - 32) * 8))); } } } while (0)
    M0_LOAD(0);
    for (int sb = 0; sb < 4; ++sb) { const long t0 = (long)tok0 + sb * 64;
#pragma unroll
        for (int i = 0; i < 9; ++i) { const int ci = tid + 512 * i; if (ci < 67 * 64) *(u4*)(xin + (ci >> 6) * 512 + (ci & 63) * 8) = pre[i]; }
        __syncthreads();
        if (sb < 3) M0_LOAD(sb + 1);
        { float xm3 = bf2f(xin[ch]), xm2 = bf2f(xin[512 + ch]), xm1 = bf2f(xin[1024 + ch]);
#pragma unroll 8
          for (int tl = 0; tl < 64; ++tl) { const float xc = bf2f(xin[(tl + 3) * 512 + ch]); const float y = cb + cw0 * xm3 + cw1 * xm2 + cw2 * xm1 + cw3 * xc; xm3 = xm2; xm2 = xm1; xm1 = xc;
              float ks = sa[sb * 64 + tl]; asm volatile("" : "+v"(ks)); float v = siluf_(y) * (isq ? 1.0f : ks); nsum += v;
              xout[tl * 512 + ch] = (bf16)f2bf(v); } }
        __syncthreads();
        for (int ci = tid; ci < 64 * 64; ci += 512) { const int row = ci >> 6, c = ci & 63;
            *(u4*)(QKC + (size_t)(t0 + row) * QP + ((c < 32) ? (h * 256 + c * 8) : (1024 + h * 256 + (c - 32) * 8))) = *(const u4*)(xout + row * 512 + c * 8); } }
#undef M0_LOAD
    if (!isq) NST[(size_t)seg * 256 + (ch - 256)] = nsum;
    __syncthreads();
}
constexpr int PB = 576;
__device__ __forceinline__ void m1_state(const Params& P, int seg, unsigned char* lds) {
    int tid_ = tidx_(P.wv); const int tid = tid_, lane = tid & 63, wave = __builtin_amdgcn_readfirstlane(tid >> 6), r32 = lane & 31, hi = lane >> 5;
    const bf16* PROJ = (const bf16*)(P.ws + WS_PROJ); const bf16* QKC = (const bf16*)P.out; bf16* U = (bf16*)(P.ws + WS_U) + (size_t)seg * 65536;
    const int bh = seg >> 5, b = bh >> 2, h = bh & 3, s = seg & 31; const size_t tok0 = (size_t)b * T + s * 256;
    f32x16 acc[8];
#pragma unroll
    for (int i = 0; i < 8; ++i) acc[i] = f32x16{};
    const int lrow = tid >> 4, lc = tid & 15;
    const bf16* gk = QKC + (tok0 + lrow) * QP + 1024 + h * 256 + lc * 8; const bf16* gv = PROJ + (tok0 + lrow) * NP + C_BV + h * 256 + lc * 8;
    u4 rk0, rk1, rv0, rv1;
    rk0 = *(const u4*)gk; rk1 = *(const u4*)(gk + 128); rv0 = *(const u4*)gv; rv1 = *(const u4*)(gv + 128);
    __syncthreads();
    for (int ck = 0; ck < 8; ++ck) {
        unsigned char* st = lds + (ck & 1) * (2 * 32 * PB);
        *(u4*)(st + lrow * PB + lc * 16) = rk0; *(u4*)(st + lrow * PB + 256 + lc * 16) = rk1;
        *(u4*)(st + 32 * PB + lrow * PB + lc * 16) = rv0; *(u4*)(st + 32 * PB + lrow * PB + 256 + lc * 16) = rv1;
        if (ck < 7) { const size_t o = (size_t)(ck + 1) * 32; rk0 = *(const u4*)(gk + o * QP); rk1 = *(const u4*)(gk + o * QP + 128); rv0 = *(const u4*)(gv + o * NP); rv1 = *(const u4*)(gv + o * NP + 128); }
        __syncthreads();
        const lds_cptr kt = (lds_cptr)st, vt = (lds_cptr)(st + 32 * PB);
#pragma unroll
        for (int ks = 0; ks < 2; ++ks) { const bf16x8 bk = tr_frag(kt, PB, ks * 16, wave * 32, lane);
#pragma unroll
            for (int et = 0; et < 8; ++et) { const bf16x8 av = tr_frag(vt, PB, ks * 16, et * 32, lane);
                acc[et] = __builtin_amdgcn_mfma_f32_32x32x16_bf16(av, bk, acc[et], 0, 0, 0); } }
    }
    __syncthreads();
    bf16* so = (bf16*)lds;
#pragma unroll
    for (int et = 0; et < 8; ++et)
#pragma unroll
        for (int r = 0; r < 16; ++r) so[(et * 32 + crow(r, hi)) * 264 + wave * 32 + r32] = (bf16)f2bf(acc[et][r]);
    __syncthreads();
    for (int i = tid; i < 256 * 32; i += 512) { const int e = i >> 5, c16 = i & 31; *(u4*)(U + (size_t)e * 256 + c16 * 8) = *(const u4*)(so + e * 264 + c16 * 8); }
    __syncthreads();
}
__device__ __forceinline__ void m2_scan(const Params& P, int part) {
    int tid_ = tidx_(P.wv); const int gt = part * 512 + tid_;
    const int bh = gt >> 13, idx = gt & 8191; bf16* U = (bf16*)(P.ws + WS_U) + (size_t)bh * 32 * 65536 + idx * 8; float* NST = (float*)(P.ws + WS_NST) + (size_t)bh * 32 * 256; float* SEGS = (float*)(P.ws + WS_SEGS);
    float c[8] = {0.f, 0.f, 0.f, 0.f, 0.f, 0.f, 0.f, 0.f}; float n8[8] = {0.f, 0.f, 0.f, 0.f, 0.f, 0.f, 0.f, 0.f}; float m = 0.f; const bool don = idx < 32;
    const float blv = SEGS[bh * 32 + (tid_ & 31)], amv = SEGS[256 + bh * 32 + (tid_ & 31)];
    for (int s0 = 0; s0 < 32; s0 += 8) {
        u4 uu[8]; f4 na[8][2];
#pragma unroll
        for (int k = 0; k < 8; ++k) uu[k] = *(const u4*)(U + (size_t)(s0 + k) * 65536);
        if (don) {
#pragma unroll
            for (int k = 0; k < 8; ++k) { const float* np = NST + (size_t)(s0 + k) * 256 + idx * 8; na[k][0] = *(const f4*)np; na[k][1] = *(const f4*)(np + 4); } }
        asm volatile("" ::: "memory");
#pragma unroll
        for (int k = 0; k < 8; ++k) { const int sg = bh * 32 + s0 + k; const float blast = __shfl(blv, s0 + k), mloc = blast + __shfl(amv, s0 + k);
            const float mn = fmaxf(blast + m, mloc); const float dec = __expf(blast + m - mn), wl = __expf(mloc - mn);
            u4 o; o.x = pk2(c[0], c[1]); o.y = pk2(c[2], c[3]); o.z = pk2(c[4], c[5]); o.w = pk2(c[6], c[7]); *(u4*)(U + (size_t)(s0 + k) * 65536) = o;
#pragma unroll
            for (int e = 0; e < 4; ++e) { c[2 * e] = dec * c[2 * e] + wl * __uint_as_float(uu[k][e] << 16); c[2 * e + 1] = dec * c[2 * e + 1] + wl * __uint_as_float(uu[k][e] & 0xffff0000u); }
            if (don) { float* np = NST + (size_t)(s0 + k) * 256 + idx * 8;
                *(f4*)np = (f4){n8[0], n8[1], n8[2], n8[3]}; *(f4*)(np + 4) = (f4){n8[4], n8[5], n8[6], n8[7]};
#pragma unroll
                for (int e = 0; e < 4; ++e) { n8[e] = dec * n8[e] + wl * na[k][0][e]; n8[4 + e] = dec * n8[4 + e] + wl * na[k][1][e]; } }
            if (idx == 0) SEGS[512 + sg] = m;
            m = mn; }
    }
}
constexpr int M3_STG = 32768 + 64 * PB;
constexpr int M3_TAB = 2 * M3_STG;
#ifdef PROBE_ID
#define M3_STAMP(k) do { if (seg == 0 && layer == 0 && tidx_(P.wv) == 0) ((unsigned long long*)(P.ws + WS_BAR + 15360))[k] = __builtin_amdgcn_s_memrealtime(); } while (0)
#else
#define M3_STAMP(k) do {} while (0)
#endif
__device__ __forceinline__ void m3_out(const Params& P, int layer, int seg, unsigned char* lds) {
    int tid_ = tidx_(P.wv); const int tid = tid_, lane = tid & 63, wave = __builtin_amdgcn_readfirstlane(tid >> 6), r32 = lane & 31, hi = lane >> 5;
    const bf16* PROJ = (const bf16*)(P.ws + WS_PROJ); const bf16* QKC = (const bf16*)P.out; const bf16* CT = (const bf16*)(P.ws + WS_U) + (size_t)seg * 65536; bf16* MIX = (bf16*)(P.ws + WS_MIX);
    const float* BC = (const float*)(P.ws + WS_BC); const float* PM = (const float*)(P.ws + WS_PM); const float* NST = (const float*)(P.ws + WS_NST) + (size_t)seg * 256; const float* SEGS = (const float*)(P.ws + WS_SEGS);
    const int bh = seg >> 5, b = bh >> 2, h = bh & 3, s = seg & 31; const size_t tok0 = (size_t)b * T + s * 256;
    float* wsf = (float*)(lds + M3_TAB) + wave * 32; float* nvec = (float*)(lds + M3_TAB + 1024); float* rowf = nvec + 256; float* wint = rowf + 256; float* clampv = wint + 256; float* dqv = clampv + 256;
    if (tid < 256) { const float mst = SEGS[512 + seg], amax = SEGS[256 + seg]; const float pm = PM[(tok0 + tid) * 4 + h], bc = BC[(tok0 + tid) * 4 + h]; const float mxt = fmaxf(mst, pm);
        rowf[tid] = __expf(amax - mxt); wint[tid] = __expf(mst - mxt); clampv[tid] = __expf(-(bc + mxt)); nvec[tid] = NST[tid]; }
    M3_STAMP(0);
    f32x16 H[8];
#pragma unroll
    for (int i = 0; i < 8; ++i) H[i] = f32x16{};
    const bf16* qrow = QKC + (tok0 + wave * 32 + r32) * QP + h * 256 + hi * 8;
    {   const int lrow = tid >> 3, lch = tid & 7;
        u4 rc[4];
#pragma unroll
        for (int i = 0; i < 4; ++i) rc[i] = *(const u4*)(CT + (size_t)(lrow + 64 * i) * 256 + lch * 8);
        __syncthreads();
        float dq = 0.f;
        for (int ck = 0; ck < 4; ++ck) { unsigned char* st = lds + (ck & 1) * 32768;
            bf16x8 qa4[4];
#pragma unroll
            for (int k4 = 0; k4 < 4; ++k4) qa4[k4] = *(const bf16x8*)(qrow + (ck * 4 + k4) * 16);
#pragma unroll
            for (int i = 0; i < 4; ++i) { const int row = lrow + 64 * i; *(u4*)(st + row * 128 + ((lch ^ (row & 7)) << 4)) = rc[i]; }
            if (ck < 3) {
#pragma unroll
                for (int i = 0; i < 4; ++i) rc[i] = *(const u4*)(CT + (size_t)(lrow + 64 * i) * 256 + (ck + 1) * 64 + lch * 8); }
            __syncthreads();
#pragma unroll
            for (int k4 = 0; k4 < 4; ++k4) { const int ks = ck * 4 + k4; const bf16x8 qa = qa4[k4];
#pragma unroll
                for (int e = 0; e < 8; ++e) dq += bf2f((unsigned short)qa[e]) * nvec[ks * 16 + hi * 8 + e];
#pragma unroll
                for (int et = 0; et < 8; ++et) { const int row = et * 32 + r32; const bf16x8 cb = *(const bf16x8*)(st + row * 128 + (((2 * k4 + hi) ^ (row & 7)) << 4));
                    H[et] = __builtin_amdgcn_mfma_f32_32x32x16_bf16(qa, cb, H[et], 0, 0, 0); } }
        }
        dq = swapsum(dq);
        if (hi == 0) dqv[wave * 32 + r32] = wint[wave * 32 + r32] * dq;
        __builtin_amdgcn_wave_barrier(); asm volatile("" ::: "memory");
        if (hi == 0) wsf[r32] = wint[wave * 32 + r32];
        __builtin_amdgcn_wave_barrier(); asm volatile("s_waitcnt lgkmcnt(0)" ::: "memory");
#pragma unroll
        for (int r = 0; r < 16; ++r) { const float a = wsf[crow(r, hi)];
#pragma unroll
            for (int et = 0; et < 8; ++et) H[et][r] *= a; }
        __builtin_amdgcn_wave_barrier(); asm volatile("" ::: "memory");
        M3_STAMP(1);
        const float rf = rowf[wave * 32 + r32]; float dsum = 0.f;
        const int krow = tid >> 3, kc4 = tid & 7;
        __syncthreads();
        for (int j = 0; j < 4; ++j) { unsigned char* st = lds + (j & 1) * M3_STG;
            bf16x8 qb16[16];
            if (j <= (wave >> 1)) {
#pragma unroll
                for (int ks = 0; ks < 4; ++ks) qb16[ks] = *(const bf16x8*)(qrow + ks * 16); }
            { const bf16* gk = QKC + (tok0 + j * 64 + krow) * QP + 1024 + h * 256; const bf16* gv = PROJ + (tok0 + j * 64 + krow) * NP + C_BV + h * 256;
#pragma unroll
              for (int i = 0; i < 4; ++i) { const int ch = kc4 + 8 * i; const u4 kk = *(const u4*)(gk + ch * 8), vv = *(const u4*)(gv + ch * 8);
                  *(u4*)(st + krow * 512 + ((ch ^ (krow & 7)) << 4)) = kk; *(u4*)(st + 32768 + krow * PB + ch * 16) = vv; } }
            __syncthreads();
            if (j <= (wave >> 1)) {
                f32x16 p0 = f32x16{}, p1 = f32x16{};
#pragma unroll
                for (int ks = 0; ks < 16; ++ks) { if ((ks & 3) == 0 && ks < 12) {
#pragma unroll
                        for (int q = 0; q < 4; ++q) qb16[4 + ks + q] = *(const bf16x8*)(qrow + (4 + ks + q) * 16); }
                    const bf16x8 qb = qb16[ks]; const int off = r32 * 512 + (((2 * ks + hi) ^ (r32 & 7)) << 4);
                    const bf16x8 a0 = *(const bf16x8*)(st + off), a1 = *(const bf16x8*)(st + off + 32 * 512);
                    p0 = __builtin_amdgcn_mfma_f32_32x32x16_bf16(a0, qb, p0, 0, 0, 0); p1 = __builtin_amdgcn_mfma_f32_32x32x16_bf16(a1, qb, p1, 0, 0, 0); }
                const int rel = wave * 32 + r32 - j * 64 - 4 * hi;
#pragma unroll
                for (int r = 0; r < 16; ++r) { const int c0 = (r & 3) + 8 * (r >> 2); const float x0 = (c0 <= rel) ? p0[r] * rf : 0.f, x1 = (c0 + 32 <= rel) ? p1[r] * rf : 0.f; p0[r] = x0; p1[r] = x1; dsum += x0 + x1; }
                bf16x8 pa[4];
#pragma unroll
                for (int k = 0; k < 4; ++k) { const f32x16& Pq = (k < 2) ? p0 : p1; const int bb = (k & 1) * 8;
                    u4 w; w.x = cvtpk(Pq[bb + 0], Pq[bb + 1]); w.y = cvtpk(Pq[bb + 2], Pq[bb + 3]); w.z = cvtpk(Pq[bb + 4], Pq[bb + 5]); w.w = cvtpk(Pq[bb + 6], Pq[bb + 7]); pa[k] = __builtin_bit_cast(bf16x8, w); }
                const lds_cptr vt = (lds_cptr)(st + 32768);
#pragma unroll
                for (int k = 0; k < 4; ++k)
#pragma unroll
                    for (int et = 0; et < 8; ++et) { const bf16x8 vf = tr_frag_perm(vt, PB, k * 16, et * 32, lane); H[et] = __builtin_amdgcn_mfma_f32_32x32x16_bf16(pa[k], vf, H[et], 0, 0, 0); }
            }
        }
        M3_STAMP(2);
        dsum = swapsum(dsum);
        const int trow = wave * 32 + r32; const float den = dqv[trow] + dsum; const float rden = 1.0f / fmaxf(fabsf(den), clampv[trow]);
        __syncthreads();
        if (hi == 0) wsf[r32] = rden;
        __builtin_amdgcn_wave_barrier(); asm volatile("s_waitcnt lgkmcnt(0)" ::: "memory");
        bf16* hs = (bf16*)(lds + wave * (32 * 528));
#pragma unroll
        for (int r = 0; r < 16; ++r) { const float a = wsf[crow(r, hi)];
#pragma unroll
            for (int et = 0; et < 8; ++et) hs[crow(r, hi) * 264 + et * 32 + r32] = (bf16)f2bf(H[et][r] * a); }
        __builtin_amdgcn_wave_barrier(); asm volatile("s_waitcnt lgkmcnt(0)" ::: "memory");
        const int c16 = lane & 31, rsel = lane >> 5; const f4 g0 = *(const f4*)(P.mnorm_g + layer * 1024 + h * 256 + c16 * 8), g1 = *(const f4*)(P.mnorm_g + layer * 1024 + h * 256 + c16 * 8 + 4);
        for (int i4 = 0; i4 < 16; i4 += 4) { u4 owq[4], zwq[4];
#pragma unroll
            for (int q = 0; q < 4; ++q) { const size_t tok = tok0 + wave * 32 + (i4 + q) * 2 + rsel; owq[q] = *(const u4*)(PROJ + tok * NP + C_BO + h * 256 + c16 * 8); zwq[q] = *(const u4*)(PROJ + tok * NP + C_BZ + h * 256 + c16 * 8); }
            asm volatile("" ::: "memory");
#pragma unroll
            for (int q = 0; q < 4; ++q) { const int row = (i4 + q) * 2 + rsel; const size_t tok = tok0 + wave * 32 + row;
                const u4 hw = *(const u4*)(hs + row * 264 + c16 * 8), ow = owq[q], zw = zwq[q];
                float hb[8]; float ss = 0.f;
#pragma unroll
                for (int e = 0; e < 4; ++e) { hb[2 * e] = __uint_as_float(hw[e] << 16) * sigmoidf_(__uint_as_float(ow[e] << 16)); hb[2 * e + 1] = __uint_as_float(hw[e] & 0xffff0000u) * sigmoidf_(__uint_as_float(ow[e] & 0xffff0000u)); ss += hb[2 * e] * hb[2 * e] + hb[2 * e + 1] * hb[2 * e + 1]; }
#pragma unroll
                for (int o = 1; o < 32; o <<= 1) ss += __shfl_xor(ss, o);
                const float rstd = 1.0f / sqrtf(ss * (1.0f / 256.0f) + EPS); float y[8];
#pragma unroll
                for (int e = 0; e < 4; ++e) { y[2 * e] = hb[2 * e] * rstd * siluf_(__uint_as_float(zw[e] << 16)); y[2 * e + 1] = hb[2 * e + 1] * rstd * siluf_(__uint_as_float(zw[e] & 0xffff0000u)); }
                u4 out; out.x = pk2(y[0] * g0[0], y[1] * g0[1]); out.y = pk2(y[2] * g0[2], y[3] * g0[3]); out.z = pk2(y[4] * g1[0], y[5] * g1[1]); out.w = pk2(y[6] * g1[2], y[7] * g1[3]);
                *(u4*)(MIX + tok * D + 512 + h * 256 + c16 * 8) = out; } }
    }
    __syncthreads();
    M3_STAMP(3);
}
}
namespace cp2 {
using at2::bf16x8; using at2::f32x16; using at2::crow;
constexpr size_t WS_W1T = 512 * MiB;
constexpr size_t WS_C1 = WS_W1T + 2 * 2 * 64 * 2048 * 2;
__device__ __forceinline__ void compress_task(const Params& P, int layer, int task, unsigned char* lds) {
    int tid_ = tidx_(P.wv); const int tid = tid_, lane = tid & 63, wave = __builtin_amdgcn_readfirstlane(tid >> 6), r32 = lane & 31, hi = lane >> 5;
    const bf16* PROJ = (const bf16*)(P.ws + WS_PROJ); bf16* KC = (bf16*)(P.ws + WS_KCMP);
    const int rt = task & 15, combo = task >> 4, g = combo & 1, b = (combo >> 1) & 1, kv = combo >> 2; const int i0 = rt * 32;
    const bf16* W1T = (const bf16*)(P.ws + WS_W1T) + (size_t)(layer * 2 + kv) * 64 * 2048; const float* C1 = (const float*)(P.ws + WS_C1) + (layer * 2 + kv) * 16 * 64;
    const float* w2 = (kv ? P.w2_v : P.w2_k) + (size_t)layer * 64 * 64;
    float* red = (float*)(lds + 69632); float* hid = (float*)(lds + 135168);
    f32x16 acc[2]; acc[0] = f32x16{}; acc[1] = f32x16{};
    const int col = (kv ? C_AVC : C_AKC) + g * 64;
    bf16x8 wf[4][4][2];
#pragma unroll
    for (int li = 0; li < 4; ++li) { const bf16* bp = W1T + (size_t)r32 * 2048 + (wave * 4 + li) * 64 + hi * 8;
#pragma unroll
        for (int kk = 0; kk < 4; ++kk) { wf[li][kk][0] = *(const bf16x8*)(bp + kk * 16); wf[li][kk][1] = *(const bf16x8*)(bp + 32 * 2048 + kk * 16); } }
    __syncthreads();
    for (int ci = tid; ci < 528 * 8; ci += 512) { const int row = ci >> 3, ch = ci & 7; int tokn = 16 * i0 + row; tokn = tokn > T - 1 ? T - 1 : tokn;
        *(u4*)(lds + row * 128 + ((ch ^ ((row >> 4) & 7)) << 4)) = *(const u4*)(PROJ + ((size_t)b * T + tokn) * NP + col + ch * 8); }
    __syncthreads();
#pragma unroll
    for (int li = 0; li < 4; ++li) { const int l = wave * 4 + li; const int row = 16 * r32 + l; const unsigned char* ap = lds + row * 128; const int sw = (row >> 4) & 7;
#pragma unroll
        for (int kk = 0; kk < 4; ++kk) { const bf16x8 a = *(const bf16x8*)(ap + (((2 * kk + hi) ^ sw) << 4));
            acc[0] = __builtin_amdgcn_mfma_f32_32x32x16_bf16(a, wf[li][kk][0], acc[0], 0, 0, 0); acc[1] = __builtin_amdgcn_mfma_f32_32x32x16_bf16(a, wf[li][kk][1], acc[1], 0, 0, 0); } }
    const f4 w2a = *(const f4*)(w2 + tid * 8), w2b = *(const f4*)(w2 + tid * 8 + 4);
    __syncthreads();
    float* w2s = (float*)lds; *(f4*)(w2s + tid * 8) = w2a; *(f4*)(w2s + tid * 8 + 4) = w2b;
#pragma unroll
    for (int ct = 0; ct < 2; ++ct)
#pragma unroll
        for (int r = 0; r < 16; ++r) red[wave * 2048 + crow(r, hi) * 64 + ct * 32 + r32] = acc[ct][r];
    __syncthreads();
    { const int i = tid >> 4, j0 = (tid & 15) * 4; f4 cpart[16];
#pragma unroll
      for (int pp = 0; pp < 16; ++pp) cpart[pp] = *(const f4*)(C1 + pp * 64 + j0);
      f4 s = cpart[0];
#pragma unroll
      for (int pp = 1; pp < 16; ++pp) s += cpart[pp];
#pragma unroll
      for (int w = 0; w < 8; ++w) s += *(const f4*)(red + w * 2048 + i * 64 + j0);
      *(f4*)(hid + i * 64 + j0) = (f4){siluf_(s[0]), siluf_(s[1]), siluf_(s[2]), siluf_(s[3])}; }
    __syncthreads();
    { const int i = tid >> 4, j0 = (tid & 15) * 4; f4 o = (f4){0.f, 0.f, 0.f, 0.f};
#pragma unroll 8
      for (int k = 0; k < 64; ++k) o += hid[i * 64 + k] * *(const f4*)(w2s + k * 64 + j0);
      if (i0 + i >= NCMP) o = (f4){0.f, 0.f, 0.f, 0.f};
      bf16* dst = KC + ((size_t)(b * 2 + g) * CMP_PITCH + i0 + i) * 128 + kv * 64 + j0;
      *(unsigned long long*)dst = (unsigned long long)pk2(o[0], o[1]) | ((unsigned long long)pk2(o[2], o[3]) << 32); }
    __syncthreads();
}
__device__ __forceinline__ void prologue_cmp(const Params& P, unsigned char* lds, int gw, int NGW, int wave, int lane) {
    float* scr = (float*)(lds + wave * 16384);
    bf16* W1T = (bf16*)(P.ws + WS_W1T); float* C1 = (float*)(P.ws + WS_C1);
    for (int it = gw; it < 4 * 64; it += NGW) { const int lk = it >> 6, r = it & 63, layer = lk >> 1, kv = lk & 1;
        const float* w1 = (kv ? P.w1_v : P.w1_k) + (size_t)layer * 2048 * 64;
        transpose_item(w1, 2048, 64, false, nullptr, W1T + (size_t)lk * 64 * 2048, 2, scr, r, lane); }
    for (int it = gw; it < 4 * 16; it += NGW) { const int lk = it >> 4, part = it & 15, layer = lk >> 1, kv = lk & 1; const float* w1 = (kv ? P.w1_v : P.w1_k) + (size_t)layer * 2048 * 64; const float* pe = (kv ? P.pe_v : P.pe_k) + (size_t)layer * 2048;
        float s = 0.f;
#pragma unroll 16
        for (int idx = part * 128; idx < part * 128 + 128; ++idx) s += pe[idx] * w1[(size_t)idx * 64 + lane];
        C1[(lk * 16 + part) * 64 + lane] = s; }
}
}
namespace sg {
using at2::bf16x8; using at2::f32x16; using at2::crow;
__device__ __forceinline__ void small_gemm(const Params& P, int layer, unsigned char* lds) {
    int tid_ = tidx_(P.wv); const int tid = tid_, lane = tid & 63, wave = __builtin_amdgcn_readfirstlane(tid >> 6), r32 = lane & 31, hi = lane >> 5;
    const bf16* XB = (const bf16*)(P.ws + WS_XB); const bf16* W = (const bf16*)(P.ws + WS_WIN) + ((size_t)layer * NP + 8192) * D; const float* SSQ = (const float*)(P.ws + WS_SSQ); float* SMALL = (float*)(P.ws + WS_SMALL);
    float* red = (float*)lds;
    for (int m0 = blockIdx.x * 64; m0 < M; m0 += gridDim.x * 64) {
        f32x16 acc[2]; acc[0] = f32x16{}; acc[1] = f32x16{};
        const bf16* a0 = XB + (size_t)(m0 + r32) * D + wave * 256 + hi * 8; const bf16* a1 = a0 + (size_t)32 * D; const bf16* bp = W + (size_t)r32 * D + wave * 256 + hi * 8;
        bf16x8 wb[16], xa[16], xc[16];
#pragma unroll
        for (int ks = 0; ks < 16; ++ks) { wb[ks] = *(const bf16x8*)(bp + ks * 16); xa[ks] = *(const bf16x8*)(a0 + ks * 16); xc[ks] = *(const bf16x8*)(a1 + ks * 16); }
        __builtin_amdgcn_sched_barrier(0);
#pragma unroll
        for (int ks = 0; ks < 16; ++ks) { acc[0] = __builtin_amdgcn_mfma_f32_32x32x16_bf16(xa[ks], wb[ks], acc[0], 0, 0, 0); acc[1] = __builtin_amdgcn_mfma_f32_32x32x16_bf16(xc[ks], wb[ks], acc[1], 0, 0, 0); }
        __syncthreads();
#pragma unroll
        for (int rt = 0; rt < 2; ++rt)
#pragma unroll
            for (int r = 0; r < 16; ++r) red[wave * 2048 + (rt * 32 + crow(r, hi)) * 32 + r32] = acc[rt][r];
        __syncthreads();
        { const int row = tid >> 3, c0 = (tid & 7) * 4; f4 s = (f4){0.f, 0.f, 0.f, 0.f};
#pragma unroll
          for (int w = 0; w < 8; ++w) s += *(const f4*)(red + w * 2048 + row * 32 + c0);
          const f4* sp = (const f4*)(SSQ + (size_t)(m0 + row) * 32); f4 q = sp[0];
#pragma unroll
          for (int j = 1; j < 8; ++j) q += sp[j];
          const float rstd = 1.0f / sqrtf(((q[0] + q[1]) + (q[2] + q[3])) * (1.0f / 2048.0f) + EPS);
          *(f4*)(SMALL + (size_t)(m0 + row) * 32 + c0) = s * rstd; }
    }
    __syncthreads();
}
}
__device__ __forceinline__ void phase_final(const Params& P, int gw, int NGW, int lane) {
    const float* SSQ = (const float*)(P.ws + WS_SSQ); const bf16* XB = (const bf16*)(P.ws + WS_XB);
    f4 gv[4][2]; { const f4* gr = (const f4*)P.final_g;
#pragma unroll
        for (int j = 0; j < 4; ++j) { gv[j][0] = gr[2 * (lane + 64 * j)]; gv[j][1] = gr[2 * (lane + 64 * j) + 1]; } }
    for (int m = gw; m < M; m += NGW) { float s = (lane < 32) ? SSQ[(size_t)m * 32 + lane] : 0.f;
        const u4* xr = (const u4*)(XB + (size_t)m * D) + lane; f4* orow = (f4*)(P.out + (size_t)m * D);
        u4 xv[4];
#pragma unroll
        for (int j = 0; j < 4; ++j) xv[j] = xr[64 * j];
        s = wsum(s);
        const float rstd = 1.0f / sqrtf(s * (1.0f / 2048.0f) + EPS);
#pragma unroll
        for (int j = 0; j < 4; ++j) { const u4 x = xv[j]; f4 a, b;
            a.x = __uint_as_float(x.x << 16); a.y = __uint_as_float(x.x & 0xffff0000u); a.z = __uint_as_float(x.y << 16); a.w = __uint_as_float(x.y & 0xffff0000u);
            b.x = __uint_as_float(x.z << 16); b.y = __uint_as_float(x.z & 0xffff0000u); b.z = __uint_as_float(x.w << 16); b.w = __uint_as_float(x.w & 0xffff0000u);
            orow[2 * (lane + 64 * j)] = a * rstd * gv[j][0]; orow[2 * (lane + 64 * j) + 1] = b * rstd * gv[j][1]; } }
}
__global__ void __launch_bounds__(512, 2) hymba_fwd(Params P) {
    extern __shared__ __attribute__((aligned(16))) unsigned char lds[];
    cg::grid_group grid = cg::this_grid();
    volatile LAS unsigned* bst = (volatile LAS unsigned*)((LAS unsigned char*)lds + (LDS_BYTES - 16));
    const int wv_s = __builtin_amdgcn_readfirstlane((int)threadIdx.x >> 6);
    { const int t0_ = tidx_(wv_s); if (t0_ < 4) bst[t0_] = 0u; }
    __syncthreads();
    if (blockIdx.x == 0) { for (int i = tidx_(wv_s); i < 4096; i += 512) __hip_atomic_store((unsigned*)(P.ws + WS_BAR) + i, 0u, __ATOMIC_RELAXED, __HIP_MEMORY_SCOPE_AGENT); }
#define GRID_BAR() xcd_barrier(xbar)
    const int G = gridDim.x, NGW = G * 8;
#define LP() Params Pl = P; Pl.wv = wv_s; { __attribute__((address_space(1))) unsigned char* wsg_ = (__attribute__((address_space(1))) unsigned char*)P.ws; asm volatile("" : "+s"(wsg_)); Pl.ws = (unsigned char*)wsg_; }
#ifdef PROBE_ID
    unsigned long long pt0 = 0, pt1 = 0;
#define UA_EXPORT() do { if (PROBE_ID >= 20 && PROBE_ID < 26 && layer == 0) { pt0 = uts[PROBE_ID - 20]; pt1 = (PROBE_ID == 25) ? __builtin_amdgcn_s_memrealtime() : uts[PROBE_ID - 19]; } } while (0)
#ifndef PROBE_LAYER
#define PROBE_LAYER 0
#endif
#define STAMP0(id, lay) do { if (PROBE_ID == (id) && (lay) == PROBE_LAYER) pt0 = __builtin_amdgcn_s_memrealtime(); } while (0)
#define STAMP1(id, lay) do { if (PROBE_ID == (id) && (lay) == PROBE_LAYER) pt1 = __builtin_amdgcn_s_memrealtime(); } while (0)
#else
#define UA_EXPORT() do {} while (0)
#define STAMP0(id, lay) do {} while (0)
#define STAMP1(id, lay) do {} while (0)
#endif
#define PH_IDS() int tid = tidx_(wv_s); const int lane = tid & 63, wave = __builtin_amdgcn_readfirstlane(tid >> 6), gw = blockIdx.x * 8 + wave; (void)lane; (void)gw;
    pg8::bf16_t* WIN = (pg8::bf16_t*)(P.ws + WS_WIN); pg8::bf16_t* WOUT = (pg8::bf16_t*)(P.ws + WS_WOUT); pg8::bf16_t* XB = (pg8::bf16_t*)(P.ws + WS_XB);
    pg8::bf16_t* PROJ = (pg8::bf16_t*)(P.ws + WS_PROJ); pg8::bf16_t* MIX = (pg8::bf16_t*)(P.ws + WS_MIX);
    float* SMALL = (float*)(P.ws + WS_SMALL); float* SSQ = (float*)(P.ws + WS_SSQ);
    STAMP0(30, PROBE_LAYER);
#ifdef PROBE_ID
    const unsigned kt0 = (unsigned)__builtin_amdgcn_s_memrealtime();
#endif
    STAMP0(1, 0);
    { PH_IDS(); LP(); phase_prologue(Pl, lds, gw, NGW, wave, lane); cp2::prologue_cmp(Pl, lds, gw, NGW, wave, lane); }
    grid.sync();
    XcdBarrier xbar = xcd_barrier_post((unsigned*)(P.ws + WS_BAR), bst, wv_s);
    STAMP1(1, 0);
    for (int layer = 0; layer < 2; ++layer) {
        STAMP0(2, layer);
        {
            const int small_pass = (int)((blockIdx.x >> 2) & 1);
#pragma nounroll
            for (int pass = 0; pass < 2; ++pass) {
                if (pass == 1 - small_pass) { __syncthreads(); LP(); sg::small_gemm(Pl, layer, lds); __syncthreads(); }
                if (pass == 0) {
                    pg8::Gemm g{XB, WIN + (size_t)layer * NP * D, M, 8192, D, wv_s}; pg8::StaticOrder S; S.init(M, 8192, G, (int)blockIdx.x);
                    pg8::EpiProj E{PROJ, NP, SSQ, SMALL};
                    pg8::gemm_phase<pg8::EpiProj, pg8::StaticOrder, true, true>((PG8_LAS unsigned char*)lds, g, S, E);
                }
            }
        }
        GRID_BAR();
        STAMP1(2, layer); STAMP0(3, layer);
        STAMP0(7, layer);
        __syncthreads(); STAMP1(7, layer);
        for (int sg = blockIdx.x; sg < 256; sg += G) { LP(); STAMP0(8, layer); ml::m0_prep(Pl, layer, sg, lds); STAMP1(8, layer); STAMP0(9, layer); ml::m1_state(Pl, sg, lds); STAMP1(9, layer); }
        GRID_BAR();
        STAMP1(3, layer); STAMP0(4, layer);
        {
            unsigned* qctr = (unsigned*)(P.ws + WS_BAR) + 3604 + layer; volatile unsigned* qslot = (volatile unsigned*)(lds + LDS_BYTES - 32);
            for (;;) {
                __syncthreads();
                if (tidx_(wv_s) == 0) *qslot = __hip_atomic_fetch_add(qctr, 1u, __ATOMIC_RELAXED, __HIP_MEMORY_SCOPE_AGENT);
                __syncthreads();
                const int it = (int)__builtin_amdgcn_readfirstlane(*qslot);
                if (it >= 256) break;
                LP();
                if (it < 128) cp2::compress_task(Pl, layer, it, lds);
                else ml::m2_scan(Pl, it - 128);
            }
        }
        GRID_BAR();
        STAMP1(4, layer); STAMP0(5, layer);
#ifdef PROBE_ID
        if (tidx_(wv_s) == 0) *(volatile unsigned long long*)(lds + LDS_BYTES - 64) = __builtin_amdgcn_s_memrealtime();
#endif
        {
            unsigned* qctr = (unsigned*)(P.ws + WS_BAR) + 3601 + layer; volatile unsigned* qslot = (volatile unsigned*)(lds + LDS_BYTES - 32);
            unsigned long long uts[8] = {0, 0, 0, 0, 0, 0, 0, 0}; (void)uts;
            for (;;) {
                __syncthreads();
                if (tidx_(wv_s) == 0) *qslot = __hip_atomic_fetch_add(qctr, 1u, __ATOMIC_RELAXED, __HIP_MEMORY_SCOPE_AGENT);
                __syncthreads();
                const int it = (int)__builtin_amdgcn_readfirstlane(*qslot);
                if (it >= 1280) break;
                LP();
                if (it < 448) { const int c = 127 - (it >> 2), bg = it & 3; at2::unit_a(Pl, layer, bg >> 1, bg & 1, c, lds, uts);
#ifdef PROBE_ID
                    if (it == 0 && layer == 0 && tidx_(wv_s) == 0) { for (int q = 0; q < 5; ++q) ((unsigned*)(P.ws + WS_BAR))[3620 + q] = (unsigned)(uts[q + 1] - uts[q]); ((unsigned*)(P.ws + WS_BAR))[3625] = (unsigned)(uts[0] - uts[6]); ((unsigned*)(P.ws + WS_BAR))[3626] = (unsigned)(uts[7] - uts[5]); }
#endif
                }
                else if (it < 704) ml::m3_out(Pl, layer, it - 448, lds);
                else if (it < 768) { const int i2 = it - 704; const int c = 15 - (i2 >> 2), bg = i2 & 3; at2::unit_a(Pl, layer, bg >> 1, bg & 1, c, lds, uts); }
                else { const int u = it - 768, bg = u >> 7; at2::unit_c(Pl, layer, bg >> 1, bg & 1, u & 127, lds); }
            }
        }
#ifdef PROBE_ID
        if ((PROBE_ID == 31 || PROBE_ID == 32) && layer == PROBE_LAYER && tidx_(wv_s) == 0) { const unsigned d = (unsigned)(__builtin_amdgcn_s_memrealtime() - *(volatile unsigned long long*)(lds + LDS_BYTES - 64)); atomicMax((unsigned*)(P.ws + WS_BAR) + 3600, (PROBE_ID == 31) ? d : (0xffffffffu - d)); }
#endif
        GRID_BAR();
        STAMP1(5, layer); STAMP0(6, layer);
#ifdef PROBE_ID
        if ((PROBE_ID == 31 || PROBE_ID == 32) && layer == PROBE_LAYER) { const unsigned v = __hip_atomic_load((unsigned*)(P.ws + WS_BAR) + 3600, __ATOMIC_RELAXED, __HIP_MEMORY_SCOPE_AGENT); pt0 = 0; pt1 = (PROBE_ID == 31) ? v : (0xffffffffu - v); }
#endif
        {
            pg8::Gemm g{MIX, WOUT + (size_t)layer * D * D, M, D, D, wv_s}; pg8::StaticOrder S; S.init(M, D, G, (int)blockIdx.x);
            pg8::EpiOut E{XB, SSQ, D};
            pg8::gemm_phase<pg8::EpiOut, pg8::StaticOrder, true, true>((PG8_LAS unsigned char*)lds, g, S, E);
        }
        GRID_BAR();
        STAMP1(6, layer);
    }
    STAMP0(13, PROBE_LAYER);
    { PH_IDS(); LP(); phase_final(Pl, gw, NGW, lane); }
    STAMP1(13, PROBE_LAYER);
    STAMP1(30, PROBE_LAYER);
#ifdef PROBE_ID
    if (PROBE_ID == 33) { if (tidx_(wv_s) == 0) { atomicMax((unsigned*)(P.ws + WS_BAR) + 3640, 0xffffffffu - kt0); atomicMax((unsigned*)(P.ws + WS_BAR) + 3641, (unsigned)__builtin_amdgcn_s_memrealtime()); } GRID_BAR(); }
    __syncthreads();
    if (blockIdx.x == 0 && tidx_(wv_s) == 0) { if (PROBE_ID == 33) { const unsigned a = __hip_atomic_load((unsigned*)(P.ws + WS_BAR) + 3640, __ATOMIC_RELAXED, __HIP_MEMORY_SCOPE_AGENT), b = __hip_atomic_load((unsigned*)(P.ws + WS_BAR) + 3641, __ATOMIC_RELAXED, __HIP_MEMORY_SCOPE_AGENT); P.out[0] += (float)((b - (0xffffffffu - a)) / 1000u) * 0.1f; } else if (PROBE_ID >= 50 && PROBE_ID < 53) { const unsigned long long* q = (const unsigned long long*)(P.ws + WS_BAR + 15360); P.out[0] += (float)((unsigned)(q[PROBE_ID - 49] - q[PROBE_ID - 50]) / 100u) * 1.0f; } else if (PROBE_ID >= 40 && PROBE_ID < 47) P.out[0] += (float)(__hip_atomic_load((unsigned*)(P.ws + WS_BAR) + 3620 + (PROBE_ID - 40), __ATOMIC_RELAXED, __HIP_MEMORY_SCOPE_AGENT) / 100u) * 1.0f; else P.out[0] += (float)(pt1 - pt0) * 1.0e-4f; }
#endif
}

extern "C" void kernel_launch(void* const* d_in, const int* in_sizes, int n_in, void* d_out, int out_size, void* d_ws, size_t ws_size, hipStream_t stream) {
    static int grid = 0;
    if (grid == 0) {
        if (n_in != 17 || out_size != M * D || ws_size < WS_END) { fprintf(stderr, "kernel_launch: unexpected shapes (n_in %d out %d ws %zu)\n", n_in, out_size, ws_size); grid = -1; return; }
        int dev = 0, cus = 0, per_cu = 0;
        (void)hipGetDevice(&dev); (void)hipDeviceGetAttribute(&cus, hipDeviceAttributeMultiprocessorCount, dev);
        (void)hipFuncSetAttribute((const void*)hymba_fwd, hipFuncAttributeMaxDynamicSharedMemorySize, LDS_BYTES);
        (void)hipOccupancyMaxActiveBlocksPerMultiprocessor(&per_cu, (const void*)hymba_fwd, 512, LDS_BYTES);
        if (per_cu < 1) { fprintf(stderr, "kernel_launch: occupancy query reports %d blocks per CU\n", per_cu); grid = -1; return; }
        grid = cus;
    }
    if (grid < 0) return;
    Params p{};
    p.x = (const float*)d_in[0]; p.norm_g = (const float*)d_in[1]; p.w_in = (const float*)d_in[2]; p.w_out = (const float*)d_in[3];
    p.pe_k = (const float*)d_in[4]; p.w1_k = (const float*)d_in[5]; p.w2_k = (const float*)d_in[6]; p.pe_v = (const float*)d_in[7]; p.w1_v = (const float*)d_in[8]; p.w2_v = (const float*)d_in[9];
    p.conv_w = (const float*)d_in[10]; p.conv_b = (const float*)d_in[11]; p.i_bias = (const float*)d_in[12]; p.f_bias = (const float*)d_in[13]; p.mnorm_g = (const float*)d_in[14];
    p.sinks = (const float*)d_in[15]; p.final_g = (const float*)d_in[16]; p.out = (float*)d_out; p.ws = (unsigned char*)d_ws;
    void* args[] = {&p};
    hipError_t e = hipLaunchCooperativeKernel((const void*)hymba_fwd, dim3(grid), dim3(512), args, LDS_BYTES, stream);
    if (e != hipSuccess) fprintf(stderr, "kernel_launch: cooperative launch failed: %s (grid %d)\n", hipGetErrorString(e), grid);
}
```

```cpp
#include <hip/hip_runtime.h>
#include <hip/hip_cooperative_groups.h>
#include <cstdio>
#include <cstdint>
namespace cg = cooperative_groups;
__device__ __forceinline__ int tidx_(int wv) { int l; asm volatile("v_mbcnt_lo_u32_b32 %0, -1, 0\n\tv_mbcnt_hi_u32_b32 %0, -1, %0" : "=v"(l)); return wv * 64 + l; }
namespace pg8 {
#define PG8_LAS __attribute__((address_space(3)))
typedef unsigned short bf16_t;
typedef short bf16x8 __attribute__((ext_vector_type(8)));
typedef float f32x4 __attribute__((ext_vector_type(4)));
typedef unsigned u32x4 __attribute__((ext_vector_type(4)));
constexpr int BM = 256, BK = 64, HALF = 128, HTB = HALF * BK * 2  , STAGE_BYTES = 8 * HTB, NXCD = 8, WGM = 8;

__host__ __device__ __forceinline__ int lds_byte(int r, int c) { const int st = (r >> 4) * 2 + (c >> 5), rr = r & 15, cc = c & 31, ob = rr * 64 + cc * 2; return st * 1024 + (ob ^ (((ob >> 9) & 1) << 5)); }
__host__ __device__ __forceinline__ void stage_rc(int b, int& R, int& C) { const int st = b / 1024, sb = b % 1024, swz = sb ^ (((sb >> 9) & 1) << 5); R = (st >> 1) * 16 + swz / 64; C = (st & 1) * 32 + (swz % 64) / 2; }
__host__ __device__ __forceinline__ int perm32(int rho) { const int n = rho >> 4, i = rho & 15; return 8 * (i >> 2) + 4 * n + (i & 3); }

struct Unit { int pm, pn; };
struct Gemm { const bf16_t* A; const bf16_t* Bt; int M, N, K, wv; };

__host__ __device__ inline int static_pm_of(int M, int N, int G, int c, int i) {
    const int nM = M / BM, nN = N / BM, nwg = nM * nN; const long L = (long)i * G + c; if (L >= nwg) return -1;
    int wgid = (int)L; { const int q = nwg / NXCD, r = nwg % NXCD, xcd = wgid % NXCD, off = wgid / NXCD; wgid = (xcd < r ? xcd * (q + 1) : r * (q + 1) + (xcd - r) * q) + off; }
    const int nig = WGM * nN, gid = wgid / nig, fm = gid * WGM, gsz = (nM - fm) < WGM ? (nM - fm) : WGM;
    return fm + ((wgid % nig) % gsz);
}
struct StaticOrder {
    int nM, nN, nwg, G, c;
    __host__ __device__ void init(int M, int N, int G_, int c_) { nM = M / BM; nN = N / BM; nwg = nM * nN; G = G_; c = c_; }
    __host__ __device__ bool next(int i, Unit& u) const {
        const long L = (long)i * G + c; if (L >= nwg) return false;
        int wgid = (int)L; { const int q = nwg / NXCD, r = nwg % NXCD, xcd = wgid % NXCD, off = wgid / NXCD; wgid = (xcd < r ? xcd * (q + 1) : r * (q + 1) + (xcd - r) * q) + off; }
        const int nig = WGM * nN, gid = wgid / nig, fm = gid * WGM, gsz = (nM - fm) < WGM ? (nM - fm) : WGM;
        u.pm = fm + ((wgid % nig) % gsz); u.pn = (wgid % nig) / gsz; return true;
    }
    __device__ __forceinline__ void a_ready(const Unit&) const {}
    __device__ __forceinline__ void done(const Unit&) const {}
};

__device__ __forceinline__ unsigned cvt_pk_bf16(float lo, float hi) { unsigned r; asm volatile("v_cvt_pk_bf16_f32 %0, %1, %2" : "=v"(r) : "v"(lo), "v"(hi)); return r; }
typedef float f32x2 __attribute__((ext_vector_type(2)));
struct EpiProj {
    static constexpr bool PERM = true, AFTER_DRAIN = false;
    bf16_t* O; int ldc; const float* ssq; float* small_;
    __device__ __forceinline__ void operator()(const f32x4 (&acc)[2][2][4][2], const Unit& u, int wr, int wc, int fr, int fq) const {
        const int row0 = u.pm * BM + wr * 64 + fr;
        float mine[2];
#pragma unroll
        for (int q = 0; q < 2; ++q) { const int idx = 2 * fq + q; const int row = row0 + (idx >> 2) * HALF + (idx & 3) * 16;
            const f32x4* sp = (const f32x4*)(ssq + (size_t)row * 32); f32x4 s4 = sp[0];
#pragma unroll
            for (int j = 1; j < 8; ++j) s4 += sp[j];
            mine[q] = 1.0f / sqrtf(((s4[0] + s4[1]) + (s4[2] + s4[3])) * (1.0f / 2048.0f) + 1.0e-6f); }
#pragma unroll
        for (int ai = 0; ai < 2; ++ai)
#pragma unroll
            for (int m = 0; m < 4; ++m) {
                const int row = row0 + ai * HALF + m * 16; const int idx = ai * 4 + m;
                const float rstd = __shfl(mine[idx & 1], fr + 16 * (idx >> 1));
                if (u.pn < 32) {
                    bf16_t* rowp = O + (size_t)row * ldc + u.pn * BM + wc * 32 + 8 * fq;
#pragma unroll
                    for (int bj = 0; bj < 2; ++bj) { const f32x4 v0 = acc[ai][bj][m][0] * rstd, v1 = acc[ai][bj][m][1] * rstd;
                        u32x4 w; w.x = cvt_pk_bf16(v0[0], v0[1]); w.y = cvt_pk_bf16(v0[2], v0[3]); w.z = cvt_pk_bf16(v1[0], v1[1]); w.w = cvt_pk_bf16(v1[2], v1[3]);
                        *(u32x4*)(rowp + bj * HALF) = w; }
                } else if (wc == 0) {
                    float* sp2 = small_ + (size_t)row * 32 + 8 * fq;
                    *(f32x4*)(sp2) = acc[ai][0][m][0] * rstd; *(f32x4*)(sp2 + 4) = acc[ai][0][m][1] * rstd;
                }
            }
    }
};
struct EpiProjTab {
    static constexpr bool PERM = true, AFTER_DRAIN = false;
    bf16_t* O; int ldc; const float* rtab;
    __device__ __forceinline__ void operator()(const f32x4 (&acc)[2][2][4][2], const Unit& u, int wr, int wc, int fr, int fq) const {
        const int rl0 = wr * 64 + fr; const int row0 = u.pm * BM + rl0;
#pragma unroll
        for (int ai = 0; ai < 2; ++ai)
#pragma unroll
            for (int m = 0; m < 4; ++m) {
                const int row = row0 + ai * HALF + m * 16; const float rstd = rtab[rl0 + ai * HALF + m * 16];
                bf16_t* rowp = O + (size_t)row * ldc + u.pn * BM + wc * 32 + 8 * fq;
#pragma unroll
                for (int bj = 0; bj < 2; ++bj) { const f32x4 v0 = acc[ai][bj][m][0] * rstd, v1 = acc[ai][bj][m][1] * rstd;
                    u32x4 w; w.x = cvt_pk_bf16(v0[0], v0[1]); w.y = cvt_pk_bf16(v0[2], v0[3]); w.z = cvt_pk_bf16(v1[0], v1[1]); w.w = cvt_pk_bf16(v1[2], v1[3]);
                    *(u32x4*)(rowp + bj * HALF) = w; }
            }
    }
};
struct EpiOut {
    static constexpr bool PERM = true, AFTER_DRAIN = false;
    bf16_t* xb; float* ssq; int ldc;
    __device__ __forceinline__ void operator()(const f32x4 (&acc)[2][2][4][2], const Unit& u, int wr, int wc, int fr, int fq) const {
        const int row0 = u.pm * BM + wr * 64 + fr, col0 = u.pn * BM + wc * 32 + 8 * fq;
#pragma unroll
        for (int ai = 0; ai < 2; ++ai) {
            u32x4 xv[4][2];
#pragma unroll
            for (int m = 0; m < 4; ++m)
#pragma unroll
                for (int bj = 0; bj < 2; ++bj) xv[m][bj] = *(const u32x4*)(xb + (size_t)(row0 + ai * HALF + m * 16) * ldc + col0 + bj * HALF);
            asm volatile("" ::: "memory");
#pragma unroll
            for (int m = 0; m < 4; ++m) {
                const int row = row0 + ai * HALF + m * 16; float s = 0.f;
#pragma unroll
                for (int bj = 0; bj < 2; ++bj) { const u32x4 x = xv[m][bj]; f32x4 v0 = acc[ai][bj][m][0], v1 = acc[ai][bj][m][1];
                    v0[0] += __uint_as_float(x.x << 16); v0[1] += __uint_as_float(x.x & 0xffff0000u); v0[2] += __uint_as_float(x.y << 16); v0[3] += __uint_as_float(x.y & 0xffff0000u);
                    v1[0] += __uint_as_float(x.z << 16); v1[1] += __uint_as_float(x.z & 0xffff0000u); v1[2] += __uint_as_float(x.w << 16); v1[3] += __uint_as_float(x.w & 0xffff0000u);
                    u32x4 w; w.x = cvt_pk_bf16(v0[0], v0[1]); w.y = cvt_pk_bf16(v0[2], v0[3]); w.z = cvt_pk_bf16(v1[0], v1[1]); w.w = cvt_pk_bf16(v1[2], v1[3]);
                    *(u32x4*)(xb + (size_t)row * ldc + col0 + bj * HALF) = w;
                    s += ((v0[0] * v0[0] + v0[1] * v0[1]) + (v0[2] * v0[2] + v0[3] * v0[3])) + ((v1[0] * v1[0] + v1[1] * v1[1]) + (v1[2] * v1[2] + v1[3] * v1[3])); }
                s += __shfl_xor(s, 16); s += __shfl_xor(s, 32);
                if (fq == 0) ssq[(size_t)row * 32 + u.pn * 4 + wc] = s;
            }
        }
    }
};
struct OneUnit { int pm, pn;
    __device__ __forceinline__ bool next(int i, Unit& u) const { if (i != 0) return false; u.pm = pm; u.pn = pn; return true; }
    __device__ __forceinline__ void a_ready(const Unit&) const {}
    __device__ __forceinline__ void done(const Unit&) const {} };
template <class Epi, class Sched, bool ALIGN_EPI = false, bool SP2 = false>
__device__ __forceinline__ void gemm_phase(PG8_LAS unsigned char* lds, const Gemm g, const Sched& S, const Epi& E) {
    int tid_ = tidx_(g.wv); const int tid = tid_, wid = __builtin_amdgcn_readfirstlane(tid >> 6), lane = tid & 63, wr = wid >> 2, wc = wid & 3, fr = lane & 15, fq = lane >> 4;
    const int K = g.K, nt = K / BK;
    unsigned voffA[2], voffB[2];
#pragma unroll
    for (int i = 0; i < 2; ++i) { int R, C; stage_rc(tid * 16 + i * 8192, R, C); const int Rb = Epi::PERM ? ((R & ~31) + perm32(R & 31)) : R;
        voffA[i] = (unsigned)(R * K + C) * 2u; voffB[i] = (unsigned)(Rb * K + C) * 2u; }
    const size_t kstep = (size_t)(BK * 2);
    const size_t hstep = (size_t)HALF * K * 2;
    const size_t tstep = 2 * hstep;
    const unsigned ldsw = (unsigned)wid * 1024u;
    const int aoff = lds_byte(wr * 64 + fr, fq * 8), boff = lds_byte(wc * 32 + fr, fq * 8);
#define PG8_SA(b, h) (((b) * 2 + (h)) * HTB)
#define PG8_SB(b, h) ((4 + (b) * 2 + (h)) * HTB)
#define PG8_STAGE(bufoff, gbase, voff) do { _Pragma("unroll") for (int _i = 0; _i < 2; ++_i) \
        __builtin_amdgcn_global_load_lds((const unsigned*)((const char*)(gbase) + (voff)[_i]), (PG8_LAS unsigned*)(lds + (bufoff) + ldsw + _i * 8192), 16, 0, 0); } while (0)
#define PG8_LDA(dst, b, h) do { _Pragma("unroll") for (int m = 0; m < 4; ++m) _Pragma("unroll") for (int k = 0; k < 2; ++k) dst[m][k] = *(const PG8_LAS bf16x8*)(lds + PG8_SA(b, h) + aoff + m * 2048 + k * 1024); } while (0)
#define PG8_LDB(dst, b, h) do { _Pragma("unroll") for (int n = 0; n < 2; ++n) _Pragma("unroll") for (int k = 0; k < 2; ++k) dst[n][k] = *(const PG8_LAS bf16x8*)(lds + PG8_SB(b, h) + boff + n * 2048 + k * 1024); } while (0)
#define PG8_MMA(ai, bj, At, Bt) do { __builtin_amdgcn_s_setprio(1); _Pragma("unroll") for (int m = 0; m < 4; ++m) _Pragma("unroll") for (int n = 0; n < 2; ++n) _Pragma("unroll") for (int k = 0; k < 2; ++k) \
        acc[ai][bj][m][n] = __builtin_amdgcn_mfma_f32_16x16x32_bf16(Bt[n][k], At[m][k], acc[ai][bj][m][n], 0, 0, 0); __builtin_amdgcn_s_setprio(0); } while (0)
#define PG8_WAIT_V(n) asm volatile("s_waitcnt vmcnt(" #n ")" ::: "memory")
#define PG8_WAIT_L(n) asm volatile("s_waitcnt lgkmcnt(" #n ")" ::: "memory")
#define PG8_BAR __builtin_amdgcn_s_barrier()
#define PG8_SCHED __builtin_amdgcn_sched_barrier(0)
    Unit cur, nxt; int ui = 0;
    if (!S.next(0, cur)) return;
    f32x4 acc[2][2][4][2];
#pragma unroll
    for (int a = 0; a < 2; ++a)
#pragma unroll
        for (int b = 0; b < 2; ++b)
#pragma unroll
            for (int m = 0; m < 4; ++m)
#pragma unroll
                for (int n = 0; n < 2; ++n) acc[a][b][m][n] = (f32x4){0.f, 0.f, 0.f, 0.f};
    bf16x8 At[4][2], B0[2][2], B1[2][2];
    const char* cA = (const char*)g.A + (size_t)cur.pm * tstep; const char* cB = (const char*)g.Bt + (size_t)cur.pn * tstep;
    S.a_ready(cur);
    if constexpr (SP2) {
        PG8_STAGE(PG8_SB(0, 0), cB, voffB); PG8_STAGE(PG8_SB(0, 1), cB + hstep, voffB); PG8_STAGE(PG8_SA(0, 0), cA, voffA); PG8_STAGE(PG8_SA(0, 1), cA + hstep, voffA);
        if (wr == 1) PG8_BAR;
        PG8_WAIT_V(2); PG8_BAR;
        PG8_STAGE(PG8_SB(1, 0), cB + kstep, voffB); PG8_STAGE(PG8_SA(1, 0), cA + kstep, voffA); PG8_STAGE(PG8_SB(1, 1), cB + hstep + kstep, voffB);
        PG8_WAIT_V(6); PG8_BAR;
    } else {
        PG8_STAGE(PG8_SB(0, 0), cB, voffB); PG8_STAGE(PG8_SA(0, 0), cA, voffA); PG8_STAGE(PG8_SB(0, 1), cB + hstep, voffB); PG8_STAGE(PG8_SA(0, 1), cA + hstep, voffA);
        if (wr == 1) PG8_BAR;
        PG8_WAIT_V(4); PG8_BAR;
        PG8_STAGE(PG8_SB(1, 0), cB + kstep, voffB); PG8_STAGE(PG8_SA(1, 0), cA + kstep, voffA); PG8_STAGE(PG8_SB(1, 1), cB + hstep + kstep, voffB);
        PG8_WAIT_V(6); PG8_BAR;
    }
    for (;;) {
        const bool has_next = S.next(ui + 1, nxt);
        const char* nA = has_next ? (const char*)g.A + (size_t)nxt.pm * tstep : cA; const char* nB = has_next ? (const char*)g.Bt + (size_t)nxt.pn * tstep : cB;
        for (int t = 0; t < nt; t += 2) {
            const bool last = (t == nt - 2);
            const char* a1 = cA + (size_t)(t + 1) * kstep;
            const char* a2 = last ? nA : cA + (size_t)(t + 2) * kstep; const char* b2 = last ? nB : cB + (size_t)(t + 2) * kstep;
            const char* a3 = a2 + kstep; const char* b3 = b2 + kstep;
            if (last && has_next) S.a_ready(nxt);
            if constexpr (SP2) {
            PG8_LDB(B0, 0, 0); PG8_LDB(B1, 0, 1); PG8_SCHED; PG8_LDA(At, 0, 0); PG8_STAGE(PG8_SA(1, 1), a1 + hstep, voffA);
            PG8_WAIT_V(8); PG8_WAIT_L(0); PG8_BAR; PG8_MMA(0, 0, At, B0); PG8_MMA(0, 1, At, B1); PG8_BAR; PG8_SCHED;
            PG8_LDA(At, 0, 1); PG8_STAGE(PG8_SB(0, 0), b2, voffB); PG8_STAGE(PG8_SB(0, 1), b2 + hstep, voffB); PG8_STAGE(PG8_SA(0, 0), a2, voffA);
            PG8_WAIT_V(8); PG8_WAIT_L(0); PG8_BAR; PG8_MMA(1, 0, At, B0); PG8_MMA(1, 1, At, B1); PG8_BAR; PG8_SCHED;
            PG8_LDB(B0, 1, 0); PG8_LDB(B1, 1, 1); PG8_SCHED; PG8_LDA(At, 1, 0); PG8_STAGE(PG8_SA(0, 1), a2 + hstep, voffA);
            PG8_WAIT_V(8); PG8_WAIT_L(0); PG8_BAR; PG8_MMA(0, 0, At, B0); PG8_MMA(0, 1, At, B1); PG8_BAR; PG8_SCHED;
            PG8_LDA(At, 1, 1); PG8_STAGE(PG8_SB(1, 0), b3, voffB); PG8_STAGE(PG8_SB(1, 1), b3 + hstep, voffB); PG8_STAGE(PG8_SA(1, 0), a3, voffA);
            PG8_WAIT_V(8); PG8_WAIT_L(0); PG8_BAR; PG8_MMA(1, 0, At, B0); PG8_MMA(1, 1, At, B1); PG8_BAR; PG8_SCHED;
            } else {
            PG8_LDB(B0, 0, 0); PG8_SCHED; PG8_LDA(At, 0, 0); PG8_STAGE(PG8_SA(1, 1), a1 + hstep, voffA);
            PG8_WAIT_L(8); PG8_BAR; PG8_WAIT_L(0); PG8_MMA(0, 0, At, B0); PG8_BAR; PG8_SCHED;
            PG8_LDB(B1, 0, 1); PG8_STAGE(PG8_SB(0, 0), b2, voffB);
            PG8_BAR; PG8_WAIT_L(0); PG8_MMA(0, 1, At, B1); PG8_BAR;
            PG8_LDA(At, 0, 1); PG8_STAGE(PG8_SA(0, 0), a2, voffA);
            PG8_BAR; PG8_WAIT_L(0); PG8_MMA(1, 0, At, B0); PG8_BAR; PG8_SCHED;
            PG8_STAGE(PG8_SB(0, 1), b2 + hstep, voffB);
            PG8_WAIT_V(6); PG8_BAR; PG8_MMA(1, 1, At, B1); PG8_BAR;
            PG8_LDB(B0, 1, 0); PG8_SCHED; PG8_LDA(At, 1, 0); PG8_STAGE(PG8_SA(0, 1), a2 + hstep, voffA);
            PG8_WAIT_L(8); PG8_BAR; PG8_WAIT_L(0); PG8_MMA(0, 0, At, B0); PG8_BAR; PG8_SCHED;
            PG8_LDB(B1, 1, 1); PG8_STAGE(PG8_SB(1, 0), b3, voffB);
            PG8_BAR; PG8_WAIT_L(0); PG8_MMA(0, 1, At, B1); PG8_BAR;
            PG8_LDA(At, 1, 1); PG8_STAGE(PG8_SA(1, 0), a3, voffA);
            PG8_BAR; PG8_WAIT_L(0); PG8_MMA(1, 0, At, B0); PG8_BAR; PG8_SCHED;
            PG8_STAGE(PG8_SB(1, 1), b3 + hstep, voffB);
            PG8_WAIT_V(6); PG8_BAR; PG8_MMA(1, 1, At, B1); PG8_BAR;
            }
        }
        if constexpr (ALIGN_EPI) { if (wr == 0) PG8_BAR; }
#ifdef PG8_PROBE
        const unsigned long long e0_ = __builtin_amdgcn_s_memrealtime();
#endif
        if constexpr (!Epi::AFTER_DRAIN) { E(acc, cur, wr, wc, fr, fq); S.done(cur); }
#ifdef PG8_PROBE
        if (wid == 0) { const unsigned long long d_ = __builtin_amdgcn_s_memrealtime() - e0_; volatile PG8_LAS unsigned long long* pa_ = (volatile PG8_LAS unsigned long long*)(lds + 155592); *pa_ = *pa_ + d_; }
#endif
        if (!has_next) break;
#pragma unroll
        for (int a = 0; a < 2; ++a)
#pragma unroll
            for (int b = 0; b < 2; ++b)
#pragma unroll
                for (int m = 0; m < 4; ++m)
#pragma unroll
                    for (int n = 0; n < 2; ++n) acc[a][b][m][n] = (f32x4){0.f, 0.f, 0.f, 0.f};
        cur = nxt; cA = nA; cB = nB; ++ui;
        if constexpr (ALIGN_EPI) { if (wr == 1) PG8_BAR; }
    }
    PG8_WAIT_V(0);
    if constexpr (!ALIGN_EPI) { if (wr == 0) PG8_BAR; }
    PG8_BAR;
    if constexpr (Epi::AFTER_DRAIN) { E.fused(acc, cur, wr, wc, fr, fq, lds, wid, lane); S.done(cur); }
#undef PG8_SA
#undef PG8_SB
#undef PG8_STAGE
#undef PG8_LDA
#undef PG8_LDB
#undef PG8_MMA
#undef PG8_WAIT_V
#undef PG8_WAIT_L
#undef PG8_BAR
#undef PG8_SCHED
}
}
constexpr int BATCH = 2, T = 8192, M = BATCH * T, D = 2048, NP = 8448, NIN = 8224;
constexpr int C_AQ = 0, C_AKC = 512, C_AVC = 640, C_AKS = 768, C_AVS = 896, C_AKW = 1024, C_AVW = 1152, C_AZ = 1280, C_BQ = 1792, C_BK = 2816, C_BV = 3840, C_BO = 4864, C_BZ = 5888,
              C_CQ = 6912, C_CK = 7424, C_CV = 7552, C_CZ = 7680;
constexpr int S_GATE = 0, S_I = 24, S_F = 28;
constexpr int NCMP = 511, CMP_PITCH = 512;
constexpr float EPS = 1.0e-6f, NEG = -1.0e30f;
constexpr size_t MiB = 1u << 20;
constexpr size_t WS_WIN = 0, WS_WOUT = 66 * MiB, WS_XB = 82 * MiB, WS_PROJ = 146 * MiB, WS_MIX = 410 * MiB, WS_SMALL = 474 * MiB, WS_SSQ = 476 * MiB, WS_KCMP = 478 * MiB, WS_VCMP = WS_KCMP + 512 * 1024, WS_END = 514 * MiB;
constexpr size_t WS_BAR = 513 * MiB + 65536;
constexpr int LDS_BYTES = 155648;
typedef unsigned short bf16;
typedef float f4 __attribute__((ext_vector_type(4)));
typedef unsigned u4 __attribute__((ext_vector_type(4)));

__device__ __forceinline__ float bf2f(unsigned short u) { return __uint_as_float(((unsigned)u) << 16); }
typedef float f32x2_hw __attribute__((ext_vector_type(2))); typedef __bf16 bf16x2_hw __attribute__((ext_vector_type(2)));
__device__ __forceinline__ unsigned pk2(float lo, float hi) { f32x2_hw v = {lo, hi}; bf16x2_hw r = __builtin_convertvector(v, bf16x2_hw); return __builtin_bit_cast(unsigned, r); }
__device__ __forceinline__ unsigned f2bf(float f) { return pk2(f, 0.f) & 0xffffu; }
__device__ __forceinline__ float wsum(float v) {
#pragma unroll
    for (int o = 1; o < 64; o <<= 1) v += __shfl_xor(v, o);
    return v; }
__device__ __forceinline__ float wmax(float v) {
#pragma unroll
    for (int o = 1; o < 64; o <<= 1) v = fmaxf(v, __shfl_xor(v, o));
    return v; }
__device__ __forceinline__ float sigmoidf_(float x) { return __builtin_amdgcn_rcpf(1.0f + __expf(-x)); }
__device__ __forceinline__ float siluf_(float x) { return x * __builtin_amdgcn_rcpf(1.0f + __expf(-x)); }
__device__ __forceinline__ float logsigmoidf_(float x) { return fminf(x, 0.f) - log1pf(__expf(-fabsf(x))); }

struct Params {
    const float* x; const float* norm_g; const float* w_in; const float* w_out;
    const float* pe_k; const float* w1_k; const float* w2_k; const float* pe_v; const float* w1_v; const float* w2_v;
    const float* conv_w; const float* conv_b; const float* i_bias; const float* f_bias; const float* mnorm_g; const float* sinks; const float* final_g;
    float* out; unsigned char* ws; int wv;
};

__device__ __forceinline__ int orig_col(int n) {
    if (n < 1280) return n;
    if (n < 4864) return n + 24;
    if (n < 8192) return n + 32;
    if (n < 8216) return 1280 + (n - 8192);
    if (n < 8224) return 4888 + (n - 8216);
    return -1;
}

__device__ __forceinline__ void transpose_item(const float* W, int K, int Nsrc, bool mapped, const float* g, bf16* WT, int nblk, float* scr, int item, int lane) {
    const int kb = item / nblk, nb = item % nblk, k0 = 64 * kb, n0 = 32 * nb;
    const int n = n0 + (lane & 31); const int oc = mapped ? orig_col(n) : n;
#pragma unroll 8
    for (int i = 0; i < 32; ++i) { const int kk = 2 * i + (lane >> 5); float v = 0.f;
        if (oc >= 0) { v = W[(size_t)(k0 + kk) * Nsrc + oc]; if (g) v *= g[k0 + kk]; }
        scr[kk * 33 + (lane & 31)] = v; }
    __builtin_amdgcn_wave_barrier(); asm volatile("s_waitcnt lgkmcnt(0)" ::: "memory");
    const int c = lane & 7;
#pragma unroll
    for (int j = 0; j < 4; ++j) { const int nn = (lane >> 3) + 8 * j; const float* s = scr + (8 * c) * 33 + nn;
        u4 o; o.x = pk2(s[0 * 33], s[1 * 33]); o.y = pk2(s[2 * 33], s[3 * 33]); o.z = pk2(s[4 * 33], s[5 * 33]); o.w = pk2(s[6 * 33], s[7 * 33]);
        *(u4*)(WT + (size_t)(n0 + nn) * K + k0 + 8 * c) = o; }
    __builtin_amdgcn_wave_barrier(); asm volatile("s_waitcnt lgkmcnt(0)" ::: "memory");
}
__device__ __forceinline__ void transpose_tile(const float* W, int K, int Nsrc, bool mapped, const float* g, bf16* WT, int ntile, unsigned char* lds, int tile, int tid) {
    float* tl = (float*)lds; const int kb = tile / ntile, nb = tile % ntile, k0 = 64 * kb, n0 = 256 * nb;
    __syncthreads();
    { const int c4 = tid & 63, r0 = tid >> 6; const int n = n0 + c4 * 4; const int oc = mapped ? orig_col(n) : n;
      float gs[8];
#pragma unroll
      for (int i = 0; i < 8; ++i) gs[i] = g ? g[k0 + r0 + 8 * i] : 1.0f;
      f4 wv[8];
#pragma unroll
      for (int i = 0; i < 8; ++i) { wv[i] = (f4){0.f, 0.f, 0.f, 0.f}; if (oc >= 0) wv[i] = *(const f4*)(W + (size_t)(k0 + r0 + 8 * i) * Nsrc + oc); }
#pragma unroll
      for (int i = 0; i < 8; ++i) { const int kk = r0 + 8 * i; f4 v = wv[i] * gs[i];
          float* d = tl + kk * 257 + c4 * 4; d[0] = v[0]; d[1] = v[1]; d[2] = v[2]; d[3] = v[3]; } }
    __syncthreads();
    { const int c = tid & 7, nn0 = tid >> 3;
#pragma unroll
      for (int j = 0; j < 4; ++j) { const int nn = nn0 + 64 * j; const float* s = tl + (8 * c) * 257 + nn;
          u4 o; o.x = pk2(s[0 * 257], s[1 * 257]); o.y = pk2(s[2 * 257], s[3 * 257]); o.z = pk2(s[4 * 257], s[5 * 257]); o.w = pk2(s[6 * 257], s[7 * 257]);
          *(u4*)(WT + (size_t)(n0 + nn) * K + k0 + 8 * c) = o; } }
}
struct PTile { const float* W; const float* g; bf16* WT; int Nsrc, k0, n0; bool mapped; };
__device__ __forceinline__ PTile ptile_of(const Params& P, int it) {
    constexpr int T_IN = (D / 64) * (NP / 256), T_OUT = (D / 64) * (D / 256);
    PTile t; int r = it;
    if (r < 2 * T_IN) { const int l = r / T_IN; r -= l * T_IN; t.W = P.w_in + (size_t)l * D * NIN; t.g = P.norm_g + l * D; t.WT = (bf16*)(P.ws + WS_WIN) + (size_t)l * NP * D; t.Nsrc = NIN; t.mapped = true;
        t.k0 = 64 * (r / (NP / 256)); t.n0 = 256 * (r % (NP / 256)); }
    else { r -= 2 * T_IN; const int l = r / T_OUT; r -= l * T_OUT; t.W = P.w_out + (size_t)l * D * D; t.g = nullptr; t.WT = (bf16*)(P.ws + WS_WOUT) + (size_t)l * D * D; t.Nsrc = D; t.mapped = false;
        t.k0 = 64 * (r / (D / 256)); t.n0 = 256 * (r % (D / 256)); }
    return t;
}
__device__ __forceinline__ void phase_prologue(const Params& P, unsigned char* lds, int gw, int NGW, int wave, int lane) {
    constexpr int T_IN = (D / 64) * (NP / 256), T_OUT = (D / 64) * (D / 256), NTILES = 2 * T_IN + 2 * T_OUT;
    const int tid = wave * 64 + lane; float* tl = (float*)lds;
    const int c4 = tid & 63, r0 = tid >> 6;
    float gs[8]; f4 wv[8];
#define PT_LOAD(t) do { const int n_ = (t).n0 + c4 * 4; const int oc_ = (t).mapped ? orig_col(n_) : n_; \
        _Pragma("unroll") for (int i = 0; i < 8; ++i) gs[i] = (t).g ? (t).g[(t).k0 + r0 + 8 * i] : 1.0f; \
        _Pragma("unroll") for (int i = 0; i < 8; ++i) { wv[i] = (f4){0.f, 0.f, 0.f, 0.f}; if (oc_ >= 0) wv[i] = *(const f4*)((t).W + (size_t)((t).k0 + r0 + 8 * i) * (t).Nsrc + oc_); } } while (0)
    int it = blockIdx.x;
    if (it < NTILES) { const PTile t = ptile_of(P, it); PT_LOAD(t); }
    for (; it < NTILES; it += gridDim.x) {
        const PTile t = ptile_of(P, it);
        __syncthreads();
#pragma unroll
        for (int i = 0; i < 8; ++i) { const int kk = r0 + 8 * i; const f4 v = wv[i] * gs[i];
            float* d = tl + kk * 257 + c4 * 4; d[0] = v[0]; d[1] = v[1]; d[2] = v[2]; d[3] = v[3]; }
        if (it + (int)gridDim.x < NTILES) { const PTile tn = ptile_of(P, it + (int)gridDim.x); PT_LOAD(tn); }
        __syncthreads();
        { const int c = tid & 7, nn0 = tid >> 3;
#pragma unroll
          for (int j = 0; j < 4; ++j) { const int nn = nn0 + 64 * j; const float* s = tl + (8 * c) * 257 + nn;
              u4 o; o.x = pk2(s[0 * 257], s[1 * 257]); o.y = pk2(s[2 * 257], s[3 * 257]); o.z = pk2(s[4 * 257], s[5 * 257]); o.w = pk2(s[6 * 257], s[7 * 257]);
              *(u4*)(t.WT + (size_t)(t.n0 + nn) * D + t.k0 + 8 * c) = o; } }
    }
#undef PT_LOAD
    __syncthreads();
    bf16* XB = (bf16*)(P.ws + WS_XB); float* SSQ = (float*)(P.ws + WS_SSQ);
    f4 xv[8];
    if (gw < M) { const f4* xr = (const f4*)(P.x + (size_t)gw * D) + lane;
#pragma unroll
        for (int j = 0; j < 8; ++j) xv[j] = xr[64 * j]; }
    for (int m = gw; m < M; m += NGW) {
        unsigned long long* o8 = (unsigned long long*)(XB + (size_t)m * D) + lane; float s = 0.f;
        unsigned long long ov[8];
#pragma unroll
        for (int j = 0; j < 8; ++j) { const f4 v = xv[j]; s += (v[0] * v[0] + v[1] * v[1]) + (v[2] * v[2] + v[3] * v[3]); ov[j] = (unsigned long long)pk2(v[0], v[1]) | ((unsigned long long)pk2(v[2], v[3]) << 32); }
        if (m + NGW < M) { const f4* xr = (const f4*)(P.x + (size_t)(m + NGW) * D) + lane;
#pragma unroll
            for (int j = 0; j < 8; ++j) xv[j] = xr[64 * j]; }
        asm volatile("" ::: "memory");
#pragma unroll
        for (int j = 0; j < 8; ++j) o8[64 * j] = ov[j];
        s = wsum(s);
        if (lane < 32) SSQ[(size_t)m * 32 + lane] = (lane == 0) ? s : 0.f;
    }
}

__device__ __forceinline__ void phase_compress(const Params& P, int layer, int gw, int NGW, int lane) {
    const bf16* PROJ = (const bf16*)(P.ws + WS_PROJ); bf16* KC = (bf16*)(P.ws + WS_KCMP);
    for (int it = gw; it < 2 * 2 * 2 * CMP_PITCH; it += NGW) {
        const int i = it % CMP_PITCH; int r = it / CMP_PITCH; const int g = r & 1; r >>= 1; const int b = r & 1; const int kv = r >> 1;
        bf16* dst = KC + ((size_t)(b * 2 + g) * CMP_PITCH + i) * 128 + kv * 64;
        if (i >= NCMP) { dst[lane] = 0; continue; }
        const float* pe = (kv ? P.pe_v : P.pe_k) + (size_t)layer * 32 * 64;
        const float* w1 = (kv ? P.w1_v : P.w1_k) + (size_t)layer * 2048 * 64;
        const float* w2 = (kv ? P.w2_v : P.w2_k) + (size_t)layer * 64 * 64;
        const bf16* src = PROJ + (size_t)(b * T + 16 * i) * NP + (kv ? C_AVC : C_AKC) + g * 64;
        float hid = 0.f;
        for (int l = 0; l < 32; ++l) {
            const bf16* row = src + (size_t)l * NP;
#pragma unroll 8
            for (int dd = 0; dd < 64; ++dd) { const float a = bf2f(row[dd]) + pe[l * 64 + dd]; hid += a * w1[(size_t)(l * 64 + dd) * 64 + lane]; }
        }
        hid = siluf_(hid);
        float o = 0.f;
        for (int k = 0; k < 64; ++k) o += __shfl(hid, k) * w2[k * 64 + lane];
        dst[lane] = (bf16)f2bf(o);
    }
}
#define LAS __attribute__((address_space(3)))
#define XB_TMO      128
#define XB_XCNT(j)  (256  + 64 * (j))
#define XB_XSUB(j)  (1280 + 64 * (j))
#define XB_XGEN(j)  (2304 + 64 * (j))
#define XB_TOP      3328
#define XB_TOPGEN   3392
#define XCD_BAR_WORDS 3456
#define XB_SPIN_CAP (1u << 18)

__device__ __forceinline__ unsigned xb_ld(unsigned* p)              { return __hip_atomic_load(p, __ATOMIC_RELAXED, __HIP_MEMORY_SCOPE_AGENT); }
__device__ __forceinline__ unsigned xb_add(unsigned* p, unsigned v) { return __hip_atomic_fetch_add(p, v, __ATOMIC_RELAXED, __HIP_MEMORY_SCOPE_AGENT); }
__device__ __forceinline__ unsigned xb_xcc_id() { return (unsigned)__builtin_amdgcn_s_getreg((3 << 11) | 20) & 0xFu; }
#define XB_SPIN(cond, bar) do { unsigned _sp = 0; while (cond) { __builtin_amdgcn_s_sleep(1); \
    if ((++_sp & 255u) == 0u) { if (xb_ld(&(bar)[XB_TMO])) break; if (_sp > XB_SPIN_CAP) { atomicAdd(&(bar)[XB_TMO], 1u); break; } } } } while (0)

struct XcdBarrier {
    unsigned* bar; unsigned x; int wv;
    volatile LAS unsigned* st;
};

__device__ __forceinline__ XcdBarrier xcd_barrier_post(unsigned* bar, volatile LAS unsigned* st, int wv) {
    XcdBarrier b; b.bar = bar; b.x = xb_xcc_id(); b.st = st; b.wv = wv;
    if (tidx_(wv) == 0) (void)xb_add(&bar[XB_XCNT(b.x)], 1u);
    return b;
}
__device__ __forceinline__ void xcd_barrier_complete(unsigned* bar, unsigned x, unsigned& nloc, unsigned& nx) {
    const unsigned G = gridDim.x * gridDim.y * gridDim.z;
    unsigned sum, cnt, mine, sp = 0u;
    for (;;) {
        sum = 0u; cnt = 0u; mine = 0u; unsigned cc[16];
#pragma unroll
        for (unsigned j = 0; j < 16; ++j) cc[j] = xb_ld(&bar[XB_XCNT(j)]);
#pragma unroll
        for (unsigned j = 0; j < 16; ++j) { const unsigned c = cc[j]; sum += c; cnt += (c > 0u) ? 1u : 0u; mine = (j == x) ? c : mine; }
        if (sum == G) break;
        __builtin_amdgcn_s_sleep(1);
        if ((++sp & 255u) == 0u) { if (xb_ld(&bar[XB_TMO])) break; if (sp > XB_SPIN_CAP) { atomicAdd(&bar[XB_TMO], 1u); break; } }
    }
    nloc = mine > 0u ? mine : 1u; nx = cnt > 0u ? cnt : 1u;
}

__device__ __forceinline__ void xcd_barrier(const XcdBarrier& b) {
    asm volatile("s_waitcnt vmcnt(0)" ::: "memory");
    __syncthreads();
    if (tidx_(b.wv) == 0) {
        unsigned* bar = b.bar; unsigned xq = b.x; asm volatile("" : "+s"(bar), "+s"(xq));
        __builtin_amdgcn_s_waitcnt(0);
        unsigned nloc = b.st[0], nx = b.st[1];
        if (nloc == 0u) { xcd_barrier_complete(bar, xq, nloc, nx); b.st[0] = nloc; b.st[1] = nx; }
        const unsigned old = xb_add(&bar[XB_XSUB(xq)], 1u);
        const unsigned gen = old / nloc;
        if (old + 1u == (gen + 1u) * nloc) {
            __builtin_amdgcn_fence(__ATOMIC_RELEASE, "agent");
            asm volatile("s_waitcnt vmcnt(0)" ::: "memory");
            const unsigned og = xb_add(&bar[XB_TOP], 1u);
            const unsigned tg = og / nx;
            if (og + 1u == (tg + 1u) * nx) xb_add(&bar[XB_TOPGEN], 1u);
            else XB_SPIN(xb_ld(&bar[XB_TOPGEN]) == tg, bar);
            __builtin_amdgcn_fence(__ATOMIC_ACQUIRE, "agent");
            xb_add(&bar[XB_XGEN(xq)], 1u);
            asm volatile("s_waitcnt vmcnt(0)" ::: "memory");
        } else {
            XB_SPIN(xb_ld(&bar[XB_XGEN(xq)]) == gen, bar);
            __builtin_amdgcn_fence(__ATOMIC_ACQUIRE, "agent");
            asm volatile("s_waitcnt vmcnt(0)" ::: "memory");
        }
    }
    __syncthreads();
}

namespace at2 {
typedef short bf16x8 __attribute__((ext_vector_type(8)));
typedef short s16x4 __attribute__((ext_vector_type(4)));
typedef float f32x16 __attribute__((ext_vector_type(16)));
typedef float f32x2_t __attribute__((ext_vector_type(2))); typedef __bf16 bf16x2_t __attribute__((ext_vector_type(2)));
typedef __attribute__((address_space(3))) const char* lds_cptr;
typedef short v4i16_t __attribute__((ext_vector_type(4)));
constexpr float C2 = 0.125f * 1.4426950408889634f;
constexpr float LOG2E = 1.4426950408889634f;
constexpr int IMPP = 132;
constexpr int L_KV = 0, L_ACC = 65536, L_IMP = L_ACC, L_SEL = 131072, L_WSF = 132096, L_GT = 133120, L_END = 136192;
__device__ __forceinline__ int crow(int r, int hi) { return (r & 3) + 8 * (r >> 2) + 4 * hi; }
__device__ __forceinline__ unsigned cvtpk(float lo, float hi) { f32x2_t v = {lo, hi}; bf16x2_t b = __builtin_convertvector(v, bf16x2_t); return __builtin_bit_cast(unsigned, b); }
__device__ __forceinline__ s16x4 vtr(lds_cptr p) { return __builtin_bit_cast(s16x4, __builtin_amdgcn_ds_read_tr16_b64_v4i16((__attribute__((address_space(3))) v4i16_t*)p)); }
__device__ __forceinline__ float swapmax(float m) { auto rr = __builtin_amdgcn_permlane32_swap(__float_as_uint(m), __float_as_uint(m), false, false); return fmaxf(__uint_as_float(rr[0]), __uint_as_float(rr[1])); }
__device__ __forceinline__ float swapsum(float m) { auto rr = __builtin_amdgcn_permlane32_swap(__float_as_uint(m), __float_as_uint(m), false, false); return __uint_as_float(rr[0]) + __uint_as_float(rr[1]); }
__device__ __forceinline__ float quadsum(float v) {
    v += __uint_as_float(__builtin_amdgcn_update_dpp(0u, __float_as_uint(v), 0xB1, 0xF, 0xF, true));
    v += __uint_as_float(__builtin_amdgcn_update_dpp(0u, __float_as_uint(v), 0x4E, 0xF, 0xF, true));
    return v; }

struct KVRegs { u4 k, v; };
__device__ __forceinline__ void kv_load(KVRegs& R, const bf16* base, size_t pitch, long row0, long rlo, long rhi, int kcol, int vcol, int tid) {
    const int key = tid >> 3, ch = tid & 7; long row = row0 + key; row = row < rlo ? rlo : (row > rhi ? rhi : row);
    const bf16* p = base + (size_t)row * pitch + ch * 8;
    R.k = *(const u4*)(p + kcol); R.v = *(const u4*)(p + vcol);
}
__device__ __forceinline__ void kv_store(const KVRegs& R, unsigned char* slot, int tid) {
    const int key = tid >> 3, ch = tid & 7;
    *(u4*)(slot + key * 128 + ((ch ^ (key & 7)) << 4)) = R.k;
    *(u4*)(slot + 8192 + (ch >> 2) * 4096 + (key >> 4) * 1024 + (key & 15) * 64 + (ch & 3) * 16) = R.v;
}
__device__ __forceinline__ void qk_tile(const unsigned char* ks, const bf16x8 (&qr)[4], f32x16& p0, f32x16& p1, int r32, int hi, const f32x16& cinit) {
    bf16x8 ka[4][2];
_Pragma("unroll")
    for (int d0 = 0; d0 < 4; ++d0) { const int off = r32 * 128 + (((2 * d0 + hi) ^ ((r32 >> 1) & 7)) << 4); ka[d0][0] = *(const bf16x8*)(ks + off); ka[d0][1] = *(const bf16x8*)(ks + off + 4096); }
    p0 = cinit; p1 = cinit;
_Pragma("unroll")
    for (int d0 = 0; d0 < 4; ++d0) { p0 = __builtin_amdgcn_mfma_f32_32x32x16_bf16(ka[d0][0], qr[d0], p0, 0, 0, 0); p1 = __builtin_amdgcn_mfma_f32_32x32x16_bf16(ka[d0][1], qr[d0], p1, 0, 0, 0); }
}
__device__ __forceinline__ void pv_tile(const unsigned char* vs, const f32x16& p0, const f32x16& p1, f32x16 (&o)[2], int lane, int hi) {
    bf16x8 pa[4];
_Pragma("unroll")
    for (int k = 0; k < 4; ++k) { const f32x16& P = (k < 2) ? p0 : p1; const int b = (k & 1) * 8;
        u4 w; w.x = cvtpk(P[b + 0], P[b + 1]); w.y = cvtpk(P[b + 2], P[b + 3]); w.z = cvtpk(P[b + 4], P[b + 5]); w.w = cvtpk(P[b + 6], P[b + 7]); pa[k] = __builtin_bit_cast(bf16x8, w); }
    const lds_cptr vb = (lds_cptr)vs + ((lane >> 4) & 1) * 32 + (lane & 3) * 8 + (4 * hi + ((lane & 15) >> 2)) * 64;
_Pragma("unroll")
    for (int d0 = 0; d0 < 2; ++d0) { bf16x8 vf4[4];
_Pragma("unroll")
        for (int k = 0; k < 4; ++k) { const s16x4 lo = vtr(vb + d0 * 4096 + k * 1024), hh = vtr(vb + d0 * 4096 + k * 1024 + 512);
            vf4[k] = (bf16x8){lo[0], lo[1], lo[2], lo[3], hh[0], hh[1], hh[2], hh[3]}; }
_Pragma("unroll")
        for (int k = 0; k < 4; ++k) o[d0] = __builtin_amdgcn_mfma_f32_32x32x16_bf16(pa[k], vf4[k], o[d0], 0, 0, 0); }
}
struct SM { float m, l; bool fresh; f32x16 o[2]; };
__device__ __forceinline__ void sm_init(SM& S) { S.m = 0.f; S.l = 0.f; S.fresh = true; S.o[0] = f32x16{}; S.o[1] = f32x16{}; }
__device__ __forceinline__ float vmax3(float a, float b, float c) { float d; asm("v_max3_f32 %0, %1, %2, %3" : "=v"(d) : "v"(a), "v"(b), "v"(c)); return d; }
__device__ __forceinline__ float max32(const f32x16& p, const f32x16& q) {
    float a = vmax3(p[0], p[1], p[2]), b = vmax3(q[0], q[1], q[2]);
    a = vmax3(a, p[3], p[4]); b = vmax3(b, q[3], q[4]); a = vmax3(a, p[5], p[6]); b = vmax3(b, q[5], q[6]); a = vmax3(a, p[7], p[8]); b = vmax3(b, q[7], q[8]);
    a = vmax3(a, p[9], p[10]); b = vmax3(b, q[9], q[10]); a = vmax3(a, p[11], p[12]); b = vmax3(b, q[11], q[12]); a = vmax3(a, p[13], p[14]); b = vmax3(b, q[13], q[14]);
    return vmax3(a, b, fmaxf(p[15], q[15])); }
struct Bias { bf16x8 A0, A1; unsigned w2, shb; };
__device__ __forceinline__ unsigned pk_hi16(unsigned lo_src, unsigned hi_src) { return __builtin_amdgcn_perm(hi_src, lo_src, 0x07060302u); }
__device__ __forceinline__ void bias_init(Bias& B, float slope2, int r32, int hi) {
    const float s32 = 32.0f * slope2; const unsigned shb = __float_as_uint(s32) & 0xffff0000u; const float r1 = s32 - __uint_as_float(shb); const unsigned smb = __float_as_uint(r1) & 0xffff0000u; const float r2 = r1 - __uint_as_float(smb);
    B.shb = hi ? 0u : shb; B.w2 = hi ? 0u : pk_hi16(smb, __float_as_uint(r2));
    const unsigned kb = __float_as_uint((float)r32) >> 16;
    u4 a0, a1;
    if (hi) { a0 = (u4){kb | (kb << 16), kb, 0u, 0u}; a1 = a0; }
    else { a0 = (u4){0x3F803F80u, 0x00003F80u, 0u, 0u}; a1 = (u4){0x3F803F80u, 0x3F803F80u, 0x3F803F80u, 0u}; }
    B.A0 = __builtin_bit_cast(bf16x8, a0); B.A1 = __builtin_bit_cast(bf16x8, a1);
}
__device__ __forceinline__ void qk_rel(const unsigned char* ks, const bf16x8 (&qr)[4], f32x16& p0, f32x16& p1, int r32, int hi, const Bias& B, float c, bool rowok, float slope2) {
    const float cv = hi ? slope2 : c;
    const unsigned hb = __float_as_uint(cv) & 0xffff0000u; const float r1 = cv - __uint_as_float(hb); const unsigned mb = __float_as_uint(r1) & 0xffff0000u; const float r2 = r1 - __uint_as_float(mb);
    u4 w; w.x = pk_hi16(hb, mb); w.y = pk_hi16(__float_as_uint(r2), B.shb); w.z = B.w2; w.w = 0u;
    if (!rowok && !hi) w.x = 0x0000FF80u;
    const bf16x8 bq = __builtin_bit_cast(bf16x8, w);
    bf16x8 ka[4][2];
_Pragma("unroll")
    for (int d0 = 0; d0 < 4; ++d0) { const int off = r32 * 128 + (((2 * d0 + hi) ^ ((r32 >> 1) & 7)) << 4); ka[d0][0] = *(const bf16x8*)(ks + off); ka[d0][1] = *(const bf16x8*)(ks + off + 4096); }
    p0 = __builtin_amdgcn_mfma_f32_32x32x16_bf16(B.A0, bq, f32x16{}, 0, 0, 0); p1 = __builtin_amdgcn_mfma_f32_32x32x16_bf16(B.A1, bq, f32x16{}, 0, 0, 0);
_Pragma("unroll")
    for (int d0 = 0; d0 < 4; ++d0) { p0 = __builtin_amdgcn_mfma_f32_32x32x16_bf16(ka[d0][0], qr[d0], p0, 0, 0, 0); p1 = __builtin_amdgcn_mfma_f32_32x32x16_bf16(ka[d0][1], qr[d0], p1, 0, 0, 0); }
}
template <bool HASN>
__device__ __forceinline__ void sm_post(SM& S, f32x16& p0, f32x16& p1, const unsigned char* kslot, bool needmask, int relc, int relw, float* wsf, int lane, int r32, int hi, f32x16& n0, f32x16& n1) {
    if (needmask) {
_Pragma("unroll")
        for (int r = 0; r < 16; ++r) { const int c0 = (r & 3) + 8 * (r >> 2);
            p0[r] = ((c0 <= relc) && (c0 > relw)) ? p0[r] : -INFINITY; p1[r] = ((c0 + 32 <= relc) && (c0 + 32 > relw)) ? p1[r] : -INFINITY; } }
    const float tmax = swapmax(max32(p0, p1));
    const bool seen = tmax > -INFINITY; const bool trig = (tmax > 6.0f) || (S.fresh && seen && tmax < -6.0f);
    if (__any(trig)) {
        const float d = trig ? tmax : 0.f; const float alpha = S.fresh ? 1.0f : __builtin_amdgcn_exp2f(-d); S.m += d; S.l *= alpha;
        if (hi == 0) wsf[r32] = alpha;
        __builtin_amdgcn_wave_barrier(); asm volatile("s_waitcnt lgkmcnt(0)" ::: "memory");
_Pragma("unroll")
        for (int r = 0; r < 16; ++r) { const float a = wsf[crow(r, hi)]; S.o[0][r] *= a; S.o[1][r] *= a; }
        __builtin_amdgcn_wave_barrier(); asm volatile("" ::: "memory");
_Pragma("unroll")
        for (int r = 0; r < 16; ++r) { p0[r] -= d; p1[r] -= d; }
        if constexpr (HASN) {
_Pragma("unroll")
            for (int r = 0; r < 16; ++r) { n0[r] -= d; n1[r] -= d; } }
    }
    S.fresh = S.fresh && !seen;
    float ls = S.l;
_Pragma("unroll")
    for (int r = 0; r < 16; ++r) { p0[r] = __builtin_amdgcn_exp2f(p0[r]); ls += p0[r]; p1[r] = __builtin_amdgcn_exp2f(p1[r]); ls += p1[r]; }
    S.l = ls;
    pv_tile(kslot + 8192, p0, p1, S.o, lane, hi);
}
__device__ __forceinline__ void sm_tile(SM& S, const unsigned char* kslot, const bf16x8 (&qr)[4], const Bias& alibi, float rc0, float slope2, bool rowok, bool needmask, int relc, int relw, float* wsf, int lane, int r32, int hi) {
    f32x16 p0, p1; qk_rel(kslot, qr, p0, p1, r32, hi, alibi, rc0 - S.m, rowok, slope2);
    sm_post<false>(S, p0, p1, kslot, needmask, relc, relw, wsf, lane, r32, hi, p0, p1);
}
__device__ __forceinline__ void sm_tile2(SM& S, const unsigned char* slA, const unsigned char* slB, const bf16x8 (&qr)[4], const Bias& alibi, float rcA0, float rcB0, float slope2, bool okA, bool okB,
                                         bool maskA, int relcA, int relwA, bool maskB, int relcB, int relwB, float* wsf, int lane, int r32, int hi) {
    f32x16 a0, a1, b0, b1; qk_rel(slA, qr, a0, a1, r32, hi, alibi, rcA0 - S.m, okA, slope2); qk_rel(slB, qr, b0, b1, r32, hi, alibi, rcB0 - S.m, okB, slope2);
    sm_post<true>(S, a0, a1, slA, maskA, relcA, relwA, wsf, lane, r32, hi, b0, b1);
    sm_post<false>(S, b0, b1, slB, maskB, relcB, relwB, wsf, lane, r32, hi, b0, b1);
}
__device__ __forceinline__ void acc_lds(float* accw, const f32x16 (&o)[2], float fac, float* wsf, int r32, int hi, bool first) {
    __builtin_amdgcn_wave_barrier(); asm volatile("" ::: "memory");
    if (hi == 0) wsf[r32] = fac;
    __builtin_amdgcn_wave_barrier(); asm volatile("s_waitcnt lgkmcnt(0)" ::: "memory");
_Pragma("unroll")
    for (int r = 0; r < 16; ++r) { const float a = wsf[crow(r, hi)]; float* p = accw + crow(r, hi) * 64 + r32;
        if (first) { p[0] = a * o[0][r]; p[32] = a * o[1][r]; } else { p[0] += a * o[0][r]; p[32] += a * o[1][r]; } }
    __builtin_amdgcn_wave_barrier(); asm volatile("s_waitcnt lgkmcnt(0)" ::: "memory");
}
__device__ __forceinline__ void acc_reg(f32x16 (&tot)[2], const f32x16 (&o)[2], float fac, float* wsf, int r32, int hi, bool first) {
    __builtin_amdgcn_wave_barrier(); asm volatile("" ::: "memory");
    if (hi == 0) wsf[r32] = fac;
    __builtin_amdgcn_wave_barrier(); asm volatile("s_waitcnt lgkmcnt(0)" ::: "memory");
_Pragma("unroll")
    for (int r = 0; r < 16; ++r) { const float a = wsf[crow(r, hi)];
        if (first) { tot[0][r] = a * o[0][r]; tot[1][r] = a * o[1][r]; } else { tot[0][r] += a * o[0][r]; tot[1][r] += a * o[1][r]; } }
    __builtin_amdgcn_wave_barrier(); asm volatile("" ::: "memory");
}
__device__ __forceinline__ void stage_rows(float* accw, const f32x16 (&tot)[2], int r32, int hi) {
_Pragma("unroll")
    for (int r = 0; r < 16; ++r) { float* p = accw + crow(r, hi) * 64 + r32; p[0] = tot[0][r]; p[32] = tot[1][r]; }
    __builtin_amdgcn_wave_barrier(); asm volatile("s_waitcnt lgkmcnt(0)" ::: "memory");
}
__device__ __forceinline__ void out_rows(const float* accw, const bf16* zbase  , bf16* mbase  , int lane) {
    const int row = lane >> 1, half = lane & 1; const float* a = accw + row * 64 + half * 32;
    const bf16* zp = zbase + (size_t)(row >> 2) * NP + (row & 3) * 64 + half * 32; bf16* mp = mbase + (size_t)(row >> 2) * D + (row & 3) * 64 + half * 32;
    u4 zq[4];
_Pragma("unroll")
    for (int i = 0; i < 4; ++i) zq[i] = *(const u4*)(zp + i * 8);
    asm volatile("" ::: "memory");
_Pragma("unroll")
    for (int i = 0; i < 4; ++i) { const u4 zw = zq[i]; const f4 a0 = *(const f4*)(a + i * 8), a1 = *(const f4*)(a + i * 8 + 4); u4 ow;
        float y[8];
_Pragma("unroll")
        for (int e = 0; e < 4; ++e) { const float z0 = __uint_as_float(zw[e] << 16), z1 = __uint_as_float(zw[e] & 0xffff0000u); y[2 * e] = siluf_(z0); y[2 * e + 1] = siluf_(z1); }
        ow.x = pk2(a0[0] * y[0], a0[1] * y[1]); ow.y = pk2(a0[2] * y[2], a0[3] * y[3]); ow.z = pk2(a1[0] * y[4], a1[1] * y[5]); ow.w = pk2(a1[2] * y[6], a1[3] * y[7]);
        *(u4*)(mp + i * 8) = ow; }
}
__device__ __forceinline__ void load_q(bf16x8 (&qr)[4], const bf16* PROJ, size_t tok, int qcol, int hi) {
_Pragma("unroll")
    for (int d0 = 0; d0 < 4; ++d0) { const u4 w = *(const u4*)(PROJ + tok * NP + qcol + d0 * 16 + hi * 8); u4 o;
_Pragma("unroll")
        for (int e = 0; e < 4; ++e) o[e] = cvtpk(__uint_as_float(w[e] << 16) * C2, __uint_as_float(w[e] & 0xffff0000u) * C2);
        qr[d0] = __builtin_bit_cast(bf16x8, o); }
}
__device__ __forceinline__ void glds16(const void* gsrc, unsigned lds_dst) { unsigned keep;
    asm volatile("s_mov_b32 %0, m0\n\ts_mov_b32 m0, %2\n\ts_nop 0\n\tglobal_load_lds_dwordx4 %1, off\n\ts_mov_b32 m0, %0" : "=&s"(keep) : "v"(gsrc), "s"(lds_dst) : "memory"); }
__device__ __forceinline__ void kv_dma(const bf16* base, size_t pitch, long row0, long rlo, long rhi, int kcol, int vcol, unsigned slot  , int wave, int lane) {
    { const int key = 8 * wave + (lane >> 3), ch = (lane & 7) ^ ((key >> 1) & 7); long row = row0 + key; row = row < rlo ? rlo : (row > rhi ? rhi : row);
      glds16(base + (size_t)row * pitch + kcol + ch * 8, (unsigned)__builtin_amdgcn_readfirstlane(slot + wave * 1024)); }
    { const int key = 16 * (wave & 3) + (lane >> 2), ch = (wave >> 2) * 4 + (lane & 3); long row = row0 + key; row = row < rlo ? rlo : (row > rhi ? rhi : row);
      glds16(base + (size_t)row * pitch + vcol + ch * 8, (unsigned)__builtin_amdgcn_readfirstlane(slot + 8192 + wave * 1024)); }
}
#define AT2_KV_PTRS(BASE, PITCH, ROWOF, KCOL, VCOL) const char* kp_; const char* vp_; \
    { const int keyk_ = 8 * wave + (lane >> 3), chk_ = (lane & 7) ^ ((keyk_ >> 1) & 7); kp_ = (const char*)((BASE) + (size_t)(ROWOF(jB_) + keyk_) * (PITCH) + (KCOL) + chk_ * 8); \
      const int keyv_ = 16 * (wave & 3) + (lane >> 2), chv_ = (wave >> 2) * 4 + (lane & 3); vp_ = (const char*)((BASE) + (size_t)(ROWOF(jB_) + keyv_) * (PITCH) + (VCOL) + chv_ * 8); } \
    const long tstride_ = (long)64 * (PITCH) * 2
#define AT2_KVF(ja, dst) do { const long off_ = (long)(jB_ - (ja)) * tstride_; const unsigned d_ = (dst) + wave * 1024; \
    glds16(kp_ - off_, (unsigned)__builtin_amdgcn_readfirstlane(d_)); glds16(vp_ - off_, (unsigned)__builtin_amdgcn_readfirstlane(d_ + 8192)); } while (0)
#define AT2_TILE_LOOP(J0, J1, BASE, PITCH, ROWOF, RLO, RHI, KCOL, VCOL, ...) do { \
    const int jA_ = (J0), jB_ = (J1); int par_ = 0; const unsigned lds0_ = (unsigned)(uintptr_t)lds; AT2_KV_PTRS(BASE, PITCH, ROWOF, KCOL, VCOL); \
    asm volatile("s_waitcnt vmcnt(0) lgkmcnt(0)" ::: "memory"); __builtin_amdgcn_s_barrier(); \
    AT2_KVF(jB_, lds0_ + L_KV); \
    if (jB_ - 1 >= jA_) AT2_KVF(jB_ - 1, lds0_ + L_KV + 16384); \
    for (int j = jB_; j >= jA_; j -= 2) { \
        asm volatile("s_waitcnt vmcnt(0) lgkmcnt(0)" ::: "memory"); __builtin_amdgcn_s_barrier(); asm volatile("" ::: "memory"); \
        if (j - 2 >= jA_) AT2_KVF(j - 2, lds0_ + L_KV + (par_ ^ 1) * 32768); \
        if (j - 3 >= jA_) AT2_KVF(j - 3, lds0_ + L_KV + (par_ ^ 1) * 32768 + 16384); \
        { const bool has2 = (j - 1 >= jA_); const unsigned char* slotA = lds + L_KV + par_ * 32768; const unsigned char* slotB = slotA + 16384; (void)has2; (void)slotB; __VA_ARGS__ } \
        par_ ^= 1; } \
    asm volatile("s_waitcnt lgkmcnt(0)" ::: "memory"); __builtin_amdgcn_s_barrier(); asm volatile("" ::: "memory"); } while (0)

#define AT2_TILE_ALL3(J0, J1, BASE, PITCH, ROWOF, KCOL, VCOL, ...) do { \
    const int jA_ = (J0), jB_ = (J1); const unsigned lds0_ = (unsigned)(uintptr_t)lds; AT2_KV_PTRS(BASE, PITCH, ROWOF, KCOL, VCOL); \
    asm volatile("s_waitcnt vmcnt(0) lgkmcnt(0)" ::: "memory"); __builtin_amdgcn_s_barrier(); \
    _Pragma("unroll") for (int q_ = 0; q_ < 3; ++q_) { if (jB_ - q_ >= jA_) AT2_KVF(jB_ - q_, lds0_ + L_KV + q_ * 16384); } \
    asm volatile("s_waitcnt vmcnt(0) lgkmcnt(0)" ::: "memory"); __builtin_amdgcn_s_barrier(); asm volatile("" ::: "memory"); \
    _Pragma("nounroll") for (int j = jB_, it_ = 0; j >= jA_; j -= 2, ++it_) { \
        const bool has2 = (j - 1 >= jA_); const unsigned char* slotA = lds + L_KV + it_ * 32768; const unsigned char* slotB = slotA + 16384; (void)has2; (void)slotB; __VA_ARGS__ } \
    asm volatile("s_waitcnt lgkmcnt(0)" ::: "memory"); __builtin_amdgcn_s_barrier(); asm volatile("" ::: "memory"); } while (0)

#define AT2_TILE_LOOP4(J0, J1, BASE, PITCH, ROWOF, RLO, RHI, KCOL, VCOL, ...) do { \
    const int jA_ = (J0), jB_ = (J1); int ps_ = 0; const unsigned lds0_ = (unsigned)(uintptr_t)lds; AT2_KV_PTRS(BASE, PITCH, ROWOF, KCOL, VCOL); \
    asm volatile("s_waitcnt vmcnt(0) lgkmcnt(0)" ::: "memory"); __builtin_amdgcn_s_barrier(); \
    _Pragma("unroll") for (int q_ = 0; q_ < 3; ++q_) { const int ja_ = jB_ - 2 * q_, jb_ = ja_ - 1; \
        AT2_KVF((ja_ < jA_) ? jA_ : ja_, lds0_ + L_KV + q_ * 32768); \
        AT2_KVF((jb_ < jA_) ? jA_ : jb_, lds0_ + L_KV + q_ * 32768 + 16384); } \
    for (int j = jB_; j >= jA_; j -= 2) { \
        asm volatile("s_waitcnt vmcnt(8) lgkmcnt(0)" ::: "memory"); __builtin_amdgcn_s_barrier(); asm volatile("" ::: "memory"); \
        { const int ja_ = j - 6, jb_ = j - 7; const unsigned dst_ = lds0_ + L_KV + ((ps_ + 3) & 3) * 32768; \
          AT2_KVF((ja_ < jA_) ? jA_ : ja_, dst_); \
          AT2_KVF((jb_ < jA_) ? jA_ : jb_, dst_ + 16384); } \
        { const bool has2 = (j - 1 >= jA_); const unsigned char* slotA = lds + L_KV + ps_ * 32768; const unsigned char* slotB = slotA + 16384; (void)has2; (void)slotB; __VA_ARGS__ } \
        ps_ = (ps_ + 1) & 3; } \
    asm volatile("s_waitcnt vmcnt(0) lgkmcnt(0)" ::: "memory"); __builtin_amdgcn_s_barrier(); asm volatile("" ::: "memory"); } while (0)

#define AT2_TILE_LOOP8(J0, J1, BASE, PITCH, ROWOF, RLO, RHI, KCOL, VCOL, ...) do { \
    const int jA_ = (J0), jB_ = (J1); int ps_ = 0; const unsigned lds0_ = (unsigned)(uintptr_t)lds; \
    asm volatile("s_waitcnt vmcnt(0) lgkmcnt(0)" ::: "memory"); __builtin_amdgcn_s_barrier(); \
    _Pragma("unroll") for (int q_ = 0; q_ < 4; ++q_) { const int ja_ = jB_ - q_; if (ja_ >= jA_) kv_dma(BASE, PITCH, ROWOF(ja_), RLO, RHI, KCOL, VCOL, lds0_ + L_KV + q_ * 16384, wave, lane); } \
    for (int j = jB_; j >= jA_; j -= 4) { \
        asm volatile("s_waitcnt vmcnt(0) lgkmcnt(0)" ::: "memory"); __builtin_amdgcn_s_barrier(); asm volatile("" ::: "memory"); \
        _Pragma("unroll") for (int q_ = 0; q_ < 4; ++q_) { const int ja_ = j - 4 - q_; if (ja_ >= jA_) kv_dma(BASE, PITCH, ROWOF(ja_), RLO, RHI, KCOL, VCOL, lds0_ + L_KV + (ps_ ^ 1) * 65536 + q_ * 16384, wave, lane); } \
        _Pragma("nounroll") for (int jq = 0; jq < 4; ++jq) { const int jt = j - jq; const unsigned char* slot = lds + L_KV + ps_ * 65536 + jq * 16384; if (jt >= jA_) { __VA_ARGS__ } } \
        ps_ ^= 1; } \
    asm volatile("s_waitcnt vmcnt(0) lgkmcnt(0)" ::: "memory"); __builtin_amdgcn_s_barrier(); asm volatile("" ::: "memory"); } while (0)

#define AT2_TILE_LOOP8T(J0, J1, BASE, PITCH, ROWOF, RLO, RHI, KCOL, VCOL, ...) do { \
    const int jA_ = (J0), jB_ = (J1); int ps_ = 0; const unsigned lds0_ = (unsigned)(uintptr_t)lds; unsigned tacc_ = 0u, tprev_ = 0u; \
    asm volatile("s_waitcnt vmcnt(0) lgkmcnt(0)" ::: "memory"); __builtin_amdgcn_s_barrier(); \
    _Pragma("unroll") for (int q_ = 0; q_ < 4; ++q_) { const int ja_ = jB_ - q_; if (ja_ >= jA_) kv_dma(BASE, PITCH, ROWOF(ja_), RLO, RHI, KCOL, VCOL, lds0_ + L_KV + q_ * 16384, wave, lane); } \
    { const int jw_ = jB_ - 4 - (tid >> 7); if (jw_ >= jA_) tprev_ = *(const unsigned*)((BASE) + (size_t)(ROWOF(jw_) + ((tid & 127) >> 1)) * (PITCH) + ((tid & 1) ? (VCOL) : (KCOL))); } \
    for (int j = jB_; j >= jA_; j -= 4) { \
        asm volatile("s_waitcnt vmcnt(0) lgkmcnt(0)" ::: "memory"); __builtin_amdgcn_s_barrier(); asm volatile("" ::: "memory"); \
        tacc_ ^= tprev_; tprev_ = 0u; \
        _Pragma("unroll") for (int q_ = 0; q_ < 4; ++q_) { const int ja_ = j - 4 - q_; if (ja_ >= jA_) kv_dma(BASE, PITCH, ROWOF(ja_), RLO, RHI, KCOL, VCOL, lds0_ + L_KV + (ps_ ^ 1) * 65536 + q_ * 16384, wave, lane); } \
        { const int jw_ = j - 8 - (tid >> 7); if (jw_ >= jA_) tprev_ = *(const unsigned*)((BASE) + (size_t)(ROWOF(jw_) + ((tid & 127) >> 1)) * (PITCH) + ((tid & 1) ? (VCOL) : (KCOL))); } \
        _Pragma("nounroll") for (int jq = 0; jq < 4; ++jq) { const int jt = j - jq; const unsigned char* slot = lds + L_KV + ps_ * 65536 + jq * 16384; if (jt >= jA_) { __VA_ARGS__ } } \
        ps_ ^= 1; } \
    asm volatile("s_waitcnt vmcnt(0) lgkmcnt(0)" ::: "memory"); __builtin_amdgcn_s_barrier(); asm volatile("" :: "v"(tacc_ ^ tprev_) : "memory"); } while (0)

#define AT2_TILE_LOOP8F(J0, J1, BASE, PITCH, ROWOF, KCOL, VCOL, ...) do { \
    const int jA_ = (J0), jB_ = (J1); int ps_ = 0; const unsigned lds0_ = (unsigned)(uintptr_t)lds; \
    const char* kp_; const char* vp_; \
    { const int keyk_ = 8 * wave + (lane >> 3), chk_ = (lane & 7) ^ ((keyk_ >> 1) & 7); kp_ = (const char*)((BASE) + (size_t)(ROWOF(jB_) + keyk_) * (PITCH) + (KCOL) + chk_ * 8); \
      const int keyv_ = 16 * (wave & 3) + (lane >> 2), chv_ = (wave >> 2) * 4 + (lane & 3); vp_ = (const char*)((BASE) + (size_t)(ROWOF(jB_) + keyv_) * (PITCH) + (VCOL) + chv_ * 8); } \
    const long tstride_ = (long)64 * (PITCH) * 2; \
    asm volatile("s_waitcnt vmcnt(0) lgkmcnt(0)" ::: "memory"); __builtin_amdgcn_s_barrier(); \
    _Pragma("unroll") for (int q_ = 0; q_ < 4; ++q_) { const int ja_ = jB_ - q_; if (ja_ >= jA_) { const long off_ = (long)(jB_ - ja_) * tstride_; \
        glds16(kp_ - off_, (unsigned)__builtin_amdgcn_readfirstlane(lds0_ + L_KV + q_ * 16384 + wave * 1024)); glds16(vp_ - off_, (unsigned)__builtin_amdgcn_readfirstlane(lds0_ + L_KV + q_ * 16384 + 8192 + wave * 1024)); } } \
    for (int j = jB_; j >= jA_; j -= 4) { \
        asm volatile("s_waitcnt vmcnt(0) lgkmcnt(0)" ::: "memory"); __builtin_amdgcn_s_barrier(); asm volatile("" ::: "memory"); \
        _Pragma("unroll") for (int q_ = 0; q_ < 4; ++q_) { const int ja_ = j - 4 - q_; if (ja_ >= jA_) { const long off_ = (long)(jB_ - ja_) * tstride_; const unsigned dst_ = lds0_ + L_KV + (ps_ ^ 1) * 65536 + q_ * 16384 + wave * 1024; \
            glds16(kp_ - off_, (unsigned)__builtin_amdgcn_readfirstlane(dst_)); glds16(vp_ - off_, (unsigned)__builtin_amdgcn_readfirstlane(dst_ + 8192)); } } \
        _Pragma("nounroll") for (int jq = 0; jq < 4; ++jq) { const int jt = j - jq; const unsigned char* slot = lds + L_KV + ps_ * 65536 + jq * 16384; if (jt >= jA_) { __VA_ARGS__ } } \
        ps_ ^= 1; } \
    asm volatile("s_waitcnt vmcnt(0) lgkmcnt(0)" ::: "memory"); __builtin_amdgcn_s_barrier(); asm volatile("" ::: "memory"); } while (0)

typedef float f32x4v __attribute__((ext_vector_type(4)));
struct SM16 { float m, l; bool fresh; f32x4v o[4]; };
__device__ __forceinline__ void sm16_init(SM16& S) { S.m = 0.f; S.l = 0.f; S.fresh = true;
_Pragma("unroll")
    for (int d = 0; d < 4; ++d) S.o[d] = (f32x4v){0.f, 0.f, 0.f, 0.f}; }
__device__ __forceinline__ float swz16max(float v) { return fmaxf(v, __int_as_float(__builtin_amdgcn_ds_swizzle(__float_as_int(v), 0x401F))); }
__device__ __forceinline__ float swz16sum(float v) { return v + __int_as_float(__builtin_amdgcn_ds_swizzle(__float_as_int(v), 0x401F)); }
struct Bias16 { bf16x8 A[4]; unsigned shb, w2; };
__device__ __forceinline__ void bias16_init(Bias16& B, float slope2, int fr, int fq) {
    const float s16 = 16.0f * slope2; const unsigned shb = __float_as_uint(s16) & 0xffff0000u; const float r1 = s16 - __uint_as_float(shb); const unsigned smb = __float_as_uint(r1) & 0xffff0000u; const float r2 = r1 - __uint_as_float(smb);
    B.shb = (fq == 0) ? shb : 0u; B.w2 = (fq == 0) ? pk_hi16(smb, __float_as_uint(r2)) : 0u;
    const unsigned kb = __float_as_uint((float)fr) >> 16;
_Pragma("unroll")
    for (int b = 0; b < 4; ++b) { const unsigned bb = __float_as_uint((float)b) >> 16; u4 a = (u4){0u, 0u, 0u, 0u};
        if (fq == 0) a = (u4){0x3F803F80u, 0x00003F80u | (bb << 16), bb | (bb << 16), 0u};
        if (fq == 1) a = (u4){kb | (kb << 16), kb, 0u, 0u};
        B.A[b] = __builtin_bit_cast(bf16x8, a); }
}
__device__ __forceinline__ void sub_tile16(SM16& S, const unsigned char* slot, const bf16x8 (&q)[2], const Bias16& B, float slope2, float c, bool rowok, bool needmask, int relc, float* wsf16, int lane, int fr, int fq) {
    bf16x8 ka[4][2];
_Pragma("unroll")
    for (int b = 0; b < 4; ++b) { const int key = 16 * b + fr;
_Pragma("unroll")
        for (int ks = 0; ks < 2; ++ks) ka[b][ks] = *(const bf16x8*)(slot + key * 128 + (((4 * ks + fq) ^ ((key >> 1) & 7)) << 4)); }
    const float cv = (fq == 0) ? c : (fq == 1) ? slope2 : 0.f;
    const unsigned hb = __float_as_uint(cv) & 0xffff0000u; const float r1 = cv - __uint_as_float(hb); const unsigned mb = __float_as_uint(r1) & 0xffff0000u; const float r2 = r1 - __uint_as_float(mb);
    u4 w; w.x = pk_hi16(hb, mb); w.y = pk_hi16(__float_as_uint(r2), B.shb); w.z = B.w2; w.w = 0u;
    if (!rowok && fq == 0) w.x = 0x0000FF80u;
    const bf16x8 bq = __builtin_bit_cast(bf16x8, w);
    __builtin_amdgcn_sched_barrier(0);
    f32x4v p[4];
_Pragma("unroll")
    for (int b = 0; b < 4; ++b) { p[b] = __builtin_amdgcn_mfma_f32_16x16x32_bf16(B.A[b], bq, (f32x4v){0.f, 0.f, 0.f, 0.f}, 0, 0, 0);
        p[b] = __builtin_amdgcn_mfma_f32_16x16x32_bf16(ka[b][0], q[0], p[b], 0, 0, 0); p[b] = __builtin_amdgcn_mfma_f32_16x16x32_bf16(ka[b][1], q[1], p[b], 0, 0, 0); }
    if (needmask) {
_Pragma("unroll")
        for (int b = 0; b < 4; ++b)
_Pragma("unroll")
            for (int i = 0; i < 4; ++i) p[b][i] = (16 * b + 4 * fq + i <= relc) ? p[b][i] : -INFINITY; }
    float pm = vmax3(p[0][0], p[0][1], p[0][2]); pm = vmax3(pm, p[0][3], p[1][0]); pm = vmax3(pm, p[1][1], p[1][2]); pm = vmax3(pm, p[1][3], p[2][0]);
    pm = vmax3(pm, p[2][1], p[2][2]); pm = vmax3(pm, p[2][3], p[3][0]); pm = vmax3(pm, p[3][1], p[3][2]); pm = fmaxf(pm, p[3][3]);
    if (__any(pm > 6.0f) || __any(S.fresh)) {
        const float tmax = swapmax(swz16max(pm));
        const bool seen = tmax > -INFINITY; const bool trig = (tmax > 6.0f) || (S.fresh && seen && tmax < -6.0f);
        if (__any(trig)) {
            const float d = trig ? tmax : 0.f; const float alpha = S.fresh ? 1.0f : __builtin_amdgcn_exp2f(-d); S.m += d; S.l *= alpha;
            __builtin_amdgcn_wave_barrier(); asm volatile("" ::: "memory");
            if (fq == 0) wsf16[fr] = alpha;
            __builtin_amdgcn_wave_barrier(); asm volatile("s_waitcnt lgkmcnt(0)" ::: "memory");
_Pragma("unroll")
            for (int i = 0; i < 4; ++i) { const float a = wsf16[4 * fq + i];
_Pragma("unroll")
                for (int dd = 0; dd < 4; ++dd) S.o[dd][i] *= a; }
            __builtin_amdgcn_wave_barrier(); asm volatile("" ::: "memory");
_Pragma("unroll")
            for (int b = 0; b < 4; ++b)
_Pragma("unroll")
                for (int i = 0; i < 4; ++i) p[b][i] -= d;
        }
        S.fresh = S.fresh && !seen;
    }
    bf16x8 vf[2][4];
    { const lds_cptr vb = (lds_cptr)slot + 8192 + (4 * fq + ((lane & 15) >> 2)) * 64 + (lane & 3) * 8;
_Pragma("unroll")
      for (int ks = 0; ks < 2; ++ks)
_Pragma("unroll")
          for (int dd = 0; dd < 4; ++dd) { const lds_cptr a = vb + (dd >> 1) * 4096 + (2 * ks) * 1024 + (dd & 1) * 32; const s16x4 lo = vtr(a), hh = vtr(a + 1024);
              vf[ks][dd] = (bf16x8){lo[0], lo[1], lo[2], lo[3], hh[0], hh[1], hh[2], hh[3]}; } }
    __builtin_amdgcn_sched_barrier(0);
    float ls = S.l;
_Pragma("unroll")
    for (int b = 0; b < 4; ++b)
_Pragma("unroll")
        for (int i = 0; i < 4; ++i) { p[b][i] = __builtin_amdgcn_exp2f(p[b][i]); ls += p[b][i]; }
    S.l = ls;
_Pragma("unroll")
    for (int ks = 0; ks < 2; ++ks) { u4 pw; pw.x = cvtpk(p[2 * ks][0], p[2 * ks][1]); pw.y = cvtpk(p[2 * ks][2], p[2 * ks][3]); pw.z = cvtpk(p[2 * ks + 1][0], p[2 * ks + 1][1]); pw.w = cvtpk(p[2 * ks + 1][2], p[2 * ks + 1][3]);
        const bf16x8 pa = __builtin_bit_cast(bf16x8, pw);
_Pragma("unroll")
        for (int dd = 0; dd < 4; ++dd) S.o[dd] = __builtin_amdgcn_mfma_f32_16x16x32_bf16(pa, vf[ks][dd], S.o[dd], 0, 0, 0); }
}

#ifdef PROBE_ID
#define UA_STAMP(k) ts[k] = __builtin_amdgcn_s_memrealtime()
#else
#define UA_STAMP(k) do {} while (0)
#endif
__device__ __forceinline__ void unit_a(const Params& P, int layer, int b, int g, int c, unsigned char* lds, unsigned long long* ts) {
    int tid_ = tidx_(P.wv); const int tid = tid_, lane = tid & 63, wave = __builtin_amdgcn_readfirstlane(tid >> 6), r32 = lane & 31, hi = lane >> 5;
    const bf16* PROJ = (const bf16*)(P.ws + WS_PROJ); const float* SMALL = (const float*)(P.ws + WS_SMALL); bf16* MIX = (bf16*)(P.ws + WS_MIX);
    UA_STAMP(6);
    float* imp = (float*)(lds + L_IMP); unsigned* selm = (unsigned*)(lds + L_SEL); float* wsf = (float*)(lds + L_WSF) + wave * 32; float* gt = (float*)(lds + L_GT) + wave * 96;
    const long rowbase = (long)b * T; const int tl = wave * 8 + (r32 >> 2), t = c * 64 + tl, hd = g * 4 + (r32 & 3); const size_t tok = (size_t)(rowbase + t);
    const float slope2 = __uint_as_float((unsigned)(126 - hd) << 23) * LOG2E;
    bf16x8 qr[4]; load_q(qr, PROJ, tok, C_AQ + hd * 64, hi);
    const f32x16 zero16 = f32x16{}; Bias alibi; bias_init(alibi, slope2, r32, hi);
    if (hi == 0) { const float* sm = SMALL + tok * 32 + S_GATE + hd * 3; gt[r32 * 3 + 0] = sigmoidf_(sm[0]); gt[r32 * 3 + 1] = sigmoidf_(sm[1]); gt[r32 * 3 + 2] = sigmoidf_(sm[2]); }
    float* accw = (float*)(lds + L_KV) + wave * 2048; f32x16 tot[2];
#define ROW_SEQ(j) (rowbase + (long)(j) * 64)
    { SM S; sm_init(S); const int j0 = (c >= 8) ? c - 8 : 0;
      AT2_TILE_LOOP4(j0, c, PROJ, NP, ROW_SEQ, rowbase, rowbase + T - 1, C_AKW + g * 64, C_AVW + g * 64, {
        const int jb = j - 1; const float rcA = slope2 * (float)(j * 64 - t), rcB = rcA - 64.0f * slope2; const int relA = t - j * 64 - 4 * hi, relB = relA + 64;
        const bool mA = (j == c) || (j == c - 8), mB = (jb == c) || (jb == c - 8);
        const int rcA_ = (j == c) ? relA : (1 << 20), rwA_ = (j == c - 8) ? relA - 512 : -(1 << 20), rcB_ = (jb == c) ? relB : (1 << 20), rwB_ = (jb == c - 8) ? relB - 512 : -(1 << 20);
        if (has2) sm_tile2(S, slotA, slotB, qr, alibi, rcA, rcB, slope2, true, true, mA, rcA_, rwA_, mB, rcB_, rwB_, wsf, lane, r32, hi);
        else sm_tile(S, slotA, qr, alibi, rcA, slope2, true, mA, rcA_, rwA_, wsf, lane, r32, hi); });
      const float lt = swapsum(S.l); acc_reg(tot, S.o, gt[r32 * 3 + 2] / lt, wsf, r32, hi, true); }
    for (int i = tid; i < 64 * IMPP; i += 512) imp[i] = 0.f;
    const int imax = (t >= 31) ? ((t - 31) >> 4) : -1;
    const int nT = ((4 * c + 2) >> 6);
    const bf16* KC = (const bf16*)(P.ws + WS_KCMP) + (size_t)(b * 2 + g) * CMP_PITCH * 128;
#define ROW_CMP(j) ((long)(j) * 64)
    UA_STAMP(0);
    float cm = -1.0e30f, cl = 0.f;
#define CMP1_TILE(jt, slot) do { \
        f32x16 p0, p1; qk_tile(slot, qr, p0, p1, r32, hi, zero16); const int rel = imax - (jt) * 64 - 4 * hi; float tm = -INFINITY; \
        _Pragma("unroll") for (int r = 0; r < 16; ++r) { const int c0 = (r & 3) + 8 * (r >> 2); const float x0 = (c0 <= rel) ? p0[r] : -INFINITY, x1 = (c0 + 32 <= rel) ? p1[r] : -INFINITY; p0[r] = x0; p1[r] = x1; tm = fmaxf(tm, fmaxf(x0, x1)); } \
        const float mn = fmaxf(cm, tm); cl *= __builtin_amdgcn_exp2f(cm - mn); cm = mn; float ls = 0.f; \
        _Pragma("unroll") for (int r = 0; r < 16; ++r) ls += __builtin_amdgcn_exp2f(p0[r] - cm) + __builtin_amdgcn_exp2f(p1[r] - cm); \
        cl += ls; } while (0)
    AT2_TILE_LOOP(0, nT, KC, 128, ROW_CMP, 0, 511, 0, 64, { CMP1_TILE(j, slotA); if (has2) CMP1_TILE(j - 1, slotB); });
    {
        const float mo = swapmax(cm); cl *= __builtin_amdgcn_exp2f(cm - mo); cm = mo; cl = swapsum(cl); }
    const float crl = (cl > 0.f) ? 1.0f / cl : 0.f;
    UA_STAMP(1);
    SM Sc; sm_init(Sc);
#define CMP2_TILE(jt, slot) do { \
        f32x16 p0, p1; qk_tile(slot, qr, p0, p1, r32, hi, zero16); const int rel = imax - (jt) * 64 - 4 * hi; \
        _Pragma("unroll") for (int r = 0; r < 16; ++r) { const int c0 = (r & 3) + 8 * (r >> 2); \
            p0[r] = (c0 <= rel) ? __builtin_amdgcn_exp2f(p0[r] - cm) * crl : 0.f; p1[r] = (c0 + 32 <= rel) ? __builtin_amdgcn_exp2f(p1[r] - cm) * crl : 0.f; } \
          \
          \
        { float q0_[4], q1_[4], t0_[4], t1_[4]; \
          _Pragma("unroll") for (int rq = 0; rq < 4; ++rq) { \
              q0_[rq] = quadsum((p0[4 * rq] + p0[4 * rq + 1]) + (p0[4 * rq + 2] + p0[4 * rq + 3])); q1_[rq] = quadsum((p1[4 * rq] + p1[4 * rq + 1]) + (p1[4 * rq + 2] + p1[4 * rq + 3])); \
              t0_[rq] = quadsum(p0[4 * rq + 3]); t1_[rq] = quadsum(p1[4 * rq + 3]); } \
          float* ipb = imp + tl * IMPP + (jt) * 16 + hi; const int jbb = (jt) * 16 + hi; \
          if ((lane & 3) == 0) { float a_[4], b_[4]; \
              _Pragma("unroll") for (int rq = 0; rq < 4; ++rq) { a_[rq] = ipb[2 * rq]; b_[rq] = ipb[2 * rq + 8]; } \
              _Pragma("unroll") for (int rq = 0; rq < 4; ++rq) { ipb[2 * rq] = a_[rq] + q0_[rq]; ipb[2 * rq + 8] = b_[rq] + q1_[rq]; } } \
          __builtin_amdgcn_wave_barrier(); asm volatile("s_waitcnt lgkmcnt(0)" ::: "memory"); \
          if ((lane & 3) == 0) { float a_[4], b_[4]; \
              _Pragma("unroll") for (int rq = 0; rq < 4; ++rq) { a_[rq] = ipb[2 * rq + 1]; b_[rq] = (jbb + 2 * rq + 9 < 128) ? ipb[2 * rq + 9] : 0.f; } \
              _Pragma("unroll") for (int rq = 0; rq < 4; ++rq) { ipb[2 * rq + 1] = a_[rq] + t0_[rq]; if (jbb + 2 * rq + 9 < 128) ipb[2 * rq + 9] = b_[rq] + t1_[rq]; } } \
          __builtin_amdgcn_wave_barrier(); asm volatile("s_waitcnt lgkmcnt(0)" ::: "memory"); } \
        pv_tile(slot + 8192, p0, p1, Sc.o, lane, hi); } while (0)
    AT2_TILE_LOOP(0, nT, KC, 128, ROW_CMP, 0, 511, 0, 64, { CMP2_TILE(j, slotA); if (has2) CMP2_TILE(j - 1, slotB); });
    __syncthreads();
    UA_STAMP(2);
    {   int c2 = c; asm volatile("" : "+s"(c2));
        const int tk = wave * 8 + (lane >> 3), sub = lane & 7; unsigned bits = 0u;
        if (c2 < 16) {
_Pragma("unroll")
            for (int i = 0; i < 16; ++i) bits |= ((sub * 16 + i) <= c2) ? (1u << i) : 0u;
        } else {
            unsigned key[16]; unsigned eligm = 0u, forcedm = 0u;
            { const f4* ip = (const f4*)(imp + tk * IMPP + sub * 16);
_Pragma("unroll")
              for (int q4 = 0; q4 < 4; ++q4) { const f4 v = ip[q4];
_Pragma("unroll")
                  for (int e = 0; e < 4; ++e) { const int i = q4 * 4 + e, jx = sub * 16 + i; const bool el = (jx >= 1) && (jx <= c2 - 2);
                      key[i] = el ? __float_as_uint(fmaxf(v[e], 0.f)) : 0u; eligm |= el ? (1u << i) : 0u; forcedm |= ((jx == 0) || (jx == c2 - 1) || (jx == c2)) ? (1u << i) : 0u; } } }
#define G8SUM(x) do { x += __builtin_amdgcn_update_dpp(0, x, 0xB1, 0xF, 0xF, true); x += __builtin_amdgcn_update_dpp(0, x, 0x4E, 0xF, 0xF, true); x += __builtin_amdgcn_update_dpp(0, x, 0x141, 0xF, 0xF, true); } while (0)
            unsigned tau = 0u; int c13 = 128;
            for (int bit = 30; bit >= 0; --bit) { const unsigned cand = tau | (1u << bit); int cnt = 0;
_Pragma("unroll")
                for (int i = 0; i < 16; ++i) cnt += (key[i] >= cand) ? 1 : 0;
                G8SUM(cnt); if (cnt >= 13) { tau = cand; c13 = cnt; }
                if (__all(c13 == 13)) break; }
            int ngt = 0, neq = 0; unsigned gtm = 0u, eqm = 0u;
_Pragma("unroll")
            for (int i = 0; i < 16; ++i) { const bool el = (eligm >> i) & 1u; const bool g1 = el && key[i] > tau, e1 = el && key[i] == tau; gtm |= g1 ? (1u << i) : 0u; eqm |= e1 ? (1u << i) : 0u; ngt += g1 ? 1 : 0; neq += e1 ? 1 : 0; }
            G8SUM(ngt); const int need = 13 - ngt;
            int incl = neq;
_Pragma("unroll")
            for (int d = 1; d < 8; d <<= 1) { const int y = __shfl_up(incl, d, 8); if (sub >= d) incl += y; }
            int pre = incl - neq;
            bits = forcedm | gtm;
_Pragma("unroll")
            for (int i = 0; i < 16; ++i) { if ((eqm >> i) & 1u) { if (pre < need) bits |= (1u << i); ++pre; } }
#undef G8SUM
        }
        ((unsigned short*)selm)[tk * 8 + sub] = (unsigned short)bits;
    }
    __builtin_amdgcn_wave_barrier(); asm volatile("s_waitcnt lgkmcnt(0)" ::: "memory");
    const unsigned sm0 = selm[tl * 4 + 0], sm1 = selm[tl * 4 + 1], sm2 = selm[tl * 4 + 2], sm3 = selm[tl * 4 + 3];
    __syncthreads();
    acc_reg(tot, Sc.o, gt[r32 * 3 + 0], wsf, r32, hi, false);
    { typedef __attribute__((address_space(1))) float gfloat; gfloat* pa = (gfloat*)(P.out + (size_t)16 * 1024 * 1024 + ((size_t)blockIdx.x * 8 + wave) * 2048 + lane); gfloat* pb = pa + 1024; asm volatile("" : "+v"(pa), "+v"(pb));
_Pragma("unroll")
      for (int r = 0; r < 16; ++r) { pa[r * 64] = tot[0][r]; pb[r * 64] = tot[1][r]; } }
    UA_STAMP(3);
    const int fr = lane & 15, fq = lane >> 4;
    SM16 S16[2]; sm16_init(S16[0]); sm16_init(S16[1]);
    {
        const int hd16 = g * 4 + (fr & 3); const float slope16 = __uint_as_float((unsigned)(126 - hd16) << 23) * LOG2E;
        Bias16 B16; bias16_init(B16, slope16, fr, fq);
        bf16x8 q16[2][2]; unsigned sel16[2][4]; int t16[2];
_Pragma("unroll")
        for (int sg = 0; sg < 2; ++sg) { const int tl16 = wave * 8 + sg * 4 + (fr >> 2); t16[sg] = c * 64 + tl16; const size_t tok16 = (size_t)(rowbase + t16[sg]);
_Pragma("unroll")
            for (int ks = 0; ks < 2; ++ks) { const u4 w = *(const u4*)(PROJ + tok16 * NP + C_AQ + hd16 * 64 + ks * 32 + fq * 8); u4 o;
_Pragma("unroll")
                for (int e = 0; e < 4; ++e) o[e] = cvtpk(__uint_as_float(w[e] << 16) * C2, __uint_as_float(w[e] & 0xffff0000u) * C2);
                q16[sg][ks] = __builtin_bit_cast(bf16x8, o); }
_Pragma("unroll")
            for (int w4 = 0; w4 < 4; ++w4) sel16[sg][w4] = selm[tl16 * 4 + w4]; }
        unsigned any16[2][4];
_Pragma("unroll")
        for (int sg = 0; sg < 2; ++sg)
_Pragma("unroll")
            for (int w4 = 0; w4 < 4; ++w4) { unsigned x = sel16[sg][w4]; x |= (unsigned)__shfl_xor((int)x, 4); x |= (unsigned)__shfl_xor((int)x, 8); any16[sg][w4] = (unsigned)__builtin_amdgcn_readfirstlane((int)x); }
        AT2_TILE_LOOP8F(0, c, PROJ, NP, ROW_SEQ, C_AKS + g * 64, C_AVS + g * 64, {
_Pragma("unroll")
            for (int sg = 0; sg < 2; ++sg) { const unsigned aw = (jt < 32) ? any16[sg][0] : (jt < 64) ? any16[sg][1] : (jt < 96) ? any16[sg][2] : any16[sg][3];
                if ((aw >> (jt & 31)) & 1u) { const unsigned wS = (jt < 32) ? sel16[sg][0] : (jt < 64) ? sel16[sg][1] : (jt < 96) ? sel16[sg][2] : sel16[sg][3]; const bool sel = (wS >> (jt & 31)) & 1u;
                    sub_tile16(S16[sg], slot, q16[sg], B16, slope16, slope16 * (float)(jt * 64 - t16[sg]) - S16[sg].m, sel, jt == c, t16[sg] - jt * 64, wsf + sg * 16, lane, fr, fq); } } });
    }
    UA_STAMP(4);
    UA_STAMP(5);
    { typedef __attribute__((address_space(1))) float gfloat; const gfloat* pa = (const gfloat*)(P.out + (size_t)16 * 1024 * 1024 + ((size_t)blockIdx.x * 8 + wave) * 2048 + lane); const gfloat* pb = pa + 1024; asm volatile("" : "+v"(pa), "+v"(pb));
_Pragma("unroll")
      for (int r = 0; r < 16; ++r) { tot[0][r] = pa[r * 64]; tot[1][r] = pb[r * 64]; } }
    stage_rows(accw, tot, r32, hi);
_Pragma("unroll")
    for (int sg = 0; sg < 2; ++sg) { const float lt = swapsum(swz16sum(S16[sg].l));
        __builtin_amdgcn_wave_barrier(); asm volatile("" ::: "memory");
        if (fq == 0) wsf[sg * 16 + fr] = gt[(sg * 16 + fr) * 3 + 1] / lt;
        __builtin_amdgcn_wave_barrier(); asm volatile("s_waitcnt lgkmcnt(0)" ::: "memory");
_Pragma("unroll")
        for (int i = 0; i < 4; ++i) { const int row = sg * 16 + 4 * fq + i; const float fac = wsf[row];
_Pragma("unroll")
            for (int dd = 0; dd < 4; ++dd) accw[row * 64 + dd * 16 + fr] += fac * S16[sg].o[dd][i]; } }
    __builtin_amdgcn_wave_barrier(); asm volatile("s_waitcnt lgkmcnt(0)" ::: "memory");
    { const size_t tok0 = (size_t)(rowbase + c * 64 + wave * 8); out_rows(accw, PROJ + tok0 * NP + C_AZ + g * 256, MIX + tok0 * D + g * 256, lane); }
    __syncthreads();
    UA_STAMP(7);
}
__device__ __forceinline__ void unit_c(const Params& P, int layer, int b, int g, int c, unsigned char* lds) {
    int tid_ = tidx_(P.wv); const int tid = tid_, lane = tid & 63, wave = __builtin_amdgcn_readfirstlane(tid >> 6), r32 = lane & 31, hi = lane >> 5;
    const bf16* PROJ = (const bf16*)(P.ws + WS_PROJ); bf16* MIX = (bf16*)(P.ws + WS_MIX);
    float* wsf = (float*)(lds + L_WSF) + wave * 32;
    const long rowbase = (long)b * T; const int tl = wave * 8 + (r32 >> 2), t = c * 64 + tl, hd = g * 4 + (r32 & 3); const size_t tok = (size_t)(rowbase + t);
    const float slope2 = __uint_as_float((unsigned)(126 - hd) << 23) * LOG2E;
    bf16x8 qr[4]; load_q(qr, PROJ, tok, C_CQ + hd * 64, hi);
    Bias alibi; bias_init(alibi, slope2, r32, hi);
    SM S; sm_init(S); const int j0 = (c >= 2) ? c - 2 : 0;
    AT2_TILE_ALL3(j0, c, PROJ, NP, ROW_SEQ, C_CK + g * 64, C_CV + g * 64, {
        const int jb = j - 1; const float rcA = slope2 * (float)(j * 64 - t), rcB = rcA - 64.0f * slope2; const int relA = t - j * 64 - 4 * hi, relB = relA + 64;
        const bool mA = (j == c) || (j == c - 2), mB = (jb == c) || (jb == c - 2);
        const int rcA_ = (j == c) ? relA : (1 << 20), rwA_ = (j == c - 2) ? relA - 128 : -(1 << 20), rcB_ = (jb == c) ? relB : (1 << 20), rwB_ = (jb == c - 2) ? relB - 128 : -(1 << 20);
        if (has2) sm_tile2(S, slotA, slotB, qr, alibi, rcA, rcB, slope2, true, true, mA, rcA_, rwA_, mB, rcB_, rwB_, wsf, lane, r32, hi);
        else sm_tile(S, slotA, qr, alibi, rcA, slope2, true, mA, rcA_, rwA_, wsf, lane, r32, hi); });
    const float lt = swapsum(S.l); const float sk2 = P.sinks[layer * 8 + hd] * LOG2E;
    const float Mx = fmaxf(S.m, sk2); const float a = __builtin_amdgcn_exp2f(S.m - Mx); const float fac = a / (lt * a + __builtin_amdgcn_exp2f(sk2 - Mx));
    float* accw = (float*)(lds + L_ACC) + wave * 2048;
    acc_lds(accw, S.o, fac, wsf, r32, hi, true);
    { const size_t tok0 = (size_t)(rowbase + c * 64 + wave * 8); out_rows(accw, PROJ + tok0 * NP + C_CZ + g * 256, MIX + tok0 * D + 1536 + g * 256, lane); }
    __syncthreads();
}
}
namespace ml {
using at2::bf16x8; using at2::s16x4; using at2::f32x16; using at2::lds_cptr; using at2::vtr; using at2::crow; using at2::cvtpk; using at2::swapsum;
constexpr size_t WS_U = 479 * MiB, WS_BC = 511 * MiB, WS_PM = WS_BC + 256 * 1024, WS_NST = WS_PM + 256 * 1024, WS_SEGS = WS_NST + 256 * 1024;
constexpr int QP = 2048;
__device__ __forceinline__ bf16x8 tr_frag(lds_cptr base, int PB, int row0, int col0, int lane) {
    const int g16 = lane >> 4, h = g16 >> 1, q = (lane & 15) >> 2, p = lane & 3;
    const lds_cptr a = base + (row0 + 8 * h + q) * PB + (col0 + 16 * (g16 & 1) + 4 * p) * 2;
    const s16x4 lo = vtr(a), hh = vtr(a + 4 * PB);
    return (bf16x8){lo[0], lo[1], lo[2], lo[3], hh[0], hh[1], hh[2], hh[3]};
}
__device__ __forceinline__ bf16x8 tr_frag_perm(lds_cptr base, int PB, int row0, int col0, int lane) {
    const int g16 = lane >> 4, h = g16 >> 1, q = (lane & 15) >> 2, p = lane & 3;
    const lds_cptr a = base + (row0 + 4 * h + q) * PB + (col0 + 16 * (g16 & 1) + 4 * p) * 2;
    const s16x4 lo = vtr(a), hh = vtr(a + 8 * PB);
    return (bf16x8){lo[0], lo[1], lo[2], lo[3], hh[0], hh[1], hh[2], hh[3]};
}
__device__ __forceinline__ void m0_prep(const Params& P, int layer, int seg, unsigned char* lds) {
    int tid_ = tidx_(P.wv); const int tid = tid_, lane = tid & 63, wave = tid >> 6;
    const bf16* PROJ = (const bf16*)(P.ws + WS_PROJ); const float* SMALL = (const float*)(P.ws + WS_SMALL); bf16* QKC = (bf16*)P.out;
    float* BC = (float*)(P.ws + WS_BC); float* PM = (float*)(P.ws + WS_PM); float* NST = (float*)(P.ws + WS_NST); float* SEGS = (float*)(P.ws + WS_SEGS);
    float* sa = (float*)lds; float* wt = sa + 256; float* scal = wt + 16;
    const int bh = seg >> 5, b = bh >> 2, h = bh & 3, s = seg & 31; const size_t tok0 = (size_t)b * T + s * 256;
    const long tlo = (long)b * T;
    u4 pre[9];
#define M0_LOAD(SB) do { const long t0_ = (long)tok0 + (SB) * 64; _Pragma("unroll") for (int i = 0; i < 9; ++i) { const int ci = tid + 512 * i; pre[i] = (u4){0u, 0u, 0u, 0u}; \
        if (ci < 67 * 64) { const int row = ci >> 6, c = ci & 63; const long tr = t0_ - 3 + row; \
            if (tr >= tlo) pre[i] = *(const u4*)(PROJ + (size_t)tr * NP + ((c < 32) ? (C_BQ + h * 256 + c * 8) : (C_BK + h * 256 + (c - 32) * 8))); } } } while (0)
    M0_LOAD(0);
    float x = 0.f, iv = 0.f;
    if (tid < 256) { const size_t tok = tok0 + tid; iv = SMALL[tok * 32 + S_I + h] + P.i_bias[layer * 4 + h]; x = logsigmoidf_(SMALL[tok * 32 + S_F + h] + P.f_bias[layer * 4 + h]);
#pragma unroll
        for (int o = 1; o < 64; o <<= 1) { const float y = __shfl_up(x, o); if (lane >= o) x += y; }
        if (lane == 63) wt[wave] = x; }
    __syncthreads();
    float a = 0.f, mx = 0.f, bc = 0.f;
    if (tid < 256) { float off = 0.f; for (int w2 = 0; w2 < wave; ++w2) off += wt[w2]; bc = x + off; a = iv - bc; mx = a;
#pragma unroll
        for (int o = 1; o < 64; o <<= 1) { const float y = __shfl_up(mx, o); if (lane >= o) mx = fmaxf(mx, y); }
        if (lane == 63) wt[8 + wave] = mx; }
    __syncthreads();
    if (tid < 256) { for (int w2 = 0; w2 < wave; ++w2) mx = fmaxf(mx, wt[8 + w2]); const size_t tok = tok0 + tid; BC[tok * 4 + h] = bc; PM[tok * 4 + h] = mx; sa[tid] = a;
        if (tid == 255) { scal[0] = bc; scal[1] = mx; SEGS[seg] = bc; SEGS[256 + seg] = mx; } }
    __syncthreads();
    const float amax = scal[1];
    if (tid < 256) sa[tid] = 0.0625f * __expf(sa[tid] - amax);
    __syncthreads();
    bf16* xin = (bf16*)(lds + 4096); bf16* xout = (bf16*)(lds + 4096 + 67 * 1024);
    const int ch = tid; const bool isq = ch < 256; const int cc = isq ? (h * 256 + ch) : (1024 + h * 256 + (ch - 256));
    const float* cw = P.conv_w + (size_t)layer * 4 * 2048 + cc; const float cw0 = cw[0], cw1 = cw[2048], cw2 = cw[4096], cw3 = cw[6144], cb = P.conv_b[layer * 2048 + cc];
    float nsum = 0.f;
    for (int sb = 0; sb < 4; ++sb) { const long t0 = (long)tok0 + sb * 64;
#pragma unroll
        for (int i = 0; i < 9; ++i) { const int ci = tid + 512 * i; if (ci < 67 * 64) *(u4*)(xin + (ci >> 6) * 512 + (ci & 63) * 8) = pre[i]; }
        __syncthreads();
        if (sb < 3) M0_LOAD(sb + 1);
        { float xm3 = bf2f(xin[ch]), xm2 = bf2f(xin[512 + ch]), xm1 = bf2f(xin[1024 + ch]);
#pragma unroll 2
          for (int t4 = 0; t4 < 64; t4 += 4) { f4 ks4 = *(const f4*)(sa + sb * 64 + t4); asm volatile("" : "+v"(ks4));
#pragma unroll
              for (int e = 0; e < 4; ++e) { const int tl = t4 + e; const float xc = bf2f(xin[(tl + 3) * 512 + ch]); const float y = __builtin_fmaf(cw3, xc, __builtin_fmaf(cw2, xm1, __builtin_fmaf(cw1, xm2, __builtin_fmaf(cw0, xm3, cb)))); xm3 = xm2; xm2 = xm1; xm1 = xc;
                  const float v = siluf_(y) * (isq ? 1.0f : ks4[e]); nsum += v;
                  xout[tl * 512 + ch] = (bf16)f2bf(v); } } }
        __syncthreads();
        for (int ci = tid; ci < 64 * 64; ci += 512) { const int row = ci >> 6, c = ci & 63;
            *(u4*)(QKC + (size_t)(t0 + row) * QP + ((c < 32) ? (h * 256 + c * 8) : (1024 + h * 256 + (c - 32) * 8))) = *(const u4*)(xout + row * 512 + c * 8); } }
#undef M0_LOAD
    if (!isq) NST[(size_t)seg * 256 + (ch - 256)] = nsum;
    __syncthreads();
}
constexpr int PB = 576;
__device__ __forceinline__ void m1_state(const Params& P, int seg, unsigned char* lds) {
    int tid_ = tidx_(P.wv); const int tid = tid_, lane = tid & 63, wave = __builtin_amdgcn_readfirstlane(tid >> 6), r32 = lane & 31, hi = lane >> 5;
    const bf16* PROJ = (const bf16*)(P.ws + WS_PROJ); const bf16* QKC = (const bf16*)P.out; bf16* U = (bf16*)(P.ws + WS_U) + (size_t)seg * 65536;
    const int bh = seg >> 5, b = bh >> 2, h = bh & 3, s = seg & 31; const size_t tok0 = (size_t)b * T + s * 256;
    f32x16 acc[8];
#pragma unroll
    for (int i = 0; i < 8; ++i) acc[i] = f32x16{};
    const int lrow = tid >> 4, lc = tid & 15;
    const bf16* gk = QKC + (tok0 + lrow) * QP + 1024 + h * 256 + lc * 8; const bf16* gv = PROJ + (tok0 + lrow) * NP + C_BV + h * 256 + lc * 8;
    u4 rkA0, rkA1, rvA0, rvA1, rkB0, rkB1, rvB0, rvB1, rkC0, rkC1, rvC0, rvC1, rkD0, rkD1, rvD0, rvD1;
#define M1_LOAD(CK, R0, R1, V0, V1) do { const size_t o = (size_t)(CK) * 32; R0 = *(const u4*)(gk + o * QP); R1 = *(const u4*)(gk + o * QP + 128); V0 = *(const u4*)(gv + o * NP); V1 = *(const u4*)(gv + o * NP + 128); } while (0)
    M1_LOAD(0, rkA0, rkA1, rvA0, rvA1); M1_LOAD(1, rkB0, rkB1, rvB0, rvB1); M1_LOAD(2, rkC0, rkC1, rvC0, rvC1); M1_LOAD(3, rkD0, rkD1, rvD0, rvD1);
    __syncthreads();
#define M1_STEP(CK, R0, R1, V0, V1) do { \
        unsigned char* st = lds + ((CK) & 1) * (2 * 32 * PB); \
        *(u4*)(st + lrow * PB + lc * 16) = R0; *(u4*)(st + lrow * PB + 256 + lc * 16) = R1; \
        *(u4*)(st + 32 * PB + lrow * PB + lc * 16) = V0; *(u4*)(st + 32 * PB + lrow * PB + 256 + lc * 16) = V1; \
        if ((CK) + 4 < 8) M1_LOAD((CK) + 4, R0, R1, V0, V1); \
        __syncthreads(); \
        const lds_cptr kt = (lds_cptr)st, vt = (lds_cptr)(st + 32 * PB); \
        _Pragma("unroll") for (int ks = 0; ks < 2; ++ks) { const bf16x8 bk = tr_frag(kt, PB, ks * 16, wave * 32, lane); \
            _Pragma("unroll") for (int eh = 0; eh < 2; ++eh) { bf16x8 av4[4];     \
                _Pragma("unroll") for (int e = 0; e < 4; ++e) av4[e] = tr_frag(vt, PB, ks * 16, (eh * 4 + e) * 32, lane); \
                _Pragma("unroll") for (int e = 0; e < 4; ++e) acc[eh * 4 + e] = __builtin_amdgcn_mfma_f32_32x32x16_bf16(av4[e], bk, acc[eh * 4 + e], 0, 0, 0); } } } while (0)
    for (int ck = 0; ck < 8; ck += 4) { M1_STEP(ck, rkA0, rkA1, rvA0, rvA1); M1_STEP(ck + 1, rkB0, rkB1, rvB0, rvB1); M1_STEP(ck + 2, rkC0, rkC1, rvC0, rvC1); M1_STEP(ck + 3, rkD0, rkD1, rvD0, rvD1); }
#undef M1_STEP
#undef M1_LOAD
    __syncthreads();
    bf16* so = (bf16*)lds;
#pragma unroll
    for (int et = 0; et < 8; ++et)
#pragma unroll
        for (int r = 0; r < 16; ++r) so[(et * 32 + crow(r, hi)) * 264 + wave * 32 + r32] = (bf16)f2bf(acc[et][r]);
    __syncthreads();
    for (int i = tid; i < 256 * 32; i += 512) { const int e = i >> 5, c16 = i & 31; *(u4*)(U + (size_t)e * 256 + c16 * 8) = *(const u4*)(so + e * 264 + c16 * 8); }
    __syncthreads();
}
__device__ __forceinline__ void m2_scan(const Params& P, int part) {
    int tid_ = tidx_(P.wv); const int gt = part * 512 + tid_;
    const int bh = gt >> 13, idx = gt & 8191; bf16* U = (bf16*)(P.ws + WS_U) + (size_t)bh * 32 * 65536 + idx * 8; float* NST = (float*)(P.ws + WS_NST) + (size_t)bh * 32 * 256; float* SEGS = (float*)(P.ws + WS_SEGS);
    float c[8] = {0.f, 0.f, 0.f, 0.f, 0.f, 0.f, 0.f, 0.f}; float n8[8] = {0.f, 0.f, 0.f, 0.f, 0.f, 0.f, 0.f, 0.f}; float m = 0.f; const bool don = idx < 32;
    const float blv = SEGS[bh * 32 + (tid_ & 31)], amv = SEGS[256 + bh * 32 + (tid_ & 31)];
    for (int s0 = 0; s0 < 32; s0 += 16) {
        u4 uu[16]; f4 na[16][2];
#pragma unroll
        for (int k = 0; k < 16; ++k) uu[k] = *(const u4*)(U + (size_t)(s0 + k) * 65536);
        if (don) {
#pragma unroll
            for (int k = 0; k < 16; ++k) { const float* np = NST + (size_t)(s0 + k) * 256 + idx * 8; na[k][0] = *(const f4*)np; na[k][1] = *(const f4*)(np + 4); } }
        asm volatile("" ::: "memory");
#pragma unroll
        for (int k = 0; k < 16; ++k) { const int sg = bh * 32 + s0 + k; const float blast = __shfl(blv, s0 + k), mloc = blast + __shfl(amv, s0 + k);
            const float mn = fmaxf(blast + m, mloc); const float dec = __expf(blast + m - mn), wl = __expf(mloc - mn);
            u4 o; o.x = pk2(c[0], c[1]); o.y = pk2(c[2], c[3]); o.z = pk2(c[4], c[5]); o.w = pk2(c[6], c[7]); *(u4*)(U + (size_t)(s0 + k) * 65536) = o;
#pragma unroll
            for (int e = 0; e < 4; ++e) { c[2 * e] = dec * c[2 * e] + wl * __uint_as_float(uu[k][e] << 16); c[2 * e + 1] = dec * c[2 * e + 1] + wl * __uint_as_float(uu[k][e] & 0xffff0000u); }
            if (don) { float* np = NST + (size_t)(s0 + k) * 256 + idx * 8;
                *(f4*)np = (f4){n8[0], n8[1], n8[2], n8[3]}; *(f4*)(np + 4) = (f4){n8[4], n8[5], n8[6], n8[7]};
#pragma unroll
                for (int e = 0; e < 4; ++e) { n8[e] = dec * n8[e] + wl * na[k][0][e]; n8[4 + e] = dec * n8[4 + e] + wl * na[k][1][e]; } }
            if (idx == 0) SEGS[512 + sg] = m;
            m = mn; }
    }
}
constexpr int M3_STG = 32768 + 64 * PB;
constexpr int M3_TAB = 2 * M3_STG;
#ifdef PROBE_ID
#define M3_STAMP(k) do { if (seg == 0 && layer == 0 && tidx_(P.wv) == 0) ((unsigned long long*)(P.ws + WS_BAR + 15360))[k] = __builtin_amdgcn_s_memrealtime(); } while (0)
#else
#define M3_STAMP(k) do {} while (0)
#endif
__device__ __forceinline__ void m3_out(const Params& P, int layer, int seg, unsigned char* lds) {
    int tid_ = tidx_(P.wv); const int tid = tid_, lane = tid & 63, wave = __builtin_amdgcn_readfirstlane(tid >> 6), r32 = lane & 31, hi = lane >> 5;
    const bf16* PROJ = (const bf16*)(P.ws + WS_PROJ); const bf16* QKC = (const bf16*)P.out; const bf16* CT = (const bf16*)(P.ws + WS_U) + (size_t)seg * 65536; bf16* MIX = (bf16*)(P.ws + WS_MIX);
    const float* BC = (const float*)(P.ws + WS_BC); const float* PM = (const float*)(P.ws + WS_PM); const float* NST = (const float*)(P.ws + WS_NST) + (size_t)seg * 256; const float* SEGS = (const float*)(P.ws + WS_SEGS);
    const int bh = seg >> 5, b = bh >> 2, h = bh & 3, s = seg & 31; const size_t tok0 = (size_t)b * T + s * 256;
    float* wsf = (float*)(lds + M3_TAB) + wave * 32; float* nvec = (float*)(lds + M3_TAB + 1024); float* rowf = nvec + 256; float* wint = rowf + 256; float* clampv = wint + 256; float* dqv = clampv + 256;
    if (tid < 256) { const float mst = SEGS[512 + seg], amax = SEGS[256 + seg]; const float pm = PM[(tok0 + tid) * 4 + h], bc = BC[(tok0 + tid) * 4 + h]; const float mxt = fmaxf(mst, pm);
        rowf[tid] = __expf(amax - mxt); wint[tid] = __expf(mst - mxt); clampv[tid] = __expf(-(bc + mxt)); nvec[tid] = NST[tid]; }
    M3_STAMP(0);
    f32x16 H[8];
#pragma unroll
    for (int i = 0; i < 8; ++i) H[i] = f32x16{};
    const bf16* qrow = QKC + (tok0 + wave * 32 + r32) * QP + h * 256 + hi * 8;
    {   const int lrow = tid >> 3, lch = tid & 7;
        u4 rs[2][4];
#pragma unroll
        for (int i = 0; i < 4; ++i) rs[0][i] = *(const u4*)(CT + (size_t)(lrow + 64 * i) * 256 + lch * 8);
#pragma unroll
        for (int i = 0; i < 4; ++i) rs[1][i] = *(const u4*)(CT + (size_t)(lrow + 64 * i) * 256 + 64 + lch * 8);
        __syncthreads();
        float dq = 0.f;
        const int cofb = r32 * 128 + (((r32 >> 1) & 3) << 5) + ((hi ^ (r32 & 1)) << 4);
#define M3_INTER_STEP(CK, RS) do { unsigned char* st = lds + ((CK) & 1) * 32768; \
            bf16x8 qa4[4]; \
            _Pragma("unroll") for (int k4 = 0; k4 < 4; ++k4) qa4[k4] = *(const bf16x8*)(qrow + ((CK) * 4 + k4) * 16); \
            _Pragma("unroll") for (int i = 0; i < 4; ++i) { const int row = lrow + 64 * i; *(u4*)(st + row * 128 + ((lch ^ (row & 7)) << 4)) = RS[i]; } \
            { const int cn = ((CK) + 2 < 4) ? (CK) + 2 : 3;     \
              _Pragma("unroll") for (int i = 0; i < 4; ++i) RS[i] = *(const u4*)(CT + (size_t)(lrow + 64 * i) * 256 + cn * 64 + lch * 8); } \
            __syncthreads(); \
            _Pragma("unroll") for (int k4 = 0; k4 < 4; ++k4) { const int ks = (CK) * 4 + k4; const bf16x8 qa = qa4[k4]; \
                _Pragma("unroll") for (int e = 0; e < 8; ++e) dq += bf2f((unsigned short)qa[e]) * nvec[ks * 16 + hi * 8 + e]; \
                _Pragma("unroll") for (int eh = 0; eh < 2; ++eh) { bf16x8 cb4[4]; \
                    _Pragma("unroll") for (int e = 0; e < 4; ++e) cb4[e] = *(const bf16x8*)(st + (cofb ^ (k4 << 5)) + (eh * 4 + e) * 4096); \
                    _Pragma("unroll") for (int e = 0; e < 4; ++e) H[eh * 4 + e] = __builtin_amdgcn_mfma_f32_32x32x16_bf16(qa, cb4[e], H[eh * 4 + e], 0, 0, 0); } } } while (0)
        for (int ck = 0; ck < 4; ck += 2) { M3_INTER_STEP(ck, rs[0]); M3_INTER_STEP(ck + 1, rs[1]); }
#undef M3_INTER_STEP
        dq = swapsum(dq);
        if (hi == 0) dqv[wave * 32 + r32] = wint[wave * 32 + r32] * dq;
        __builtin_amdgcn_wave_barrier(); asm volatile("" ::: "memory");
        if (hi == 0) wsf[r32] = wint[wave * 32 + r32];
        __builtin_amdgcn_wave_barrier(); asm volatile("s_waitcnt lgkmcnt(0)" ::: "memory");
#pragma unroll
        for (int r = 0; r < 16; ++r) { const float a = wsf[crow(r, hi)];
#pragma unroll
            for (int et = 0; et < 8; ++et) H[et][r] *= a; }
        __builtin_amdgcn_wave_barrier(); asm volatile("" ::: "memory");
        M3_STAMP(1);
        const float rf = rowf[wave * 32 + r32]; float dsum = 0.f;
        const int krow = tid >> 3, kc4 = tid & 7;
        __syncthreads();
        const int kofs = krow * 512 + ((kc4 ^ (krow & 7)) << 4), vofs = 32768 + krow * PB + kc4 * 16;
        const int offb = r32 * 512 + (((r32 >> 1) & 3) << 5) + ((hi ^ (r32 & 1)) << 4);
        u4 nk[4], nv[4];
        { const bf16* gk = QKC + (tok0 + krow) * QP + 1024 + h * 256; const bf16* gv = PROJ + (tok0 + krow) * NP + C_BV + h * 256;
#pragma unroll
          for (int i = 0; i < 4; ++i) { const int ch = kc4 + 8 * i; nk[i] = *(const u4*)(gk + ch * 8); nv[i] = *(const u4*)(gv + ch * 8); }
#pragma unroll
          for (int i = 0; i < 4; ++i) { *(u4*)(lds + kofs + i * 128) = nk[i]; *(u4*)(lds + vofs + i * 128) = nv[i]; } }
        for (int j = 0; j < 4; ++j) { unsigned char* st = lds + (j & 1) * M3_STG;
            bf16x8 qb16[16];
            if (j <= (wave >> 1)) {
#pragma unroll
                for (int ks = 0; ks < 4; ++ks) qb16[ks] = *(const bf16x8*)(qrow + ks * 16); }
            __syncthreads();
            f32x16 p0 = f32x16{}, p1 = f32x16{};
            if (j <= (wave >> 1)) {
#pragma unroll
                for (int ks = 0; ks < 16; ++ks) { if ((ks & 3) == 0 && ks < 12) {
#pragma unroll
                        for (int q = 0; q < 4; ++q) qb16[4 + ks + q] = *(const bf16x8*)(qrow + (4 + ks + q) * 16); }
                    const bf16x8 qb = qb16[ks]; const int off = (offb ^ ((ks & 3) << 5)) + (ks >> 2) * 128;
                    const bf16x8 a0 = *(const bf16x8*)(st + off), a1 = *(const bf16x8*)(st + off + 32 * 512);
                    p0 = __builtin_amdgcn_mfma_f32_32x32x16_bf16(a0, qb, p0, 0, 0, 0); p1 = __builtin_amdgcn_mfma_f32_32x32x16_bf16(a1, qb, p1, 0, 0, 0); } }
            __builtin_amdgcn_sched_barrier(0);
            { const int jn = (j < 3) ? j + 1 : 3;
              const int t_ = tidx_(P.wv); const int kr_ = t_ >> 3, kc_ = t_ & 7;
              const bf16* gk = QKC + (tok0 + jn * 64 + kr_) * QP + 1024 + h * 256; const bf16* gv = PROJ + (tok0 + jn * 64 + kr_) * NP + C_BV + h * 256;
#pragma unroll
                for (int i = 0; i < 4; ++i) { const int ch = kc_ + 8 * i; nk[i] = *(const u4*)(gk + ch * 8); nv[i] = *(const u4*)(gv + ch * 8); } }
            __builtin_amdgcn_sched_barrier(0);
            if (j <= (wave >> 1)) {
                const int rel = wave * 32 + r32 - j * 64 - 4 * hi;
#pragma unroll
                for (int r = 0; r < 16; ++r) { const int c0 = (r & 3) + 8 * (r >> 2); const float x0 = (c0 <= rel) ? p0[r] * rf : 0.f, x1 = (c0 + 32 <= rel) ? p1[r] * rf : 0.f; p0[r] = x0; p1[r] = x1; dsum += x0 + x1; }
                bf16x8 pa[4];
#pragma unroll
                for (int k = 0; k < 4; ++k) { const f32x16& Pq = (k < 2) ? p0 : p1; const int bb = (k & 1) * 8;
                    u4 w; w.x = cvtpk(Pq[bb + 0], Pq[bb + 1]); w.y = cvtpk(Pq[bb + 2], Pq[bb + 3]); w.z = cvtpk(Pq[bb + 4], Pq[bb + 5]); w.w = cvtpk(Pq[bb + 6], Pq[bb + 7]); pa[k] = __builtin_bit_cast(bf16x8, w); }
                const lds_cptr vt = (lds_cptr)(st + 32768);
#pragma unroll
                for (int k = 0; k < 4; ++k)
#pragma unroll
                    for (int eh = 0; eh < 2; ++eh) { bf16x8 vf4[4];
#pragma unroll
                        for (int e = 0; e < 4; ++e) vf4[e] = tr_frag_perm(vt, PB, k * 16, (eh * 4 + e) * 32, lane);
#pragma unroll
                        for (int e = 0; e < 4; ++e) H[eh * 4 + e] = __builtin_amdgcn_mfma_f32_32x32x16_bf16(pa[k], vf4[e], H[eh * 4 + e], 0, 0, 0); }
            }
            { unsigned char* sn = lds + ((j + 1) & 1) * M3_STG;
              const int t_ = tidx_(P.wv); const int kr_ = t_ >> 3, kc_ = t_ & 7; const int kofs_ = kr_ * 512 + ((kc_ ^ (kr_ & 7)) << 4), vofs_ = 32768 + kr_ * PB + kc_ * 16;
#pragma unroll
              for (int i = 0; i < 4; ++i) { *(u4*)(sn + kofs_ + i * 128) = nk[i]; *(u4*)(sn + vofs_ + i * 128) = nv[i]; } }
        }
        M3_STAMP(2);
        dsum = swapsum(dsum);
        const int trow = wave * 32 + r32; const float den = dqv[trow] + dsum; const float rden = 1.0f / fmaxf(fabsf(den), clampv[trow]);
        __syncthreads();
        if (hi == 0) wsf[r32] = rden;
        __builtin_amdgcn_wave_barrier(); asm volatile("s_waitcnt lgkmcnt(0)" ::: "memory");
        bf16* hs = (bf16*)(lds + wave * (32 * 528));
#pragma unroll
        for (int r = 0; r < 16; ++r) { const float a = wsf[crow(r, hi)];
#pragma unroll
            for (int et = 0; et < 8; ++et) hs[crow(r, hi) * 264 + et * 32 + r32] = (bf16)f2bf(H[et][r] * a); }
        __builtin_amdgcn_wave_barrier(); asm volatile("s_waitcnt lgkmcnt(0)" ::: "memory");
        const int c16 = lane & 31, rsel = lane >> 5; const f4 g0 = *(const f4*)(P.mnorm_g + layer * 1024 + h * 256 + c16 * 8), g1 = *(const f4*)(P.mnorm_g + layer * 1024 + h * 256 + c16 * 8 + 4);
        u4 owA[4], zwA[4], owB[4], zwB[4];
#define M3_GLOAD(I4, OW, ZW) do { _Pragma("unroll") for (int q = 0; q < 4; ++q) { const size_t tok = tok0 + wave * 32 + ((I4) + q) * 2 + rsel; OW[q] = *(const u4*)(PROJ + tok * NP + C_BO + h * 256 + c16 * 8); ZW[q] = *(const u4*)(PROJ + tok * NP + C_BZ + h * 256 + c16 * 8); } } while (0)
#define M3_GROUP(I4, OW, ZW) do { _Pragma("unroll") for (int q = 0; q < 4; ++q) { const int row = ((I4) + q) * 2 + rsel; const size_t tok = tok0 + wave * 32 + row; \
                const u4 hw = *(const u4*)(hs + row * 264 + c16 * 8), ow = OW[q], zw = ZW[q]; \
                float hb[8]; float ss = 0.f; \
                _Pragma("unroll") for (int e = 0; e < 4; ++e) { hb[2 * e] = __uint_as_float(hw[e] << 16) * sigmoidf_(__uint_as_float(ow[e] << 16)); hb[2 * e + 1] = __uint_as_float(hw[e] & 0xffff0000u) * sigmoidf_(__uint_as_float(ow[e] & 0xffff0000u)); ss += hb[2 * e] * hb[2 * e] + hb[2 * e + 1] * hb[2 * e + 1]; } \
                ss += __int_as_float(__builtin_amdgcn_update_dpp(0, __float_as_int(ss), 0xB1, 0xF, 0xF, true)); ss += __int_as_float(__builtin_amdgcn_update_dpp(0, __float_as_int(ss), 0x4E, 0xF, 0xF, true)); \
                ss += __int_as_float(__builtin_amdgcn_update_dpp(0, __float_as_int(ss), 0x141, 0xF, 0xF, true)); ss += __int_as_float(__builtin_amdgcn_update_dpp(0, __float_as_int(ss), 0x140, 0xF, 0xF, true)); \
                ss = at2::swz16sum(ss); \
                const float rstd = 1.0f / sqrtf(ss * (1.0f / 256.0f) + EPS); float y[8]; \
                _Pragma("unroll") for (int e = 0; e < 4; ++e) { y[2 * e] = hb[2 * e] * rstd * siluf_(__uint_as_float(zw[e] << 16)); y[2 * e + 1] = hb[2 * e + 1] * rstd * siluf_(__uint_as_float(zw[e] & 0xffff0000u)); } \
                u4 out; out.x = pk2(y[0] * g0[0], y[1] * g0[1]); out.y = pk2(y[2] * g0[2], y[3] * g0[3]); out.z = pk2(y[4] * g1[0], y[5] * g1[1]); out.w = pk2(y[6] * g1[2], y[7] * g1[3]); \
                *(u4*)(MIX + tok * D + 512 + h * 256 + c16 * 8) = out; } } while (0)
        M3_GLOAD(0, owB, zwB);
#pragma nounroll
        for (int i4 = 0; i4 < 16; i4 += 4) {
#pragma unroll
            for (int q = 0; q < 4; ++q) { owA[q] = owB[q]; zwA[q] = zwB[q]; }
            if (i4 + 4 < 16) M3_GLOAD(i4 + 4, owB, zwB);
            asm volatile("" ::: "memory");
            M3_GROUP(i4, owA, zwA); }
#undef M3_GLOAD
#undef M3_GROUP
    }
    __syncthreads();
    M3_STAMP(3);
}
}
namespace cp2 {
using at2::bf16x8; using at2::f32x16; using at2::crow;
constexpr size_t WS_W1T = 512 * MiB;
constexpr size_t WS_C1 = WS_W1T + 2 * 2 * 64 * 2048 * 2;
__device__ __forceinline__ void compress_task(const Params& P, int layer, int task, unsigned char* lds) {
    int tid_ = tidx_(P.wv); const int tid = tid_, lane = tid & 63, wave = __builtin_amdgcn_readfirstlane(tid >> 6), r32 = lane & 31, hi = lane >> 5;
    const bf16* PROJ = (const bf16*)(P.ws + WS_PROJ); bf16* KC = (bf16*)(P.ws + WS_KCMP);
    const int rt = task & 15, combo = task >> 4, g = combo & 1, b = (combo >> 1) & 1, kv = combo >> 2; const int i0 = rt * 32;
    const bf16* W1T = (const bf16*)(P.ws + WS_W1T) + (size_t)(layer * 2 + kv) * 64 * 2048; const float* C1 = (const float*)(P.ws + WS_C1) + (layer * 2 + kv) * 16 * 64;
    const float* w2 = (kv ? P.w2_v : P.w2_k) + (size_t)layer * 64 * 64;
    float* red = (float*)(lds + 69632); float* hid = (float*)(lds + 135168);
    f32x16 acc[2]; acc[0] = f32x16{}; acc[1] = f32x16{};
    const int col = (kv ? C_AVC : C_AKC) + g * 64;
    bf16x8 wf[4][4][2];
#pragma unroll
    for (int li = 0; li < 4; ++li) { const bf16* bp = W1T + (size_t)r32 * 2048 + (wave * 4 + li) * 64 + hi * 8;
#pragma unroll
        for (int kk = 0; kk < 4; ++kk) { wf[li][kk][0] = *(const bf16x8*)(bp + kk * 16); wf[li][kk][1] = *(const bf16x8*)(bp + 32 * 2048 + kk * 16); } }
    __syncthreads();
    { u4 tv[9];
#pragma unroll
      for (int i = 0; i < 9; ++i) { const int ci = tid + 512 * i; tv[i] = (u4){0u, 0u, 0u, 0u};
          if (ci < 528 * 8) { const int row = ci >> 3, ch = ci & 7; int tokn = 16 * i0 + row; tokn = tokn > T - 1 ? T - 1 : tokn; tv[i] = *(const u4*)(PROJ + ((size_t)b * T + tokn) * NP + col + ch * 8); } }
      asm volatile("" ::: "memory");
#pragma unroll
      for (int i = 0; i < 9; ++i) { const int ci = tid + 512 * i; if (ci < 528 * 8) { const int row = ci >> 3, ch = ci & 7; *(u4*)(lds + row * 128 + ((ch ^ ((row >> 4) & 7)) << 4)) = tv[i]; } } }
    __syncthreads();
#pragma unroll
    for (int li = 0; li < 4; ++li) { const int l = wave * 4 + li; const int row = 16 * r32 + l; const unsigned char* ap = lds + row * 128; const int sw = (row >> 4) & 7;
        bf16x8 af[4];
#pragma unroll
        for (int kk = 0; kk < 4; ++kk) af[kk] = *(const bf16x8*)(ap + (((2 * kk + hi) ^ sw) << 4));
#pragma unroll
        for (int kk = 0; kk < 4; ++kk) { acc[0] = __builtin_amdgcn_mfma_f32_32x32x16_bf16(af[kk], wf[li][kk][0], acc[0], 0, 0, 0); acc[1] = __builtin_amdgcn_mfma_f32_32x32x16_bf16(af[kk], wf[li][kk][1], acc[1], 0, 0, 0); } }
    const f4 w2a = *(const f4*)(w2 + tid * 8), w2b = *(const f4*)(w2 + tid * 8 + 4);
    __syncthreads();
    float* w2s = (float*)lds; *(f4*)(w2s + tid * 8) = w2a; *(f4*)(w2s + tid * 8 + 4) = w2b;
#pragma unroll
    for (int ct = 0; ct < 2; ++ct)
#pragma unroll
        for (int r = 0; r < 16; ++r) red[wave * 2048 + crow(r, hi) * 64 + ct * 32 + r32] = acc[ct][r];
    __syncthreads();
    { const int i = tid >> 4, j0 = (tid & 15) * 4; f4 cpart[16];
#pragma unroll
      for (int pp = 0; pp < 16; ++pp) cpart[pp] = *(const f4*)(C1 + pp * 64 + j0);
      f4 s = cpart[0];
#pragma unroll
      for (int pp = 1; pp < 16; ++pp) s += cpart[pp];
      { f4 rr[8];
#pragma unroll
        for (int w = 0; w < 8; ++w) rr[w] = *(const f4*)(red + w * 2048 + i * 64 + j0);
#pragma unroll
        for (int w = 0; w < 8; ++w) s += rr[w]; }
      *(f4*)(hid + i * 64 + j0) = (f4){siluf_(s[0]), siluf_(s[1]), siluf_(s[2]), siluf_(s[3])}; }
    __syncthreads();
    { const int i = tid >> 4, j0 = (tid & 15) * 4; f4 o = (f4){0.f, 0.f, 0.f, 0.f};
      for (int kb = 0; kb < 64; kb += 8) { const f4 h0 = *(const f4*)(hid + i * 64 + kb), h1 = *(const f4*)(hid + i * 64 + kb + 4); f4 wv8[8];
#pragma unroll
          for (int q = 0; q < 8; ++q) wv8[q] = *(const f4*)(w2s + (kb + q) * 64 + j0);
#pragma unroll
          for (int q = 0; q < 8; ++q) o += ((q < 4) ? h0[q & 3] : h1[q & 3]) * wv8[q]; }
      if (i0 + i >= NCMP) o = (f4){0.f, 0.f, 0.f, 0.f};
      bf16* dst = KC + ((size_t)(b * 2 + g) * CMP_PITCH + i0 + i) * 128 + kv * 64 + j0;
      *(unsigned long long*)dst = (unsigned long long)pk2(o[0], o[1]) | ((unsigned long long)pk2(o[2], o[3]) << 32); }
    __syncthreads();
}
__device__ __forceinline__ void prologue_cmp(const Params& P, unsigned char* lds, int gw, int NGW, int wave, int lane) {
    float* scr = (float*)(lds + wave * 16384);
    bf16* W1T = (bf16*)(P.ws + WS_W1T); float* C1 = (float*)(P.ws + WS_C1);
    for (int it = gw; it < 4 * 64; it += NGW) { const int lk = it >> 6, r = it & 63, layer = lk >> 1, kv = lk & 1;
        const float* w1 = (kv ? P.w1_v : P.w1_k) + (size_t)layer * 2048 * 64;
        transpose_item(w1, 2048, 64, false, nullptr, W1T + (size_t)lk * 64 * 2048, 2, scr, r, lane); }
    for (int it = gw; it < 4 * 16; it += NGW) { const int lk = it >> 4, part = it & 15, layer = lk >> 1, kv = lk & 1; const float* w1 = (kv ? P.w1_v : P.w1_k) + (size_t)layer * 2048 * 64; const float* pe = (kv ? P.pe_v : P.pe_k) + (size_t)layer * 2048;
        float s = 0.f;
#pragma unroll 16
        for (int idx = part * 128; idx < part * 128 + 128; ++idx) s += pe[idx] * w1[(size_t)idx * 64 + lane];
        C1[(lk * 16 + part) * 64 + lane] = s; }
}
}
namespace sg {
using at2::bf16x8; using at2::f32x16; using at2::crow;
__device__ __forceinline__ void small_gemm(const Params& P, int layer, unsigned char* lds) {
    int tid_ = tidx_(P.wv); const int tid = tid_, lane = tid & 63, wave = __builtin_amdgcn_readfirstlane(tid >> 6), r32 = lane & 31, hi = lane >> 5;
    const bf16* XB = (const bf16*)(P.ws + WS_XB); const bf16* W = (const bf16*)(P.ws + WS_WIN) + ((size_t)layer * NP + 8192) * D; const float* SSQ = (const float*)(P.ws + WS_SSQ); float* SMALL = (float*)(P.ws + WS_SMALL);
    float* red = (float*)lds;
    for (int m0 = blockIdx.x * 64; m0 < M; m0 += gridDim.x * 64) {
        f32x16 acc[2]; acc[0] = f32x16{}; acc[1] = f32x16{};
        const bf16* a0 = XB + (size_t)(m0 + r32) * D + wave * 256 + hi * 8; const bf16* a1 = a0 + (size_t)32 * D; const bf16* bp = W + (size_t)r32 * D + wave * 256 + hi * 8;
        bf16x8 wb[16], xa[16], xc[16];
#pragma unroll
        for (int ks = 0; ks < 16; ++ks) { wb[ks] = *(const bf16x8*)(bp + ks * 16); xa[ks] = *(const bf16x8*)(a0 + ks * 16); xc[ks] = *(const bf16x8*)(a1 + ks * 16); }
        __builtin_amdgcn_sched_barrier(0);
#pragma unroll
        for (int ks = 0; ks < 16; ++ks) { acc[0] = __builtin_amdgcn_mfma_f32_32x32x16_bf16(xa[ks], wb[ks], acc[0], 0, 0, 0); acc[1] = __builtin_amdgcn_mfma_f32_32x32x16_bf16(xc[ks], wb[ks], acc[1], 0, 0, 0); }
        __syncthreads();
#pragma unroll
        for (int rt = 0; rt < 2; ++rt)
#pragma unroll
            for (int r = 0; r < 16; ++r) red[wave * 2048 + (rt * 32 + crow(r, hi)) * 32 + r32] = acc[rt][r];
        __syncthreads();
        { const int row = tid >> 3, c0 = (tid & 7) * 4; f4 s = (f4){0.f, 0.f, 0.f, 0.f};
#pragma unroll
          for (int w = 0; w < 8; ++w) s += *(const f4*)(red + w * 2048 + row * 32 + c0);
          const f4* sp = (const f4*)(SSQ + (size_t)(m0 + row) * 32); f4 q = sp[0];
#pragma unroll
          for (int j = 1; j < 8; ++j) q += sp[j];
          const float rstd = 1.0f / sqrtf(((q[0] + q[1]) + (q[2] + q[3])) * (1.0f / 2048.0f) + EPS);
          *(f4*)(SMALL + (size_t)(m0 + row) * 32 + c0) = s * rstd; }
    }
    __syncthreads();
}
}
__device__ __forceinline__ void phase_final(const Params& P, int gw, int NGW, int lane) {
    const float* SSQ = (const float*)(P.ws + WS_SSQ); const bf16* XB = (const bf16*)(P.ws + WS_XB);
    f4 gv[4][2]; { const f4* gr = (const f4*)P.final_g;
#pragma unroll
        for (int j = 0; j < 4; ++j) { gv[j][0] = gr[2 * (lane + 64 * j)]; gv[j][1] = gr[2 * (lane + 64 * j) + 1]; } }
    for (int m = gw; m < M; m += NGW) { float s = (lane < 32) ? SSQ[(size_t)m * 32 + lane] : 0.f;
        const u4* xr = (const u4*)(XB + (size_t)m * D) + lane; f4* orow = (f4*)(P.out + (size_t)m * D);
        u4 xv[4];
#pragma unroll
        for (int j = 0; j < 4; ++j) xv[j] = xr[64 * j];
        s = wsum(s);
        const float rstd = 1.0f / sqrtf(s * (1.0f / 2048.0f) + EPS);
#pragma unroll
        for (int j = 0; j < 4; ++j) { const u4 x = xv[j]; f4 a, b;
            a.x = __uint_as_float(x.x << 16); a.y = __uint_as_float(x.x & 0xffff0000u); a.z = __uint_as_float(x.y << 16); a.w = __uint_as_float(x.y & 0xffff0000u);
            b.x = __uint_as_float(x.z << 16); b.y = __uint_as_float(x.z & 0xffff0000u); b.z = __uint_as_float(x.w << 16); b.w = __uint_as_float(x.w & 0xffff0000u);
            orow[2 * (lane + 64 * j)] = a * rstd * gv[j][0]; orow[2 * (lane + 64 * j) + 1] = b * rstd * gv[j][1]; } }
}
__global__ void __launch_bounds__(512, 2) hymba_fwd(Params P) {
    extern __shared__ __attribute__((aligned(16))) unsigned char lds[];
    cg::grid_group grid = cg::this_grid();
    volatile LAS unsigned* bst = (volatile LAS unsigned*)((LAS unsigned char*)lds + (LDS_BYTES - 16));
    const int wv_s = __builtin_amdgcn_readfirstlane((int)threadIdx.x >> 6);
    { const int t0_ = tidx_(wv_s); if (t0_ < 4) bst[t0_] = 0u; }
    __syncthreads();
    if (blockIdx.x == 0) { for (int i = tidx_(wv_s); i < 4096; i += 512) __hip_atomic_store((unsigned*)(P.ws + WS_BAR) + i, 0u, __ATOMIC_RELAXED, __HIP_MEMORY_SCOPE_AGENT); }
#define GRID_BAR() xcd_barrier(xbar)
    const int G = gridDim.x, NGW = G * 8;
#define LP() Params Pl = P; Pl.wv = wv_s; { __attribute__((address_space(1))) unsigned char* wsg_ = (__attribute__((address_space(1))) unsigned char*)P.ws; asm volatile("" : "+s"(wsg_)); Pl.ws = (unsigned char*)wsg_; }
#ifdef PROBE_ID
    unsigned long long pt0 = 0, pt1 = 0;
#define UA_EXPORT() do { if (PROBE_ID >= 20 && PROBE_ID < 26 && layer == 0) { pt0 = uts[PROBE_ID - 20]; pt1 = (PROBE_ID == 25) ? __builtin_amdgcn_s_memrealtime() : uts[PROBE_ID - 19]; } } while (0)
#ifndef PROBE_LAYER
#define PROBE_LAYER 0
#endif
#define STAMP0(id, lay) do { if (PROBE_ID == (id) && (lay) == PROBE_LAYER) pt0 = __builtin_amdgcn_s_memrealtime(); } while (0)
#define STAMP1(id, lay) do { if (PROBE_ID == (id) && (lay) == PROBE_LAYER) pt1 = __builtin_amdgcn_s_memrealtime(); } while (0)
#else
#define UA_EXPORT() do {} while (0)
#define STAMP0(id, lay) do {} while (0)
#define STAMP1(id, lay) do {} while (0)
#endif
#define PH_IDS() int tid = tidx_(wv_s); const int lane = tid & 63, wave = __builtin_amdgcn_readfirstlane(tid >> 6), gw = blockIdx.x * 8 + wave; (void)lane; (void)gw;
    pg8::bf16_t* WIN = (pg8::bf16_t*)(P.ws + WS_WIN); pg8::bf16_t* WOUT = (pg8::bf16_t*)(P.ws + WS_WOUT); pg8::bf16_t* XB = (pg8::bf16_t*)(P.ws + WS_XB);
    pg8::bf16_t* PROJ = (pg8::bf16_t*)(P.ws + WS_PROJ); pg8::bf16_t* MIX = (pg8::bf16_t*)(P.ws + WS_MIX);
    float* SMALL = (float*)(P.ws + WS_SMALL); float* SSQ = (float*)(P.ws + WS_SSQ);
    STAMP0(30, PROBE_LAYER);
#ifdef PROBE_ID
    const unsigned kt0 = (unsigned)__builtin_amdgcn_s_memrealtime();
#endif
    STAMP0(1, 0);
    { PH_IDS(); LP(); phase_prologue(Pl, lds, gw, NGW, wave, lane); cp2::prologue_cmp(Pl, lds, gw, NGW, wave, lane); }
    grid.sync();
    XcdBarrier xbar = xcd_barrier_post((unsigned*)(P.ws + WS_BAR), bst, wv_s);
    STAMP1(1, 0);
    for (int layer = 0; layer < 2; ++layer) {
        STAMP0(2, layer);
        {
            const int small_pass = (int)((blockIdx.x >> 2) & 1);
#pragma nounroll
            for (int pass = 0; pass < 2; ++pass) {
                if (pass == 1 - small_pass) { __syncthreads(); LP(); sg::small_gemm(Pl, layer, lds); __syncthreads(); }
                if (pass == 0) {
                    const int pm0 = pg8::static_pm_of(M, 8192, G, (int)blockIdx.x, 0); bool same = pm0 >= 0;
                    for (int i = 1; i < 64; ++i) { const int pmi = pg8::static_pm_of(M, 8192, G, (int)blockIdx.x, i); if (pmi < 0) break; if (pmi != pm0) same = false; }
                    if (same) {
                        float* rtab = (float*)(lds + 132096);
                        { const int t_ = tidx_(wv_s);
                          if (t_ < 256) { const f4* sp = (const f4*)(SSQ + (size_t)(pm0 * 256 + t_) * 32); f4 s4 = sp[0];
#pragma unroll
                              for (int j = 1; j < 8; ++j) s4 += sp[j];
                              rtab[t_] = 1.0f / sqrtf(((s4[0] + s4[1]) + (s4[2] + s4[3])) * (1.0f / 2048.0f) + EPS); } }
                        __syncthreads();
                        pg8::Gemm g{XB, WIN + (size_t)layer * NP * D, M, 8192, D, wv_s}; pg8::StaticOrder S; S.init(M, 8192, G, (int)blockIdx.x);
                        pg8::EpiProjTab E{PROJ, NP, rtab};
                        pg8::gemm_phase<pg8::EpiProjTab, pg8::StaticOrder, true, true>((PG8_LAS unsigned char*)lds, g, S, E);
                    } else {
                        pg8::Gemm g{XB, WIN + (size_t)layer * NP * D, M, 8192, D, wv_s}; pg8::StaticOrder S; S.init(M, 8192, G, (int)blockIdx.x);
                        pg8::EpiProj E{PROJ, NP, SSQ, SMALL};
                        pg8::gemm_phase<pg8::EpiProj, pg8::StaticOrder, true, true>((PG8_LAS unsigned char*)lds, g, S, E);
                    }
                }
            }
        }
        GRID_BAR();
        STAMP1(2, layer); STAMP0(3, layer);
        STAMP0(7, layer);
        __syncthreads(); STAMP1(7, layer);
        for (int sg = blockIdx.x; sg < 256; sg += G) { LP(); STAMP0(8, layer); ml::m0_prep(Pl, layer, sg, lds); STAMP1(8, layer); STAMP0(9, layer); ml::m1_state(Pl, sg, lds); STAMP1(9, layer); }
        GRID_BAR();
        STAMP1(3, layer); STAMP0(4, layer);
        {
            unsigned* qctr = (unsigned*)(P.ws + WS_BAR) + 3604 + layer; volatile unsigned* qslot = (volatile unsigned*)(lds + LDS_BYTES - 32);
            for (;;) {
                __syncthreads();
                if (tidx_(wv_s) == 0) *qslot = __hip_atomic_fetch_add(qctr, 1u, __ATOMIC_RELAXED, __HIP_MEMORY_SCOPE_AGENT);
                __syncthreads();
                const int it = (int)__builtin_amdgcn_readfirstlane(*qslot);
                if (it >= 256) break;
                LP();
                if (it < 128) cp2::compress_task(Pl, layer, it, lds);
                else ml::m2_scan(Pl, it - 128);
            }
        }
        GRID_BAR();
        STAMP1(4, layer); STAMP0(5, layer);
#ifdef PROBE_ID
        if (tidx_(wv_s) == 0) *(volatile unsigned long long*)(lds + LDS_BYTES - 64) = __builtin_amdgcn_s_memrealtime();
#endif
        {
            unsigned* qctr = (unsigned*)(P.ws + WS_BAR) + 3601 + layer; volatile unsigned* qslot = (volatile unsigned*)(lds + LDS_BYTES - 32);
            unsigned long long uts[8] = {0, 0, 0, 0, 0, 0, 0, 0}; (void)uts;
            for (;;) {
                __syncthreads();
                if (tidx_(wv_s) == 0) *qslot = __hip_atomic_fetch_add(qctr, 1u, __ATOMIC_RELAXED, __HIP_MEMORY_SCOPE_AGENT);
                __syncthreads();
                const int it = (int)__builtin_amdgcn_readfirstlane(*qslot);
                if (it >= 1280) break;
                LP();
                if (it < 448) { const int c = 127 - (it >> 2), bg = it & 3; at2::unit_a(Pl, layer, bg >> 1, bg & 1, c, lds, uts);
#ifdef PROBE_ID
                    if (it == 0 && layer == 0 && tidx_(wv_s) == 0) { for (int q = 0; q < 5; ++q) ((unsigned*)(P.ws + WS_BAR))[3620 + q] = (unsigned)(uts[q + 1] - uts[q]); ((unsigned*)(P.ws + WS_BAR))[3625] = (unsigned)(uts[0] - uts[6]); ((unsigned*)(P.ws + WS_BAR))[3626] = (unsigned)(uts[7] - uts[5]); }
#endif
                }
                else if (it < 704) ml::m3_out(Pl, layer, it - 448, lds);
                else if (it < 768) { const int i2 = it - 704; const int c = 15 - (i2 >> 2), bg = i2 & 3; at2::unit_a(Pl, layer, bg >> 1, bg & 1, c, lds, uts); }
                else { const int u = it - 768, bg = u >> 7; at2::unit_c(Pl, layer, bg >> 1, bg & 1, u & 127, lds); }
            }
        }
#ifdef PROBE_ID
        if ((PROBE_ID == 31 || PROBE_ID == 32) && layer == PROBE_LAYER && tidx_(wv_s) == 0) { const unsigned d = (unsigned)(__builtin_amdgcn_s_memrealtime() - *(volatile unsigned long long*)(lds + LDS_BYTES - 64)); atomicMax((unsigned*)(P.ws + WS_BAR) + 3600, (PROBE_ID == 31) ? d : (0xffffffffu - d)); }
#endif
        GRID_BAR();
        STAMP1(5, layer); STAMP0(6, layer);
#ifdef PROBE_ID
        if ((PROBE_ID == 31 || PROBE_ID == 32) && layer == PROBE_LAYER) { const unsigned v = __hip_atomic_load((unsigned*)(P.ws + WS_BAR) + 3600, __ATOMIC_RELAXED, __HIP_MEMORY_SCOPE_AGENT); pt0 = 0; pt1 = (PROBE_ID == 31) ? v : (0xffffffffu - v); }
#endif
        {
            pg8::Gemm g{MIX, WOUT + (size_t)layer * D * D, M, D, D, wv_s}; pg8::StaticOrder S; S.init(M, D, G, (int)blockIdx.x);
            pg8::EpiOut E{XB, SSQ, D};
            pg8::gemm_phase<pg8::EpiOut, pg8::StaticOrder, true, true>((PG8_LAS unsigned char*)lds, g, S, E);
        }
        GRID_BAR();
        STAMP1(6, layer);
    }
    STAMP0(13, PROBE_LAYER);
    { PH_IDS(); LP(); phase_final(Pl, gw, NGW, lane); }
    STAMP1(13, PROBE_LAYER);
    STAMP1(30, PROBE_LAYER);
#ifdef PROBE_ID
    if (PROBE_ID == 33) { if (tidx_(wv_s) == 0) { atomicMax((unsigned*)(P.ws + WS_BAR) + 3640, 0xffffffffu - kt0); atomicMax((unsigned*)(P.ws + WS_BAR) + 3641, (unsigned)__builtin_amdgcn_s_memrealtime()); } GRID_BAR(); }
    __syncthreads();
    if (blockIdx.x == 0 && tidx_(wv_s) == 0) { if (PROBE_ID == 33) { const unsigned a = __hip_atomic_load((unsigned*)(P.ws + WS_BAR) + 3640, __ATOMIC_RELAXED, __HIP_MEMORY_SCOPE_AGENT), b = __hip_atomic_load((unsigned*)(P.ws + WS_BAR) + 3641, __ATOMIC_RELAXED, __HIP_MEMORY_SCOPE_AGENT); P.out[0] += (float)((b - (0xffffffffu - a)) / 1000u) * 0.1f; } else if (PROBE_ID >= 50 && PROBE_ID < 53) { const unsigned long long* q = (const unsigned long long*)(P.ws + WS_BAR + 15360); P.out[0] += (float)((unsigned)(q[PROBE_ID - 49] - q[PROBE_ID - 50]) / 100u) * 1.0f; } else if (PROBE_ID >= 40 && PROBE_ID < 47) P.out[0] += (float)(__hip_atomic_load((unsigned*)(P.ws + WS_BAR) + 3620 + (PROBE_ID - 40), __ATOMIC_RELAXED, __HIP_MEMORY_SCOPE_AGENT) / 100u) * 1.0f; else P.out[0] += (float)(pt1 - pt0) * 1.0e-4f; }
#endif
}

extern "C" void kernel_launch(void* const* d_in, const int* in_sizes, int n_in, void* d_out, int out_size, void* d_ws, size_t ws_size, hipStream_t stream) {
    static int grid = 0;
    if (grid == 0) {
        if (n_in != 17 || out_size != M * D || ws_size < WS_END) { fprintf(stderr, "kernel_launch: unexpected shapes (n_in %d out %d ws %zu)\n", n_in, out_size, ws_size); grid = -1; return; }
        int dev = 0, cus = 0, per_cu = 0;
        (void)hipGetDevice(&dev); (void)hipDeviceGetAttribute(&cus, hipDeviceAttributeMultiprocessorCount, dev);
        (void)hipFuncSetAttribute((const void*)hymba_fwd, hipFuncAttributeMaxDynamicSharedMemorySize, LDS_BYTES);
        (void)hipOccupancyMaxActiveBlocksPerMultiprocessor(&per_cu, (const void*)hymba_fwd, 512, LDS_BYTES);
        if (per_cu < 1) { fprintf(stderr, "kernel_launch: occupancy query reports %d blocks per CU\n", per_cu); grid = -1; return; }
        grid = cus;
    }
    if (grid < 0) return;
    Params p{};
    p.x = (const float*)d_in[0]; p.norm_g = (const float*)d_in[1]; p.w_in = (const float*)d_in[2]; p.w_out = (const float*)d_in[3];
    p.pe_k = (const float*)d_in[4]; p.w1_k = (const float*)d_in[5]; p.w2_k = (const float*)d_in[6]; p.pe_v = (const float*)d_in[7]; p.w1_v = (const float*)d_in[8]; p.w2_v = (const float*)d_in[9];
    p.conv_w = (const float*)d_in[10]; p.conv_b = (const float*)d_in[11]; p.i_bias = (const float*)d_in[12]; p.f_bias = (const float*)d_in[13]; p.mnorm_g = (const float*)d_in[14];
    p.sinks = (const float*)d_in[15]; p.final_g = (const float*)d_in[16]; p.out = (float*)d_out; p.ws = (unsigned char*)d_ws;
    void* args[] = {&p};
    hipError_t e = hipLaunchCooperativeKernel((const void*)hymba_fwd, dim3(grid), dim3(512), args, LDS_BYTES, stream);
    if (e != hipSuccess) fprintf(stderr, "kernel_launch: cooperative launch failed: %s (grid %d)\n", hipGetErrorString(e), grid);
}
```
